# Optimizing an MI355X kernel written in HIP

```python
import jax
import jax.numpy as jnp
from jax import lax
import numpy as np

D_MODEL = 1024
BATCH = 8
SEQ = 4096
DEPTH = 2

GRID_W = 64
CTX_LEN = 256
EPS = 1e-6

NA_HEADS = 8
NA_HEAD_DIM = 64
NA_WIN_R = 8
NA_WIN_C = 16
NA_WIDTH = NA_HEADS * NA_HEAD_DIM

CONV_CH = 256
CONV_WIDTH = 31

GLA_HEADS = 4
GLA_DK = 32
GLA_DV = 64
GLA_GATE_RANK = 16
GLA_TAU = 16.0
GLA_CHUNK = 64
GLA_K = GLA_HEADS * GLA_DK
GLA_V = GLA_HEADS * GLA_DV
ROPE_THETA = 10000.0

MIX_WIDTH = NA_WIDTH + CONV_CH + GLA_V
D_FF = 4 * D_MODEL
IN_SPLITS = (NA_WIDTH, NA_WIDTH, NA_WIDTH, 2 * CONV_CH, GLA_K, GLA_K, GLA_V, GLA_V, GLA_GATE_RANK, GLA_GATE_RANK)
IN_WIDTH = 3 * NA_WIDTH + 2 * CONV_CH + 2 * GLA_K + 2 * GLA_V + 2 * GLA_GATE_RANK

kernel_name = 'hymba_style_natten_conformer_gla_dit'


def rms_norm(x, g):
    xf = x.astype(jnp.float32)
    y = xf * lax.rsqrt(jnp.mean(xf * xf, axis=-1, keepdims=True) + EPS)
    return (y * g.astype(jnp.float32)).astype(x.dtype)


def layer_norm(x, g, b):
    xf = x.astype(jnp.float32)
    mu = jnp.mean(xf, axis=-1, keepdims=True)
    var = jnp.mean(jnp.square(xf - mu), axis=-1, keepdims=True)
    y = (xf - mu) * lax.rsqrt(var + EPS)
    return (y * g.astype(jnp.float32) + b.astype(jnp.float32)).astype(x.dtype)


def modulate(h, shift, scale):
    return h * (1.0 + scale) + shift


def split_heads(t, n_heads, head_dim):
    return t.reshape(t.shape[0], t.shape[1], n_heads, head_dim)


def split_columns(u):
    offsets = np.cumsum(IN_SPLITS)[:-1].tolist()
    return jnp.split(u, offsets, axis=-1)


def axial_rope(t):
    n, d = t.shape[1], t.shape[-1]
    half = d // 2
    n_freq = half // 2
    pos = jnp.arange(n)
    inv_freq = ROPE_THETA ** (-jnp.arange(n_freq, dtype=jnp.float32) / n_freq)
    tf = t.astype(jnp.float32)

    def rotate(u, p):
        ang = p.astype(jnp.float32)[:, None] * inv_freq[None, :]
        cos = jnp.cos(ang)[None, :, None, :]
        sin = jnp.sin(ang)[None, :, None, :]
        u1, u2 = u[..., :n_freq], u[..., n_freq:]
        return jnp.concatenate([u1 * cos - u2 * sin, u1 * sin + u2 * cos], axis=-1)

    out = jnp.concatenate([rotate(tf[..., :half], pos // GRID_W), rotate(tf[..., half:], pos % GRID_W)], axis=-1)
    return out.astype(t.dtype)


def neighborhood_attention(q, k, v, k_ctx, v_ctx, rpb, rows):
    b = q.shape[0]
    wr = min(NA_WIN_R, rows)
    n_loc = wr * NA_WIN_C
    qg = q.reshape(b, rows, GRID_W, NA_HEADS, NA_HEAD_DIM)
    kg = k.reshape(b, rows, GRID_W, NA_HEADS, NA_HEAD_DIM)
    vg = v.reshape(b, rows, GRID_W, NA_HEADS, NA_HEAD_DIM)
    cols = jnp.arange(GRID_W)
    col_start = jnp.clip(cols - NA_WIN_C // 2, 0, GRID_W - NA_WIN_C)
    col_idx = col_start[:, None] + jnp.arange(NA_WIN_C)[None, :]
    col_off = col_idx - cols[:, None] + (NA_WIN_C - 1)

    def row_block(r):
        r0 = jnp.clip(r - wr // 2, 0, rows - wr)
        q_r = lax.dynamic_index_in_dim(qg, r, axis=1, keepdims=False)
        k_win = lax.dynamic_slice_in_dim(kg, r0, wr, axis=1)[:, :, col_idx]
        v_win = lax.dynamic_slice_in_dim(vg, r0, wr, axis=1)[:, :, col_idx]
        row_off = r0 + jnp.arange(wr) - r + (NA_WIN_R - 1)
        bias = rpb[:, row_off[:, None, None], col_off[None, :, :]]
        bias = jnp.transpose(bias, (0, 2, 1, 3))[None].astype(jnp.float32)
        s_loc = jnp.einsum('bqhd,brqchd->bhqrc', q_r, k_win).astype(jnp.float32) + bias
        s_ctx = jnp.einsum('bqhd,blhd->bhql', q_r, k_ctx).astype(jnp.float32)
        s = jnp.concatenate([s_loc.reshape(b, NA_HEADS, GRID_W, n_loc), s_ctx], axis=-1)
        p = jax.nn.softmax(s, axis=-1).astype(v.dtype)
        p_loc = p[..., :n_loc].reshape(b, NA_HEADS, GRID_W, wr, NA_WIN_C)
        return (jnp.einsum('bhqrc,brqchd->bqhd', p_loc, v_win)
                + jnp.einsum('bhql,blhd->bqhd', p[..., n_loc:], v_ctx))

    o = lax.map(row_block, jnp.arange(rows))
    return jnp.transpose(o, (1, 0, 2, 3, 4)).reshape(b, rows * GRID_W, NA_WIDTH)


def context_attention(q, k, v):
    s = jnp.einsum('blhd,bmhd->bhlm', q, k).astype(jnp.float32)
    p = jax.nn.softmax(s, axis=-1).astype(v.dtype)
    o = jnp.einsum('bhlm,bmhd->blhd', p, v)
    return o.reshape(o.shape[0], o.shape[1], NA_WIDTH)


def conv_module(u, conv_w, conv_b, ln_g, ln_b, pw_w, pw_b):
    a, g = jnp.split(u, 2, axis=-1)
    h = a * jax.nn.sigmoid(g)
    h = lax.conv_general_dilated(
        h, conv_w[:, None, :].astype(h.dtype), window_strides=(1,),
        padding=[(CONV_WIDTH // 2, CONV_WIDTH // 2)],
        dimension_numbers=('NWC', 'WIO', 'NWC'), feature_group_count=CONV_CH) + conv_b
    h = jax.nn.silu(layer_norm(h, ln_g, ln_b))
    return h @ pw_w + pw_b


def gla_log_decay(z, w, b):
    a = (z @ w + b).astype(jnp.float32)
    return (jax.nn.log_sigmoid(a) / GLA_TAU).reshape(z.shape[0], z.shape[1], GLA_HEADS, GLA_DK)


def gla_chunked_scan(q, k, v, log_a, s0):
    b, n = q.shape[0], q.shape[1]
    n_chunks = n // GLA_CHUNK

    def to_chunks(t):
        t = t.astype(jnp.float32).reshape(b, n_chunks, GLA_CHUNK, t.shape[2], t.shape[3])
        return jnp.transpose(t, (1, 0, 3, 2, 4))

    mask = jnp.tril(jnp.ones((GLA_CHUNK, GLA_CHUNK), dtype=bool))[:, :, None]

    def step(state, inp):
        q_c, k_c, v_c, la_c = inp
        cum = jnp.cumsum(la_c, axis=2)
        rel = jnp.exp(jnp.where(mask, cum[:, :, :, None, :] - cum[:, :, None, :, :], -jnp.inf))
        att = jnp.einsum('bhtd,bhsd,bhtsd->bhts', q_c, k_c, rel)
        out = (jnp.einsum('bhts,bhsv->bhtv', att, v_c)
               + jnp.einsum('bhtd,bhdv->bhtv', q_c * jnp.exp(cum), state))
        last = cum[:, :, -1:, :]
        state = (jnp.exp(last[:, :, 0, :])[..., None] * state
                 + jnp.einsum('bhsd,bhsv->bhdv', k_c * jnp.exp(last - cum), v_c))
        return state, out

    state, out = lax.scan(step, s0, (to_chunks(q), to_chunks(k), to_chunks(v), to_chunks(log_a)))
    out = jnp.transpose(out, (1, 0, 3, 2, 4)).reshape(b, n, GLA_HEADS, GLA_DV)
    return out.astype(v.dtype), state


def gla_bidirectional(q, k, v, la_fwd, la_bwd, s_fwd0, s_bwd0):
    o_f, s_f = gla_chunked_scan(q, k, v, la_fwd, s_fwd0)
    o_b, s_b = gla_chunked_scan(q[:, ::-1], k[:, ::-1], v[:, ::-1], la_bwd[:, ::-1], s_bwd0)
    return o_f + o_b[:, ::-1], s_f, s_b


def gla_output(o, r, g):
    o = rms_norm(o, g)
    return o.reshape(o.shape[0], o.shape[1], GLA_V).astype(r.dtype) * jax.nn.silu(r)


def squared_relu_mlp(h, w1, w2):
    return jnp.square(jax.nn.relu(h @ w1)) @ w2


def hybrid_layer(x, xc, c, c_ctx, p, rows, need_ctx_out):
    b = x.shape[0]
    mod = jax.nn.silu(c) @ p['w_ada'] + p['b_ada']
    mod_c = jax.nn.silu(c_ctx) @ p['w_ada'] + p['b_ada']
    sh_a, sc_a, g_a, sh_m, sc_m, g_m = jnp.split(mod[:, None, :], 6, axis=-1)
    sh_ac, sc_ac, g_ac, sh_mc, sc_mc, g_mc = jnp.split(mod_c, 6, axis=-1)

    h = modulate(rms_norm(x, p['norm1_g']), sh_a, sc_a)
    hc = modulate(rms_norm(xc, p['norm1_g']), sh_ac, sc_ac)
    qa, ka, va, ub, qg, kg, vg, rg, zf, zb = split_columns(h @ p['w_in'])
    qac, kac, vac, ubc, qgc, kgc, vgc, rgc, zfc, zbc = split_columns(hc @ p['w_in'])

    na_scale = NA_HEAD_DIM ** -0.5
    k_ctx = rms_norm(split_heads(kac, NA_HEADS, NA_HEAD_DIM), p['na_k_g'])
    v_ctx = split_heads(vac, NA_HEADS, NA_HEAD_DIM)
    o_a = neighborhood_attention(
        rms_norm(split_heads(qa, NA_HEADS, NA_HEAD_DIM), p['na_q_g']) * na_scale,
        rms_norm(split_heads(ka, NA_HEADS, NA_HEAD_DIM), p['na_k_g']),
        split_heads(va, NA_HEADS, NA_HEAD_DIM), k_ctx, v_ctx, p['na_rpb'], rows)

    o_b = conv_module(ub, p['conv_w'], p['conv_b'], p['conv_ln_g'], p['conv_ln_b'], p['conv_pw_w'], p['conv_pw_b'])

    gla_scale = GLA_DK ** -0.5
    zero_state = jnp.zeros((b, GLA_HEADS, GLA_DK, GLA_DV), jnp.float32)
    o_gc, s_f, s_b = gla_bidirectional(
        split_heads(qgc, GLA_HEADS, GLA_DK) * gla_scale, split_heads(kgc, GLA_HEADS, GLA_DK),
        split_heads(vgc, GLA_HEADS, GLA_DV),
        gla_log_decay(zfc, p['gla_gw_f'], p['gla_gb_f']), gla_log_decay(zbc, p['gla_gw_b'], p['gla_gb_b']),
        zero_state, zero_state)
    o_g, _, _ = gla_bidirectional(
        axial_rope(split_heads(qg, GLA_HEADS, GLA_DK)) * gla_scale, axial_rope(split_heads(kg, GLA_HEADS, GLA_DK)),
        split_heads(vg, GLA_HEADS, GLA_DV),
        gla_log_decay(zf, p['gla_gw_f'], p['gla_gb_f']), gla_log_decay(zb, p['gla_gw_b'], p['gla_gb_b']),
        s_f, s_b)
    o_c = gla_output(o_g, rg, p['gla_out_g'])

    x = x + g_a * (jnp.concatenate([o_a, o_b, o_c], axis=-1) @ p['w_out'])
    x = x + g_m * squared_relu_mlp(modulate(rms_norm(x, p['norm2_g']), sh_m, sc_m), p['w_mlp_in'], p['w_mlp_out'])
    if not need_ctx_out:
        return x, None

    o_ac = context_attention(rms_norm(split_heads(qac, NA_HEADS, NA_HEAD_DIM), p['na_q_g']) * na_scale, k_ctx, v_ctx)
    o_bc = conv_module(ubc, p['conv_w'], p['conv_b'], p['conv_ln_g'], p['conv_ln_b'], p['conv_pw_w'], p['conv_pw_b'])
    o_cc = gla_output(o_gc, rgc, p['gla_out_g'])
    xc = xc + g_ac * (jnp.concatenate([o_ac, o_bc, o_cc], axis=-1) @ p['w_out'])
    xc = xc + g_mc * squared_relu_mlp(modulate(rms_norm(xc, p['norm2_g']), sh_mc, sc_mc), p['w_mlp_in'], p['w_mlp_out'])
    return x, xc


def setup_inputs(seed: int = 0) -> dict:
    key = jax.random.key(seed)
    ks = jax.random.split(key, 32)
    D = D_MODEL

    def nrm(k, shape, s):
        return jax.random.normal(k, shape, jnp.float32) * s

    return {
        'x': nrm(ks[0], (BATCH, SEQ, D), 1.0),
        'c': nrm(ks[1], (BATCH, D), 1.0),
        'ctx': nrm(ks[2], (BATCH, CTX_LEN, D), 1.0),
        'c_ctx': nrm(ks[3], (D,), 1.0),
        'w_ada': nrm(ks[4], (DEPTH, D, 6 * D), D ** -0.5),
        'b_ada': nrm(ks[5], (DEPTH, 6 * D), 0.02),
        'norm1_g': 1.0 + nrm(ks[6], (DEPTH, D), 0.02),
        'w_in': nrm(ks[7], (DEPTH, D, IN_WIDTH), D ** -0.5),
        'na_q_g': 1.0 + nrm(ks[8], (DEPTH, NA_HEAD_DIM), 0.02),
        'na_k_g': 1.0 + nrm(ks[9], (DEPTH, NA_HEAD_DIM), 0.02),
        'na_rpb': nrm(ks[10], (DEPTH, NA_HEADS, 2 * NA_WIN_R - 1, 2 * NA_WIN_C - 1), 0.1),
        'conv_w': nrm(ks[11], (DEPTH, CONV_WIDTH, CONV_CH), CONV_WIDTH ** -0.5),
        'conv_b': nrm(ks[12], (DEPTH, CONV_CH), 0.02),
        'conv_ln_g': 1.0 + nrm(ks[13], (DEPTH, CONV_CH), 0.02),
        'conv_ln_b': nrm(ks[14], (DEPTH, CONV_CH), 0.02),
        'conv_pw_w': nrm(ks[15], (DEPTH, CONV_CH, CONV_CH), CONV_CH ** -0.5),
        'conv_pw_b': nrm(ks[16], (DEPTH, CONV_CH), 0.02),
        'gla_gw_f': nrm(ks[17], (DEPTH, GLA_GATE_RANK, GLA_K), GLA_GATE_RANK ** -0.5),
        'gla_gb_f': nrm(ks[18], (DEPTH, GLA_K), 0.1),
        'gla_gw_b': nrm(ks[19], (DEPTH, GLA_GATE_RANK, GLA_K), GLA_GATE_RANK ** -0.5),
        'gla_gb_b': nrm(ks[20], (DEPTH, GLA_K), 0.1),
        'gla_out_g': 1.0 + nrm(ks[21], (DEPTH, GLA_DV), 0.02),
        'w_out': nrm(ks[22], (DEPTH, MIX_WIDTH, D), MIX_WIDTH ** -0.5),
        'norm2_g': 1.0 + nrm(ks[23], (DEPTH, D), 0.02),
        'w_mlp_in': nrm(ks[24], (DEPTH, D, D_FF), D ** -0.5),
        'w_mlp_out': nrm(ks[25], (DEPTH, D_FF, D), D_FF ** -0.5),
    }


def reference(x, c, ctx, c_ctx, w_ada, b_ada, norm1_g, w_in, na_q_g, na_k_g, na_rpb,
              conv_w, conv_b, conv_ln_g, conv_ln_b, conv_pw_w, conv_pw_b,
              gla_gw_f, gla_gb_f, gla_gw_b, gla_gb_b, gla_out_g, w_out, norm2_g,
              w_mlp_in, w_mlp_out):
    rows = x.shape[1] // GRID_W
    xc = ctx
    for layer in range(DEPTH):
        p = {
            'w_ada': w_ada[layer], 'b_ada': b_ada[layer], 'norm1_g': norm1_g[layer], 'w_in': w_in[layer],
            'na_q_g': na_q_g[layer], 'na_k_g': na_k_g[layer], 'na_rpb': na_rpb[layer],
            'conv_w': conv_w[layer], 'conv_b': conv_b[layer], 'conv_ln_g': conv_ln_g[layer],
            'conv_ln_b': conv_ln_b[layer], 'conv_pw_w': conv_pw_w[layer], 'conv_pw_b': conv_pw_b[layer],
            'gla_gw_f': gla_gw_f[layer], 'gla_gb_f': gla_gb_f[layer], 'gla_gw_b': gla_gw_b[layer],
            'gla_gb_b': gla_gb_b[layer], 'gla_out_g': gla_out_g[layer], 'w_out': w_out[layer],
            'norm2_g': norm2_g[layer], 'w_mlp_in': w_mlp_in[layer], 'w_mlp_out': w_mlp_out[layer],
        }
        x, xc = hybrid_layer(x, xc, c, c_ctx, p, rows, layer < DEPTH - 1)
    return x
```

```cpp
#include <hip/hip_runtime.h>
#include <hip/hip_cooperative_groups.h>
#include <cstdio>
namespace cg = cooperative_groups;

#ifndef MK_ONE_LAUNCH
#define MK_ONE_LAUNCH 1
#endif

#define LAS __attribute__((address_space(3)))
typedef unsigned short bf16_t;
typedef short bf16x8 __attribute__((ext_vector_type(8)));
typedef float f32x4 __attribute__((ext_vector_type(4)));
typedef float f32x2 __attribute__((ext_vector_type(2)));
typedef unsigned u32x4 __attribute__((ext_vector_type(4)));
typedef unsigned u32x2 __attribute__((ext_vector_type(2)));

constexpr int DM = 1024, NBATCH = 8, SEQ = 4096, CTXL = 256, DEPTH = 2;
constexpr int NLAT = NBATCH * SEQ, NCTX = NBATCH * CTXL, MTOT = NLAT + NCTX;
constexpr int NIN = 3072, DFF = 4096, INW = 2848;
constexpr int C_QA = 0, C_KA = 512, C_VA = 1024, C_UA = 1536, C_UG = 1792, C_QG = 2048, C_KG = 2176, C_VG = 2304, C_RG = 2560, C_GF = 2816, C_GB = 2944;
constexpr float EPS = 1e-6f;
constexpr int NCHUNK = 68;
constexpr int NGU = NBATCH * NCHUNK * 4;

constexpr size_t WS_WTIN = 0;
constexpr size_t WS_WTOUT = WS_WTIN + (size_t)DEPTH * NIN * DM * 2;
constexpr size_t WS_WT1 = WS_WTOUT + (size_t)DEPTH * DM * DM * 2;
constexpr size_t WS_WT2 = WS_WT1 + (size_t)DEPTH * DFF * DM * 2;
constexpr size_t WS_WPW = WS_WT2 + (size_t)DEPTH * DFF * DM * 2;
constexpr size_t WS_MOD = WS_WPW + (size_t)DEPTH * 256 * 256 * 2;
constexpr size_t WS_ROPE = WS_MOD + (size_t)DEPTH * 9 * 6144 * 4;
constexpr size_t WS_H = WS_ROPE + 4096;
constexpr size_t WS_U = WS_H + (size_t)MTOT * DM * 2;
constexpr size_t WS_MIX = WS_U + (size_t)MTOT * NIN * 2;
constexpr size_t WS_XC = WS_MIX + (size_t)MTOT * DM * 2;
constexpr size_t WS_DST = WS_XC + (size_t)NCTX * DM * 4;
constexpr size_t WS_DEC = WS_DST + (size_t)NGU * 2 * 2048 * 4;
constexpr size_t WS_SIN = WS_DEC + (size_t)NGU * 2 * 32 * 4;
constexpr size_t WS_GQK = WS_SIN + (size_t)NGU * 2 * 2048 * 2;
constexpr size_t WS_GVT = WS_GQK + (size_t)NGU * 4 * 2048 * 2;
constexpr size_t WS_BAR = WS_GVT + (size_t)NGU * 4096 * 2;
constexpr size_t WS_END = WS_BAR + 16384;
static_assert(WS_END <= (size_t)512 * 1024 * 1024, "workspace too large");
constexpr int LDS_BYTES = 163840;

struct Args { const float* in[26]; float* out; unsigned char* ws; int ph_lo, ph_hi; };

__device__ __forceinline__ float bf2f(bf16_t b) { return __uint_as_float((unsigned)b << 16); }
__device__ __forceinline__ bf16_t f2bf(float f) { unsigned u = __float_as_uint(f); u += 0x7fffu + ((u >> 16) & 1u); return (bf16_t)(u >> 16); }
__device__ __forceinline__ unsigned cvt_pk_bf16(float lo, float hi) { unsigned r; asm volatile("v_cvt_pk_bf16_f32 %0, %1, %2" : "=v"(r) : "v"(lo), "v"(hi)); return r; }
__device__ __forceinline__ float sigmoidf_(float x) { return __builtin_amdgcn_rcpf(1.0f + __expf(-x)); }
__device__ __forceinline__ float siluf_(float x) { return x * __builtin_amdgcn_rcpf(1.0f + __expf(-x)); }
__device__ __forceinline__ float logsigmoidf_(float x) { return x < -30.f ? x : -__logf(1.0f + __expf(-x)); }
__device__ __forceinline__ f32x4 mfma16(bf16x8 a, bf16x8 b, f32x4 c) { return __builtin_amdgcn_mfma_f32_16x16x32_bf16(a, b, c, 0, 0, 0); }

__device__ __forceinline__ float wave_scan_incl(float x) {
    float t;
    t = __int_as_float(__builtin_amdgcn_update_dpp(0, __float_as_int(x), 0x111, 0xf, 0xf, true)); x += t;
    t = __int_as_float(__builtin_amdgcn_update_dpp(0, __float_as_int(x), 0x112, 0xf, 0xf, true)); x += t;
    t = __int_as_float(__builtin_amdgcn_update_dpp(0, __float_as_int(x), 0x114, 0xf, 0xf, true)); x += t;
    t = __int_as_float(__builtin_amdgcn_update_dpp(0, __float_as_int(x), 0x118, 0xf, 0xf, true)); x += t;
    t = __int_as_float(__builtin_amdgcn_update_dpp(0, __float_as_int(x), 0x142, 0xa, 0xf, false)); x += t;
    t = __int_as_float(__builtin_amdgcn_update_dpp(0, __float_as_int(x), 0x143, 0xc, 0xf, false)); x += t;
    return x;
}
#define SHX(x, m) __int_as_float(__builtin_amdgcn_ds_bpermute((F.lane ^ (m)) << 2, __float_as_int(x)))
namespace pg8 {
constexpr int BM = 256, BK = 64, HALF = 128, HTB = HALF * BK * 2, STAGE_BYTES = 8 * HTB, NXCD = 8, WGM = 8;
__host__ __device__ __forceinline__ int lds_byte(int r, int c) { const int st = (r >> 4) * 2 + (c >> 5), rr = r & 15, cc = c & 31, ob = rr * 64 + cc * 2; return st * 1024 + (ob ^ (((ob >> 9) & 1) << 5)); }
__host__ __device__ __forceinline__ void stage_rc(int b, int& R, int& C) { const int st = b / 1024, sb = b % 1024, swz = sb ^ (((sb >> 9) & 1) << 5); R = (st >> 1) * 16 + swz / 64; C = (st & 1) * 32 + (swz % 64) / 2; }
__host__ __device__ __forceinline__ int perm32(int rho) { const int n = rho >> 4, i = rho & 15; return 8 * (i >> 2) + 4 * n + (i & 3); }
struct Unit { int pm, pn, kt0, nt, split, sp; };
struct Gemm { const bf16_t* A; const bf16_t* Bt; int M, N, K; };
struct StaticOrder {
    int nM, nN, nwg, G, c, ntK, nsplit_tiles, ns;
    __device__ __forceinline__ void init(int M, int N, int G_, int c_, int K) { nM = M / BM; nN = N / BM; nwg = nM * nN; G = G_; c = c_; ntK = K / BK; nsplit_tiles = 0; ns = 1; }
    __device__ __forceinline__ void add_split(int ntiles, int ns_) { nsplit_tiles = ntiles; ns = ns_; }
    __device__ __forceinline__ bool next(int i, Unit& u) const {
        const long L = (long)i * G + c;
        const bool sp = L >= nwg;
        const int sidx = sp ? (int)(L - nwg) : 0;
        const bool ok = !sp || sidx < nsplit_tiles * ns;
        const int tile = sidx / ns, spi = sidx % ns;
        int wgid = sp ? 0 : (int)L; { const int q = nwg / NXCD, r = nwg % NXCD, xcd = wgid % NXCD, off = wgid / NXCD; wgid = (xcd < r ? xcd * (q + 1) : r * (q + 1) + (xcd - r) * q) + off; }
        const int nig = WGM * nN, gid = wgid / nig, fm = gid * WGM, gsz = (nM - fm) < WGM ? (nM - fm) : WGM;
        const int pm_f = fm + ((wgid % nig) % gsz), pn_f = (wgid % nig) / gsz;
        const int nts = ntK / ns;
        u.pm = sp ? nM + tile / nN : pm_f; u.pn = sp ? tile % nN : pn_f; u.nt = sp ? nts : ntK; u.kt0 = sp ? spi * nts : 0; u.split = sp ? 1 : 0; u.sp = spi;
        return ok;
    }
    __device__ __forceinline__ void a_ready(const Unit&) const {}
    __device__ __forceinline__ void done(const Unit&) const {}
};
template <int ACT  > struct EpiBf16 {
    static constexpr bool PERM = true;
    bf16_t* O; int ldc;
    __device__ __forceinline__ void operator()(const f32x4 (&acc)[2][2][4][2], const Unit& u, int wr, int wc, int fr, int fq) const {
        const int row0 = u.pm * BM + wr * 64 + fr; const int col0 = u.pn * BM + wc * 32 + 8 * fq;
#pragma unroll
        for (int ai = 0; ai < 2; ++ai)
#pragma unroll
            for (int m = 0; m < 4; ++m) { bf16_t* rowp = O + (size_t)(row0 + ai * HALF + m * 16) * ldc + col0;
#pragma unroll
                for (int bj = 0; bj < 2; ++bj) { f32x4 v0 = acc[ai][bj][m][0], v1 = acc[ai][bj][m][1];
                    if (ACT == 1) {
#pragma unroll
                        for (int j = 0; j < 4; ++j) { float a = fmaxf(v0[j], 0.f), b = fmaxf(v1[j], 0.f); v0[j] = a * a; v1[j] = b * b; } }
                    u32x4 w; w.x = cvt_pk_bf16(v0[0], v0[1]); w.y = cvt_pk_bf16(v0[2], v0[3]); w.z = cvt_pk_bf16(v1[0], v1[1]); w.w = cvt_pk_bf16(v1[2], v1[3]);
                    *(u32x4*)(rowp + bj * HALF) = w; } }
    }
};
struct EpiResid {
    static constexpr bool PERM = false;
    const float* base_lat; const float* base_ctx; float* out_lat; float* out_ctx; const float* mod; int goff; float* part;
    __device__ __forceinline__ void operator()(const f32x4 (&acc)[2][2][4][2], const Unit& u, int wr, int wc, int fr, int fq) const {
        const bool lat = u.pm < (NLAT / BM);
        const float* bp = lat ? base_lat + (size_t)u.pm * BM * DM : base_ctx + (size_t)(u.pm - NLAT / BM) * BM * DM;
        float* op = lat ? out_lat + (size_t)u.pm * BM * DM : out_ctx + (size_t)(u.pm - NLAT / BM) * BM * DM;
        const float* g = mod + (lat ? (u.pm >> 4) : 8) * 6144 + goff;
        const int col0 = u.pn * BM + wc * 32 + 4 * fq;
        f32x4 gv[2][2];
#pragma unroll
        for (int bj = 0; bj < 2; ++bj)
#pragma unroll
            for (int n = 0; n < 2; ++n) gv[bj][n] = *(const f32x4*)(g + col0 + bj * HALF + n * 16);
#pragma unroll
        for (int ai = 0; ai < 2; ++ai)
#pragma unroll
            for (int m = 0; m < 4; ++m) { const size_t ro = (size_t)(wr * 64 + fr + ai * HALF + m * 16) * DM + col0;
#pragma unroll
                for (int bj = 0; bj < 2; ++bj)
#pragma unroll
                    for (int n = 0; n < 2; ++n) {
                        if (u.split) *(f32x4*)(part + (size_t)u.sp * NCTX * DM + (size_t)(u.pm - NLAT / BM) * BM * DM + ro + bj * HALF + n * 16) = gv[bj][n] * acc[ai][bj][m][n];
                        else { const f32x4 bs = *(const f32x4*)(bp + ro + bj * HALF + n * 16); *(f32x4*)(op + ro + bj * HALF + n * 16) = bs + gv[bj][n] * acc[ai][bj][m][n]; } }
                asm volatile("" ::: "memory"); }
    }
};

template <class Epi, class Sched>
__device__ __forceinline__ void gemm_phase(LAS unsigned char* lds, const int tid, const Gemm g, const Sched& S, const Epi& E) {
    const int wid = __builtin_amdgcn_readfirstlane(tid >> 6), lane = tid & 63, wr = wid >> 2, wc = wid & 3, fr = lane & 15, fq = lane >> 4;
    const int K = g.K;
    unsigned voffA[2], voffB[2];
#pragma unroll
    for (int i = 0; i < 2; ++i) { int R, C; stage_rc(tid * 16 + i * 8192, R, C); const int Rb = Epi::PERM ? ((R & ~31) + perm32(R & 31)) : R;
        voffA[i] = (unsigned)(R * K + C) * 2u; voffB[i] = (unsigned)(Rb * K + C) * 2u; }
    const size_t kstep = (size_t)(BK * 2);
    const size_t hstep = (size_t)HALF * K * 2;
    const size_t tstep = 2 * hstep;
    const unsigned ldsw = (unsigned)wid * 1024u;
    const int aoff = lds_byte(wr * 64 + fr, fq * 8), boff = lds_byte(wc * 32 + fr, fq * 8);
#define PG8_SA(b, h) (((b) * 2 + (h)) * HTB)
#define PG8_SB(b, h) ((4 + (b) * 2 + (h)) * HTB)
#define PG8_STAGE(bufoff, gbase, voff) do { _Pragma("unroll") for (int _i = 0; _i < 2; ++_i) \
        __builtin_amdgcn_global_load_lds((const unsigned*)((const char*)(gbase) + (voff)[_i]), (LAS unsigned*)(lds + (bufoff) + ldsw + _i * 8192), 16, 0, 0); } while (0)
#define PG8_LDA(dst, b, h) do { _Pragma("unroll") for (int m = 0; m < 4; ++m) _Pragma("unroll") for (int k = 0; k < 2; ++k) dst[m][k] = *(const LAS bf16x8*)(lds + PG8_SA(b, h) + aoff + m * 2048 + k * 1024); } while (0)
#define PG8_LDB(dst, b, h) do { _Pragma("unroll") for (int n = 0; n < 2; ++n) _Pragma("unroll") for (int k = 0; k < 2; ++k) dst[n][k] = *(const LAS bf16x8*)(lds + PG8_SB(b, h) + boff + n * 2048 + k * 1024); } while (0)
#define PG8_MMA(ai, bj, At, Bt) do { __builtin_amdgcn_s_setprio(1); _Pragma("unroll") for (int m = 0; m < 4; ++m) _Pragma("unroll") for (int n = 0; n < 2; ++n) _Pragma("unroll") for (int k = 0; k < 2; ++k) \
        acc[ai][bj][m][n] = __builtin_amdgcn_mfma_f32_16x16x32_bf16(Bt[n][k], At[m][k], acc[ai][bj][m][n], 0, 0, 0); __builtin_amdgcn_s_setprio(0); } while (0)
#define PG8_WAIT_V(n) asm volatile("s_waitcnt vmcnt(" #n ")" ::: "memory")
#define PG8_WAIT_L(n) asm volatile("s_waitcnt lgkmcnt(" #n ")" ::: "memory")
#define PG8_BAR __builtin_amdgcn_s_barrier()
#define PG8_SCHED __builtin_amdgcn_sched_barrier(0)
    Unit cur, nxt; int ui = 0;
    if (!S.next(0, cur)) return;
    f32x4 acc[2][2][4][2];
#pragma unroll
    for (int a = 0; a < 2; ++a)
#pragma unroll
        for (int b = 0; b < 2; ++b)
#pragma unroll
            for (int m = 0; m < 4; ++m)
#pragma unroll
                for (int n = 0; n < 2; ++n) acc[a][b][m][n] = (f32x4){0.f, 0.f, 0.f, 0.f};
    bf16x8 At[4][2], B0[2][2], B1[2][2];
    const char* cA = (const char*)g.A + (size_t)cur.pm * tstep + (size_t)cur.kt0 * kstep; const char* cB = (const char*)g.Bt + (size_t)cur.pn * tstep + (size_t)cur.kt0 * kstep;
    S.a_ready(cur);
    PG8_STAGE(PG8_SB(0, 0), cB, voffB); PG8_STAGE(PG8_SA(0, 0), cA, voffA); PG8_STAGE(PG8_SB(0, 1), cB + hstep, voffB); PG8_STAGE(PG8_SA(0, 1), cA + hstep, voffA);
    if (wr == 1) PG8_BAR;
    PG8_WAIT_V(4); PG8_BAR;
    PG8_STAGE(PG8_SB(1, 0), cB + kstep, voffB); PG8_STAGE(PG8_SA(1, 0), cA + kstep, voffA); PG8_STAGE(PG8_SB(1, 1), cB + hstep + kstep, voffB);
    PG8_WAIT_V(6); PG8_BAR;
    for (;;) {
        const bool has_next = S.next(ui + 1, nxt);
        const char* nA = has_next ? (const char*)g.A + (size_t)nxt.pm * tstep + (size_t)nxt.kt0 * kstep : cA; const char* nB = has_next ? (const char*)g.Bt + (size_t)nxt.pn * tstep + (size_t)nxt.kt0 * kstep : cB;
        const int nt = cur.nt;
        for (int t = 0; t < nt; t += 2) {
            const bool last = (t == nt - 2);
            const char* a1 = cA + (size_t)(t + 1) * kstep;
            const char* a2 = last ? nA : cA + (size_t)(t + 2) * kstep; const char* b2 = last ? nB : cB + (size_t)(t + 2) * kstep;
            const char* a3 = a2 + kstep; const char* b3 = b2 + kstep;
            if (last && has_next) S.a_ready(nxt);
            PG8_LDB(B0, 0, 0); PG8_SCHED; PG8_LDA(At, 0, 0); PG8_STAGE(PG8_SA(1, 1), a1 + hstep, voffA);
            PG8_WAIT_L(8); PG8_BAR; PG8_WAIT_L(0); PG8_MMA(0, 0, At, B0); PG8_BAR; PG8_SCHED;
            PG8_LDB(B1, 0, 1); PG8_STAGE(PG8_SB(0, 0), b2, voffB);
            PG8_BAR; PG8_WAIT_L(0); PG8_MMA(0, 1, At, B1); PG8_BAR;
            PG8_LDA(At, 0, 1); PG8_STAGE(PG8_SA(0, 0), a2, voffA);
            PG8_BAR; PG8_WAIT_L(0); PG8_MMA(1, 0, At, B0); PG8_BAR; PG8_SCHED;
            PG8_STAGE(PG8_SB(0, 1), b2 + hstep, voffB);
            PG8_WAIT_V(6); PG8_BAR; PG8_MMA(1, 1, At, B1); PG8_BAR;
            PG8_LDB(B0, 1, 0); PG8_SCHED; PG8_LDA(At, 1, 0); PG8_STAGE(PG8_SA(0, 1), a2 + hstep, voffA);
            PG8_WAIT_L(8); PG8_BAR; PG8_WAIT_L(0); PG8_MMA(0, 0, At, B0); PG8_BAR; PG8_SCHED;
            PG8_LDB(B1, 1, 1); PG8_STAGE(PG8_SB(1, 0), b3, voffB);
            PG8_BAR; PG8_WAIT_L(0); PG8_MMA(0, 1, At, B1); PG8_BAR;
            PG8_LDA(At, 1, 1); PG8_STAGE(PG8_SA(1, 0), a3, voffA);
            PG8_BAR; PG8_WAIT_L(0); PG8_MMA(1, 0, At, B0); PG8_BAR; PG8_SCHED;
            PG8_STAGE(PG8_SB(1, 1), b3 + hstep, voffB);
            PG8_WAIT_V(6); PG8_BAR; PG8_MMA(1, 1, At, B1); PG8_BAR;
        }
        E(acc, cur, wr, wc, fr, fq); S.done(cur);
        if (!has_next) break;
#pragma unroll
        for (int a = 0; a < 2; ++a)
#pragma unroll
            for (int b = 0; b < 2; ++b)
#pragma unroll
                for (int m = 0; m < 4; ++m)
#pragma unroll
                    for (int n = 0; n < 2; ++n) acc[a][b][m][n] = (f32x4){0.f, 0.f, 0.f, 0.f};
        cur = nxt; cA = nA; cB = nB; ++ui;
    }
    PG8_WAIT_V(0);
    if (wr == 0) PG8_BAR;
    PG8_BAR;
#undef PG8_SA
#undef PG8_SB
#undef PG8_STAGE
#undef PG8_LDA
#undef PG8_LDB
#undef PG8_MMA
#undef PG8_WAIT_V
#undef PG8_WAIT_L
#undef PG8_BAR
#undef PG8_SCHED
}
}

typedef const float* fptr_t;
struct Frame {
    LAS unsigned char* lds; int tid, lane, wave, G, bid;
    const __attribute__((address_space(4))) fptr_t* inp; float* out; unsigned char* ws;
    __device__ __forceinline__ const float* IN(int i) const { return inp[i]; }
    bf16_t *WtIn, *WtOut, *Wt1, *Wt2, *Wpw, *H, *U, *MIX, *HID, *SinT;
    float *mod, *rope, *XC, *dST, *dec;
    bf16_t *GQK, *GVT;
};

__device__ __forceinline__ void frame_derive(Frame& F) {
    unsigned char* ws = F.ws;
    F.lane = F.tid & 63; F.wave = __builtin_amdgcn_readfirstlane(F.tid >> 6);
    F.WtIn = (bf16_t*)(ws + WS_WTIN); F.WtOut = (bf16_t*)(ws + WS_WTOUT); F.Wt1 = (bf16_t*)(ws + WS_WT1); F.Wt2 = (bf16_t*)(ws + WS_WT2); F.Wpw = (bf16_t*)(ws + WS_WPW);
    F.mod = (float*)(ws + WS_MOD); F.rope = (float*)(ws + WS_ROPE); F.H = (bf16_t*)(ws + WS_H); F.U = (bf16_t*)(ws + WS_U); F.MIX = (bf16_t*)(ws + WS_MIX); F.HID = (bf16_t*)(ws + WS_U);
    F.XC = (float*)(ws + WS_XC); F.dST = (float*)(ws + WS_DST); F.dec = (float*)(ws + WS_DEC); F.SinT = (bf16_t*)(ws + WS_SIN); F.GQK = (bf16_t*)(ws + WS_GQK); F.GVT = (bf16_t*)(ws + WS_GVT);
}
__device__ __forceinline__ void frame_refresh(Frame& F) {
    asm volatile("" : "+v"(F.tid)); asm volatile("" : "+s"(F.ws), "+s"(F.out), "+s"(F.inp), "+s"(F.bid), "+s"(F.G), "+s"(F.lds));
    frame_derive(F);
}
__device__ __forceinline__ void transpose_tile(Frame& F, const float* src, int lds_, int k0, int n0, bf16_t* dst, int ldd) {
    LAS float* T = (LAS float*)F.lds;
    const int r = F.tid >> 4, c4 = (F.tid & 15) * 4;
#pragma unroll
    for (int p = 0; p < 2; ++p) { const int rr = r + p * 32; const f32x4 v = *(const f32x4*)(src + (size_t)(k0 + rr) * lds_ + n0 + c4);
        T[rr * 65 + c4] = v[0]; T[rr * 65 + c4 + 1] = v[1]; T[rr * 65 + c4 + 2] = v[2]; T[rr * 65 + c4 + 3] = v[3]; }
    __syncthreads();
    const int n = F.tid >> 3, kk = (F.tid & 7) * 8;
    u32x4 w;
    w.x = cvt_pk_bf16(T[(kk + 0) * 65 + n], T[(kk + 1) * 65 + n]); w.y = cvt_pk_bf16(T[(kk + 2) * 65 + n], T[(kk + 3) * 65 + n]);
    w.z = cvt_pk_bf16(T[(kk + 4) * 65 + n], T[(kk + 5) * 65 + n]); w.w = cvt_pk_bf16(T[(kk + 6) * 65 + n], T[(kk + 7) * 65 + n]);
    *(u32x4*)(dst + (size_t)(n0 + n) * ldd + k0 + kk) = w;
    __syncthreads();
}

__device__ __forceinline__ void ada_tile(Frame& F, int l, int cgp) {
    LAS float* sc = (LAS float*)F.lds;
    LAS float* red = (LAS float*)(F.lds + 36864);
    const float* c = F.IN(1); const float* cc = F.IN(3);
    for (int i = F.tid; i < 9216; i += 512) { const int j = i >> 10, k = i & 1023; const float v = j < 8 ? c[j * 1024 + k] : cc[k]; sc[i] = siluf_(v); }
    __syncthreads();
    const int n0 = cgp * 64;
    const float* w = F.IN(4) + (size_t)l * 1024 * 6144 + n0 + F.lane;
    float acc[9];
#pragma unroll
    for (int j = 0; j < 9; ++j) acc[j] = 0.f;
    const int kb = F.wave * 128;
#pragma unroll 8
    for (int k = 0; k < 128; ++k) { const float wv = w[(size_t)(kb + k) * 6144];
#pragma unroll
        for (int j = 0; j < 9; ++j) acc[j] += sc[j * 1024 + kb + k] * wv; }
#pragma unroll
    for (int j = 0; j < 9; ++j) red[(F.wave * 9 + j) * 64 + F.lane] = acc[j];
    __syncthreads();
    for (int i = F.tid; i < 576; i += 512) { const int j = i >> 6, col = i & 63; float s = F.IN(5)[l * 6144 + n0 + col];
#pragma unroll
        for (int w8 = 0; w8 < 8; ++w8) s += red[(w8 * 9 + j) * 64 + col];
        F.mod[(size_t)(l * 9 + j) * 6144 + n0 + col] = s; }
    __syncthreads();
}

__device__ __forceinline__ void gate_tile(Frame& F, int l, int kb) {
    const int k = kb * 64 + (F.tid & 63);
    const float* wrow = F.IN(7) + ((size_t)l * 1024 + k) * INW + 2816;
    float z[32];
#pragma unroll
    for (int i = 0; i < 8; ++i) { const f32x4 v = *(const f32x4*)(wrow + 4 * i); z[4 * i] = v[0]; z[4 * i + 1] = v[1]; z[4 * i + 2] = v[2]; z[4 * i + 3] = v[3]; }
    for (int idx = 0; idx < 32; ++idx) {
        const int n = (F.tid >> 6) + 8 * idx, dir = n >> 7, nn = n & 127;
        const float* gw = (dir ? F.IN(19) : F.IN(17)) + (size_t)l * 16 * 128 + nn;
        float s = 0.f;
        if (dir == 0) {
#pragma unroll
            for (int r = 0; r < 16; ++r) s += z[r] * gw[r * 128];
        } else {
#pragma unroll
            for (int r = 0; r < 16; ++r) s += z[16 + r] * gw[r * 128];
        }
        F.WtIn[((size_t)l * NIN + 2816 + n) * DM + k] = f2bf(s);
    }
}

__device__ void phase_setup(Frame& F) {
    constexpr int N_ADA = 192, N_GATE = 32, N_ROPE = 1, TPL = 704 + 256 + 1024 + 1024 + 16, N_TR = 2 * TPL;
    constexpr int N_ITEMS = N_ADA + N_GATE + N_ROPE + N_TR;
    for (int it = F.bid; it < N_ITEMS; it += F.G) {
        frame_refresh(F);
        if (it < N_ADA) { ada_tile(F, it / 96, it % 96); continue; }
        int i = it - N_ADA;
        if (i < N_GATE) { gate_tile(F, i >> 4, i & 15); continue; }
        i -= N_GATE;
        if (i < N_ROPE) {
            const int p = F.tid >> 3, f = F.tid & 7;
            const float inv = powf(10000.0f, -(float)f / 8.0f); const float ang = (float)p * inv;
            F.rope[F.tid] = cosf(ang); F.rope[512 + F.tid] = sinf(ang);
            continue; }
        i -= N_ROPE;
        const int l = i / TPL; int j = i % TPL;
        if (j < 704) { transpose_tile(F, F.IN(7) + (size_t)l * DM * INW, INW, (j / 44) * 64, (j % 44) * 64, F.WtIn + (size_t)l * NIN * DM, DM); continue; }
        j -= 704;
        if (j < 256) { transpose_tile(F, F.IN(22) + (size_t)l * DM * DM, DM, (j / 16) * 64, (j % 16) * 64, F.WtOut + (size_t)l * DM * DM, DM); continue; }
        j -= 256;
        if (j < 1024) { transpose_tile(F, F.IN(24) + (size_t)l * DM * DFF, DFF, (j / 64) * 64, (j % 64) * 64, F.Wt1 + (size_t)l * DFF * DM, DM); continue; }
        j -= 1024;
        if (j < 1024) { transpose_tile(F, F.IN(25) + (size_t)l * DFF * DM, DM, (j / 16) * 64, (j % 16) * 64, F.Wt2 + (size_t)l * DM * DFF, DFF); continue; }
        j -= 1024;
        transpose_tile(F, F.IN(15) + (size_t)l * 65536, 256, (j / 4) * 64, (j % 4) * 64, F.Wpw + (size_t)l * 65536, 256);
    }
}

__device__ void phase_prep(Frame& F, const float* src_lat, const float* src_ctx, const float* modl, int off_sh, int off_sc, const float* gvec, int M, int nparts) {
    for (int row = F.bid * 8 + F.wave; row < M; row += F.G * 8) {
        const float* xp = row < NLAT ? src_lat + (size_t)row * DM : src_ctx + (size_t)(row - NLAT) * DM;
        const float* mp = modl + (row < NLAT ? (row >> 12) : 8) * 6144;
        f32x4 v[4]; float ss = 0.f;
#pragma unroll
        for (int i = 0; i < 4; ++i) { v[i] = *(const f32x4*)(xp + i * 256 + F.lane * 4);
            if (nparts > 0 && row >= NLAT) {
                const float* pp = F.dST + (size_t)(row - NLAT) * DM + i * 256 + F.lane * 4;
                for (int sp = 0; sp < nparts; ++sp) v[i] += *(const f32x4*)(pp + (size_t)sp * NCTX * DM);
                *(f32x4*)(F.XC + (size_t)(row - NLAT) * DM + i * 256 + F.lane * 4) = v[i]; }
            ss += v[i][0] * v[i][0] + v[i][1] * v[i][1] + v[i][2] * v[i][2] + v[i][3] * v[i][3]; }
#pragma unroll
        for (int o = 1; o < 64; o <<= 1) ss += SHX(ss, o);
        const float r = rsqrtf(ss * (1.0f / DM) + EPS);
#pragma unroll
        for (int i = 0; i < 4; ++i) { const int c = i * 256 + F.lane * 4;
            const f32x4 g = *(const f32x4*)(gvec + c), sh = *(const f32x4*)(mp + off_sh + c), sc = *(const f32x4*)(mp + off_sc + c);
            f32x4 y;
#pragma unroll
            for (int j = 0; j < 4; ++j) y[j] = v[i][j] * r * g[j] * (1.0f + sc[j]) + sh[j];
            u32x2 w; w.x = cvt_pk_bf16(y[0], y[1]); w.y = cvt_pk_bf16(y[2], y[3]);
            *(u32x2*)(F.H + (size_t)row * DM + c) = w; }
    }
}

constexpr int NSLOT = 11;
constexpr int VTL_STRIDE = NSLOT * 64 + 8, VTC_STRIDE = 264;
constexpr int NA_VTL = 0, NA_VTC = NA_VTL + 64 * VTL_STRIDE * 2, NA_RPB = NA_VTC + 64 * VTC_STRIDE * 2, NA_RKL = NA_RPB + 1920, NA_RKC = NA_RKL + NSLOT * 64 * 4, NA_GQ = NA_RKC + 1024, NA_KC = NA_GQ + 256, NA_END = NA_KC + 32768;
static_assert(NA_END <= LDS_BYTES - 16, "na lds");

__device__ __forceinline__ float sumsq8(bf16x8 v) { float s = 0.f;
#pragma unroll
    for (int i = 0; i < 8; ++i) { const float f = bf2f((bf16_t)v[i]); s += f * f; } return s; }

__device__ __forceinline__ void na_qfrag(Frame& F, int h, const bf16_t* qrowp, bf16x8 (&qf)[2]) {
    const int fq = F.lane >> 4;
    const bf16x8 q0 = *(const bf16x8*)(qrowp + C_QA + h * 64 + 8 * fq), q1 = *(const bf16x8*)(qrowp + C_QA + h * 64 + 32 + 8 * fq);
    float ss = sumsq8(q0) + sumsq8(q1); ss += SHX(ss, 16); ss += SHX(ss, 32);
    const float rq = rsqrtf(ss * (1.0f / 64.0f) + EPS);
    LAS float* GQ = (LAS float*)(F.lds + NA_GQ);
    const f32x4 g0 = *(const LAS f32x4*)(GQ + 8 * fq), g1 = *(const LAS f32x4*)(GQ + 8 * fq + 4), g2 = *(const LAS f32x4*)(GQ + 32 + 8 * fq), g3 = *(const LAS f32x4*)(GQ + 36 + 8 * fq);
#pragma unroll
    for (int i = 0; i < 4; ++i) {
        qf[0][i] = (short)f2bf(bf2f((bf16_t)q0[i]) * rq * g0[i]); qf[0][4 + i] = (short)f2bf(bf2f((bf16_t)q0[4 + i]) * rq * g1[i]);
        qf[1][i] = (short)f2bf(bf2f((bf16_t)q1[i]) * rq * g2[i]); qf[1][4 + i] = (short)f2bf(bf2f((bf16_t)q1[4 + i]) * rq * g3[i]); }
}

template <bool LOCAL>
__device__ __forceinline__ void na_wave(Frame& F, int h, const bf16x8 (&qf)[2], const bf16_t* kbase  ,
                                        int qb, int kc0, int ro0, LAS bf16_t* VT, int vstride, int vrow0, f32x4 (&o)[4], float& mrow, float& lrow) {
    constexpr int ntile = 16, tile_base = 0;
    const int fr = F.lane & 15, fq = F.lane >> 4;
    const unsigned klane = (unsigned)(fr * NIN + C_KA + h * 64 + 8 * fq);
    bf16x8 kb[4][2][2];
#define NA_LOADB(bi, buf) do { _Pragma("unroll") for (int tt = 0; tt < 2; ++tt) { const int t_ = (bi) * 2 + tt; if (t_ < ntile) { \
        const bf16_t* tbp = LOCAL ? kbase + (size_t)((t_ >> 1) * 64 + (t_ & 1) * 16) * NIN : kbase + (size_t)((tile_base + t_) * 16) * NIN; \
        if (LOCAL) { kb[buf][tt][0] = *(const bf16x8*)(tbp + klane); kb[buf][tt][1] = *(const bf16x8*)(tbp + klane + 32); } \
        else { kb[buf][tt][0] = *(const LAS bf16x8*)(F.lds + NA_KC + ((t_ * 2) * 64 + F.lane) * 16); kb[buf][tt][1] = *(const LAS bf16x8*)(F.lds + NA_KC + ((t_ * 2 + 1) * 64 + F.lane) * 16); } } } } while (0)
    if (LOCAL) { NA_LOADB(0, 0); NA_LOADB(1, 1); NA_LOADB(2, 2); }
    LAS float* rpb = (LAS float*)(F.lds + NA_RPB);
    LAS float* RKL = (LAS float*)(F.lds + NA_RKL); LAS float* RKC = (LAS float*)(F.lds + NA_RKC);
    int bo[2][4];
    if (LOCAL) {
        const int qcol = 16 * qb + fr; int cs = qcol - 8; cs = cs < 0 ? 0 : (cs > 48 ? 48 : cs);
#pragma unroll
        for (int hc = 0; hc < 2; ++hc)
#pragma unroll
            for (int j = 0; j < 4; ++j) { const int keycol = kc0 + 16 * hc + 4 * fq + j; bo[hc][j] = (keycol >= cs && keycol < cs + 16) ? keycol - qcol + 15 : 31; }
    }
    f32x4 sc[16];
#pragma unroll
    for (int bi = 0; bi < 8; ++bi) {
        asm volatile("" ::: "memory");
        if (LOCAL && bi + 3 < 8) NA_LOADB(bi + 3, (bi + 3) & 3);
        asm volatile("" ::: "memory");
#pragma unroll
        for (int tt = 0; tt < 2; ++tt) {
            const int t = bi * 2 + tt;
            sc[t] = (f32x4){-1e30f, -1e30f, -1e30f, -1e30f};
            if (t < ntile) {
                const f32x4 rk = LOCAL ? *(const LAS f32x4*)(RKL + ((vrow0 + (t >> 1)) % NSLOT) * 64 + kc0 + 16 * (t & 1) + 4 * fq) : *(const LAS f32x4*)(RKC + (tile_base + t) * 16 + 4 * fq);
                f32x4 a = (f32x4){0.f, 0.f, 0.f, 0.f};
                if (LOCAL) { a = mfma16(kb[bi & 3][tt][0], qf[0], a); a = mfma16(kb[bi & 3][tt][1], qf[1], a); }
                else { a = mfma16(*(const LAS bf16x8*)(F.lds + NA_KC + ((t * 2) * 64 + F.lane) * 16), qf[0], a); a = mfma16(*(const LAS bf16x8*)(F.lds + NA_KC + ((t * 2 + 1) * 64 + F.lane) * 16), qf[1], a); }
#pragma unroll
                for (int j = 0; j < 4; ++j) {
                    float sv = a[j] * rk[j];
                    if (LOCAL) sv += rpb[(ro0 + (t >> 1)) * 32 + bo[t & 1][j]];
                    sc[t][j] = sv;
                }
            }
        }
    }
#undef NA_LOADB
    {
        float m = -1e30f;
#pragma unroll
        for (int t = 0; t < 16; ++t) m = fmaxf(fmaxf(fmaxf(m, sc[t][0]), fmaxf(sc[t][1], sc[t][2])), sc[t][3]);
        m = fmaxf(m, SHX(m, 16)); m = fmaxf(m, SHX(m, 32));
        float sm = 0.f;
#pragma unroll
        for (int t = 0; t < 16; ++t)
#pragma unroll
            for (int j = 0; j < 4; ++j) { const float p = __builtin_amdgcn_exp2f(sc[t][j] - m); sc[t][j] = p; sm += p; }
        sm += SHX(sm, 16); sm += SHX(sm, 32);
        mrow = m; lrow = sm;
    }
    int vo[LOCAL ? 1 : 2][2][4];
#pragma unroll
    for (int par = 0; par < (LOCAL ? 1 : 2); ++par)
#pragma unroll
        for (int hc = 0; hc < 2; ++hc)
#pragma unroll
            for (int nb = 0; nb < 4; ++nb) { const int d = nb * 16 + fr;
                vo[par][hc][nb] = d * vstride + (((LOCAL ? kc0 : 32 * par) + 16 * hc + 4 * fq) ^ (((d >> 3) & 7) << 3)) + (LOCAL ? 0 : tile_base * 16);
                asm volatile("" : "+v"(vo[par][hc][nb])); }
#pragma unroll
    for (int nb = 0; nb < 4; ++nb) o[nb] = (f32x4){0.f, 0.f, 0.f, 0.f};
#pragma unroll
    for (int ks = 0; ks < 8; ++ks) {
        if (2 * ks < ntile) {
            union { bf16x8 v; unsigned u[4]; } pb;
            pb.u[0] = cvt_pk_bf16(sc[2 * ks][0], sc[2 * ks][1]); pb.u[1] = cvt_pk_bf16(sc[2 * ks][2], sc[2 * ks][3]);
            pb.u[2] = cvt_pk_bf16(sc[2 * ks + 1][0], sc[2 * ks + 1][1]); pb.u[3] = cvt_pk_bf16(sc[2 * ks + 1][2], sc[2 * ks + 1][3]);
            const int kso = LOCAL ? ((vrow0 + ks) % NSLOT) * 64 : (ks >> 1) * 64;
#pragma unroll
            for (int nb = 0; nb < 4; ++nb) {
                union { bf16x8 v; u32x2 h2[2]; } va;
                va.h2[0] = *(const LAS u32x2*)(VT + vo[LOCAL ? 0 : (ks & 1)][0][nb] + kso);
                va.h2[1] = *(const LAS u32x2*)(VT + vo[LOCAL ? 0 : (ks & 1)][1][nb] + kso);
                o[nb] = mfma16(va.v, pb.v, o[nb]); }
        }
    }
}

__device__ __forceinline__ void stage_ctx(Frame& F, const bf16_t* ctx0, int h, int l) {
    LAS bf16_t* VTC = (LAS bf16_t*)(F.lds + NA_VTC); LAS float* RKC = (LAS float*)(F.lds + NA_RKC);
    if (F.tid < 64) ((LAS float*)(F.lds + NA_GQ))[F.tid] = F.IN(8)[l * 64 + F.tid] * F.IN(9)[l * 64 + F.tid] * (0.125f * 1.4426950408889634f);
#pragma unroll
    for (int it = 0; it < 4; ++it) {
        const int item = it * 512 + F.tid, key = item >> 3, dg = item & 7;
        const bf16x8 v = *(const bf16x8*)(ctx0 + (size_t)key * NIN + C_VA + h * 64 + dg * 8);
        const bf16x8 kk = *(const bf16x8*)(ctx0 + (size_t)key * NIN + C_KA + h * 64 + dg * 8);
        const int kx = key ^ (dg << 3);
#pragma unroll
        for (int i = 0; i < 8; ++i) VTC[(dg * 8 + i) * VTC_STRIDE + kx] = (bf16_t)v[i];
        *(LAS bf16x8*)(F.lds + NA_KC + ((((key >> 4) * 2 + (dg >> 2)) * 64) + (dg & 3) * 16 + (key & 15)) * 16) = kk;
        float ss = sumsq8(kk); ss += SHX(ss, 1); ss += SHX(ss, 2); ss += SHX(ss, 4);
        if (dg == 0) RKC[key] = rsqrtf(ss * (1.0f / 64.0f) + EPS);
    }
}

__device__ __forceinline__ void na_store(Frame& F, int h, int qrow0, const f32x4 (&o)[4], float inv) {
    const int fr = F.lane & 15, fq = F.lane >> 4;
    bf16_t* op = F.MIX + (size_t)(qrow0 + fr) * DM + h * 64 + 4 * fq;
#pragma unroll
    for (int nb = 0; nb < 4; ++nb) { const f32x4 r = o[nb] * inv; u32x2 w; w.x = cvt_pk_bf16(r[0], r[1]); w.y = cvt_pk_bf16(r[2], r[3]); *(u32x2*)(op + nb * 16) = w; }
}

__device__ __forceinline__ void na_band(Frame& F, int l, int unit, bool stage_shared) {
    const int qb = F.wave & 3, half = F.wave >> 2;
    const int b = unit >> 6, h = (unit >> 3) & 7, R = (unit & 7) * 8;
    LAS bf16_t* VTL = (LAS bf16_t*)(F.lds + NA_VTL); LAS bf16_t* VTC = (LAS bf16_t*)(F.lds + NA_VTC); LAS float* RKL = (LAS float*)(F.lds + NA_RKL);
    const bf16_t* lat = F.U + (size_t)(b * SEQ) * NIN; const bf16_t* ctx0 = F.U + (size_t)(NLAT + b * CTXL) * NIN;
    const int skey = F.tid >> 3, sdg = F.tid & 7, skx = skey ^ (sdg << 3);
    const bf16_t* vsrc = lat + (size_t)skey * NIN + C_VA + h * 64 + sdg * 8;
    const bf16_t* ksrc = lat + (size_t)skey * NIN + C_KA + h * 64 + sdg * 8;
#define NA_R0(r_) ((r_) - 4 < 0 ? 0 : ((r_) - 4 > 56 ? 56 : (r_) - 4))
    int hi = NA_R0(R + 1) + 7;
    {
        for (int krow = NA_R0(R); krow <= hi; ++krow) { const bf16x8 v = *(const bf16x8*)(vsrc + (size_t)krow * 64 * NIN), kk = *(const bf16x8*)(ksrc + (size_t)krow * 64 * NIN);
            LAS bf16_t* dst = VTL + (sdg * 8) * VTL_STRIDE + (krow % NSLOT) * 64 + skx;
#pragma unroll
            for (int i = 0; i < 8; ++i) dst[i * VTL_STRIDE] = (bf16_t)v[i];
            float ss = sumsq8(kk); ss += SHX(ss, 1); ss += SHX(ss, 2); ss += SHX(ss, 4);
            if (sdg == 0) RKL[(krow % NSLOT) * 64 + skey] = rsqrtf(ss * (1.0f / 64.0f) + EPS); }
        if (stage_shared) stage_ctx(F, ctx0, h, l);
        LAS float* rpb = (LAS float*)(F.lds + NA_RPB); const float* src = F.IN(10) + ((size_t)l * 8 + h) * 465; if (stage_shared && F.tid < 480) { const int rr_ = F.tid >> 5, cc_ = F.tid & 31; rpb[F.tid] = cc_ < 31 ? src[rr_ * 31 + cc_] * 1.4426950408889634f : -1e30f; }
    }
    __syncthreads();
    int kc0 = 16 * qb - 8; kc0 = kc0 < 0 ? 0 : (kc0 > 32 ? 32 : kc0);
    for (int it2 = 0; it2 < 4; ++it2) {
        asm volatile("" : "+v"(F.lane)); const bf16_t* ctxp = ctx0; asm volatile("" : "+s"(ctxp));
        const int rA = R + 2 * it2, r = rA + half, r0 = NA_R0(r);
        int newhi = it2 < 3 ? NA_R0(rA + 3) + 7 : hi; newhi = newhi > 63 ? 63 : newhi;
        const int nnew = newhi - hi;
        bf16x8 pv0 = (bf16x8){0, 0, 0, 0, 0, 0, 0, 0}, pv1 = pv0, pk0 = pv0, pk1 = pv0;
        if (nnew > 0) { pv0 = *(const bf16x8*)(vsrc + (size_t)(hi + 1) * 64 * NIN); pk0 = *(const bf16x8*)(ksrc + (size_t)(hi + 1) * 64 * NIN); }
        if (nnew > 1) { pv1 = *(const bf16x8*)(vsrc + (size_t)(hi + 2) * 64 * NIN); pk1 = *(const bf16x8*)(ksrc + (size_t)(hi + 2) * 64 * NIN); }
        const int fr = F.lane & 15;
        const int qrow0 = b * SEQ + r * 64 + 16 * qb;
        bf16x8 qf[2];
        na_qfrag(F, h, F.U + (size_t)(qrow0 + fr) * NIN, qf);
        f32x4 oacc[4]; float mrun = -1e30f, lrun = 0.f;
#pragma unroll
        for (int nb = 0; nb < 4; ++nb) oacc[nb] = (f32x4){0.f, 0.f, 0.f, 0.f};
#pragma unroll 1
        for (int ph2 = 0; ph2 < 2; ++ph2) {
            asm volatile("" : "+v"(F.lane) :: "memory");
            f32x4 o[4]; float m1, l1;
            if (ph2 == 0) na_wave<false>(F, h, qf, ctxp, qb, 0, 0, VTC, VTC_STRIDE, 0, o, m1, l1);
            else {
                if (nnew > 0) { const int slot = (hi + 1) % NSLOT; LAS bf16_t* dst = VTL + (sdg * 8) * VTL_STRIDE + slot * 64 + skx;
#pragma unroll
                    for (int i = 0; i < 8; ++i) dst[i * VTL_STRIDE] = (bf16_t)pv0[i];
                    float ss = sumsq8(pk0); ss += SHX(ss, 1); ss += SHX(ss, 2); ss += SHX(ss, 4);
                    if (sdg == 0) RKL[slot * 64 + skey] = rsqrtf(ss * (1.0f / 64.0f) + EPS); }
                if (nnew > 1) { const int slot = (hi + 2) % NSLOT; LAS bf16_t* dst = VTL + (sdg * 8) * VTL_STRIDE + slot * 64 + skx;
#pragma unroll
                    for (int i = 0; i < 8; ++i) dst[i * VTL_STRIDE] = (bf16_t)pv1[i];
                    float ss = sumsq8(pk1); ss += SHX(ss, 1); ss += SHX(ss, 2); ss += SHX(ss, 4);
                    if (sdg == 0) RKL[slot * 64 + skey] = rsqrtf(ss * (1.0f / 64.0f) + EPS); }
                na_wave<true>(F, h, qf, lat + (size_t)(r0 * 64 + kc0) * NIN, qb, kc0, r0 - r + 7, VTL, VTL_STRIDE, r0, o, m1, l1);
            }
            const float M = fmaxf(mrun, m1), a1 = __builtin_amdgcn_exp2f(mrun - M), a2 = __builtin_amdgcn_exp2f(m1 - M);
#pragma unroll
            for (int nb = 0; nb < 4; ++nb) oacc[nb] = oacc[nb] * a1 + o[nb] * a2;
            lrun = lrun * a1 + l1 * a2; mrun = M;
        }
        na_store(F, h, qrow0, oacc, 1.0f / lrun);
        hi = newhi;
        __syncthreads();
    }
#undef NA_R0
}

__device__ __forceinline__ void na_ctx_unit(Frame& F, int l, int u2) {
    const int fr = F.lane & 15;
    const int b = u2 >> 4, qblk = (u2 >> 3) & 1, h = u2 & 7;
    LAS bf16_t* VTC = (LAS bf16_t*)(F.lds + NA_VTC);
    const bf16_t* ctx0 = F.U + (size_t)(NLAT + b * CTXL) * NIN;
    stage_ctx(F, ctx0, h, l);
    __syncthreads();
    const int qrow0 = NLAT + b * CTXL + qblk * 128 + 16 * F.wave;
    bf16x8 qf[2];
    na_qfrag(F, h, F.U + (size_t)(qrow0 + fr) * NIN, qf);
    f32x4 o[4]; float m1, l1;
    na_wave<false>(F, h, qf, ctx0, 0, 0, 0, VTC, VTC_STRIDE, 0, o, m1, l1);
    na_store(F, h, qrow0, o, 1.0f / l1);
    __syncthreads();
}

constexpr int CV_G = 0, CV_ACT = 65536, CV_END = 96256;
static_assert(CV_ACT + 64 * 264 * 2 <= LDS_BYTES, "conv lds");
__device__ __forceinline__ void conv_unit(Frame& F, int l, int unit) {
    const int fr = F.lane & 15, fq = F.lane >> 4;
    int row0, seq0, seqn;
    if (unit < 512) { row0 = unit * 64; seq0 = (unit >> 6) * SEQ; seqn = SEQ; } else { const int u2 = unit - 512; row0 = NLAT + u2 * 64; seq0 = NLAT + (u2 >> 2) * CTXL; seqn = CTXL; }
    LAS float* G = (LAS float*)(F.lds + CV_G);
    for (int item = F.tid; item < 94 * 32; item += 512) {
        const int i = item >> 5, c8 = (item & 31) * 8; const int row = row0 - 15 + i;
        f32x4 g0 = (f32x4){0.f, 0.f, 0.f, 0.f}, g1 = g0;
        if (row >= seq0 && row < seq0 + seqn) {
            const bf16x8 a = *(const bf16x8*)(F.U + (size_t)row * NIN + C_UA + c8), g = *(const bf16x8*)(F.U + (size_t)row * NIN + C_UG + c8);
#pragma unroll
            for (int e = 0; e < 4; ++e) { g0[e] = bf2f((bf16_t)a[e]) * sigmoidf_(bf2f((bf16_t)g[e])); g1[e] = bf2f((bf16_t)a[4 + e]) * sigmoidf_(bf2f((bf16_t)g[4 + e])); }
        }
        *(LAS f32x4*)(G + i * 256 + c8) = g0; *(LAS f32x4*)(G + i * 256 + c8 + 4) = g1;
    }
    __syncthreads();
    const int ch = F.tid & 255, tg = F.tid >> 8;
    float acc[32];
    {
        float w[31];
        const float* cw = F.IN(11) + (size_t)l * 31 * 256 + ch;
#pragma unroll
        for (int j = 0; j < 31; ++j) w[j] = cw[j * 256];
        const float cb = F.IN(12)[l * 256 + ch];
#pragma unroll
        for (int tb = 0; tb < 4; ++tb) {
            float xr[38];
#pragma unroll
            for (int i = 0; i < 38; ++i) xr[i] = G[(tg * 32 + tb * 8 + i) * 256 + ch];
#pragma unroll
            for (int o = 0; o < 8; ++o) { float a = cb;
#pragma unroll
                for (int j = 0; j < 31; ++j) a += w[j] * xr[o + j];
                acc[tb * 8 + o] = a; }
        }
    }
    __syncthreads();
#pragma unroll
    for (int t = 0; t < 32; ++t) G[(tg * 32 + t) * 256 + ch] = acc[t];
    __syncthreads();
    LAS bf16_t* ACT = (LAS bf16_t*)(F.lds + CV_ACT);
    {
        const f32x4 lg = *(const f32x4*)(F.IN(13) + l * 256 + F.lane * 4), lb = *(const f32x4*)(F.IN(14) + l * 256 + F.lane * 4);
#pragma unroll
        for (int tt = 0; tt < 8; ++tt) { const int t = F.wave * 8 + tt;
            const f32x4 v = *(const LAS f32x4*)(G + t * 256 + F.lane * 4);
            float s = v[0] + v[1] + v[2] + v[3];
#pragma unroll
            for (int o = 1; o < 64; o <<= 1) s += SHX(s, o);
            const float mu = s * (1.0f / 256.0f);
            const f32x4 dv = v - mu; float q = dv[0] * dv[0] + dv[1] * dv[1] + dv[2] * dv[2] + dv[3] * dv[3];
#pragma unroll
            for (int o = 1; o < 64; o <<= 1) q += SHX(q, o);
            const float rs = rsqrtf(q * (1.0f / 256.0f) + EPS);
            float y[4];
#pragma unroll
            for (int e = 0; e < 4; ++e) y[e] = siluf_(dv[e] * rs * lg[e] + lb[e]);
            u32x2 w; w.x = cvt_pk_bf16(y[0], y[1]); w.y = cvt_pk_bf16(y[2], y[3]);
            *(LAS u32x2*)(ACT + t * 264 + F.lane * 4) = w; }
    }
    __syncthreads();
    f32x4 o[4][2];
#pragma unroll
    for (int mb = 0; mb < 4; ++mb) { o[mb][0] = (f32x4){0.f, 0.f, 0.f, 0.f}; o[mb][1] = o[mb][0]; }
    const bf16_t* wp = F.Wpw + (size_t)l * 65536 + (size_t)(F.wave * 32 + fr) * 256 + 8 * fq;
#pragma unroll
    for (int ks = 0; ks < 8; ++ks) {
        const bf16x8 b0 = *(const bf16x8*)(wp + ks * 32), b1 = *(const bf16x8*)(wp + 16 * 256 + ks * 32);
#pragma unroll
        for (int mb = 0; mb < 4; ++mb) { const bf16x8 a = *(const LAS bf16x8*)(ACT + (mb * 16 + fr) * 264 + ks * 32 + 8 * fq);
            o[mb][0] = mfma16(b0, a, o[mb][0]); o[mb][1] = mfma16(b1, a, o[mb][1]); }
    }
#pragma unroll
    for (int nn = 0; nn < 2; ++nn) { const int n = F.wave * 32 + nn * 16 + 4 * fq; const f32x4 pb = *(const f32x4*)(F.IN(16) + l * 256 + n);
#pragma unroll
        for (int mb = 0; mb < 4; ++mb) { const f32x4 r = o[mb][nn] + pb; u32x2 w; w.x = cvt_pk_bf16(r[0], r[1]); w.y = cvt_pk_bf16(r[2], r[3]);
            *(u32x2*)(F.MIX + (size_t)(row0 + mb * 16 + fr) * DM + 512 + n) = w; } }
    __syncthreads();
}

struct GlaLd { bf16x8 af, ab, qo, qp, ko, kp, v0, v1; };
__device__ __forceinline__ void gla_unit_decode(int unit, int& b, int& cc, int& h, int& row0);
__device__ __forceinline__ void gla_load(Frame& F, int pair, GlaLd& g) {
    const int slot = F.wave >> 2, w4 = F.wave & 3, t4 = F.tid & 255;
    int b, cc, h, row0; gla_unit_decode(pair * 2 + slot, b, cc, h, row0);
    const bf16_t* rp = F.U + (size_t)(row0 + F.lane) * NIN;
    g.af = *(const bf16x8*)(rp + C_GF + h * 32 + 8 * w4); g.ab = *(const bf16x8*)(rp + C_GB + h * 32 + 8 * w4);
    g.qo = *(const bf16x8*)(rp + C_QG + h * 32 + 8 * w4); g.qp = *(const bf16x8*)(rp + C_QG + h * 32 + 8 * (w4 ^ 1));
    g.ko = *(const bf16x8*)(rp + C_KG + h * 32 + 8 * w4); g.kp = *(const bf16x8*)(rp + C_KG + h * 32 + 8 * (w4 ^ 1));
    g.v0 = *(const bf16x8*)(F.U + (size_t)(row0 + (t4 >> 3)) * NIN + C_VG + h * 64 + (t4 & 7) * 8);
    g.v1 = *(const bf16x8*)(F.U + (size_t)(row0 + 32 + (t4 >> 3)) * NIN + C_VG + h * 64 + (t4 & 7) * 8);
}
__device__ __forceinline__ void gla_prep(Frame& F, const GlaLd& g, int l, int b, int cc, int h, int row0, int w4, float (&qF)[8], float (&kF)[8], float (&qB)[8], float (&kB)[8], float (&totF)[8], float (&totB)[8]) {
    const int lane = F.lane;
    const bf16x8 af = g.af, ab = g.ab, qo = g.qo, qp = g.qp, ko = g.ko, kp = g.kp;
    const float* gbf = F.IN(18) + l * 128 + h * 32 + 8 * w4; const float* gbb = F.IN(20) + l * 128 + h * 32 + 8 * w4;
    const bool isctx = cc < 4;
    const int p = (w4 < 2) ? (cc - 4) : lane;
    const float qscale = 0.17677669529663687f;
#pragma unroll
    for (int i = 0; i < 8; ++i) {
        const float laf = logsigmoidf_(bf2f((bf16_t)af[i]) + gbf[i]) * (1.0f / 16.0f), lab = logsigmoidf_(bf2f((bf16_t)ab[i]) + gbb[i]) * (1.0f / 16.0f);
        const float cf = wave_scan_incl(laf), pb = wave_scan_incl(lab);
        totF[i] = __int_as_float(__builtin_amdgcn_readlane(__float_as_int(cf), 63)); totB[i] = __int_as_float(__builtin_amdgcn_readlane(__float_as_int(pb), 63));
        const float cb = totB[i] - pb + lab;
        float q = bf2f((bf16_t)qo[i]), k = bf2f((bf16_t)ko[i]);
        if (!isctx) {
            const float cs = F.rope[p * 8 + i], sn = F.rope[512 + p * 8 + i];
            const float q2 = bf2f((bf16_t)qp[i]), k2 = bf2f((bf16_t)kp[i]);
            if (w4 & 1) { q = q2 * sn + q * cs; k = k2 * sn + k * cs; } else { q = q * cs - q2 * sn; k = k * cs - k2 * sn; }
        }
        q *= qscale;
        const float ef = __expf(cf), eb = __expf(cb);
        qF[i] = q * ef; kF[i] = k * __expf(-cf); qB[i] = q * eb; kB[i] = k * __expf(-cb);
    }
}
__device__ __forceinline__ void gla_unit_decode(int unit, int& b, int& cc, int& h, int& row0) {
    h = unit & 3; const int t = unit >> 2; cc = t % NCHUNK; b = t / NCHUNK;
    row0 = cc < 4 ? NLAT + b * CTXL + cc * 64 : b * SEQ + (cc - 4) * 64;
}
__device__ __forceinline__ void gla_stage_vt(const GlaLd& g, LAS bf16_t* VT, int t4) {
    const int s = t4 >> 3, dg = t4 & 7;
#pragma unroll
    for (int i = 0; i < 8; ++i) { VT[(dg * 8 + i) * 72 + s] = (bf16_t)g.v0[i]; VT[(dg * 8 + i) * 72 + 32 + s] = (bf16_t)g.v1[i]; }
}

constexpr int GL_SLOT = 18432 + 256;
__device__ __forceinline__ void gla_local_pair(Frame& F, int l, int pair, const GlaLd& g) {
    const int fr = F.lane & 15, fq = F.lane >> 4;
    const int slot = F.wave >> 2, w4 = F.wave & 3, t4 = F.tid & 255;
    const int unit = pair * 2 + slot; int b, cc, h, row0; gla_unit_decode(unit, b, cc, h, row0);
    LAS unsigned char* sb = F.lds + slot * GL_SLOT;
    LAS bf16_t* KT[2] = {(LAS bf16_t*)sb, (LAS bf16_t*)(sb + 4608)}; LAS bf16_t* VT = (LAS bf16_t*)(sb + 9216); LAS float* TOT = (LAS float*)(sb + 18432);
    {
        float qF[8], kF[8], qB[8], kB[8], totF[8], totB[8];
        gla_prep(F, g, l, b, cc, h, row0, w4, qF, kF, qB, kB, totF, totB);
#pragma unroll
        for (int i = 0; i < 8; ++i) { KT[0][(8 * w4 + i) * 72 + F.lane] = f2bf(kF[i]); KT[1][(8 * w4 + i) * 72 + F.lane] = f2bf(kB[i]); }
        {
            bf16_t* gq = F.GQK + (size_t)unit * 8192 + F.lane * 32 + 8 * w4; u32x4 w;
            w.x = cvt_pk_bf16(qF[0], qF[1]); w.y = cvt_pk_bf16(qF[2], qF[3]); w.z = cvt_pk_bf16(qF[4], qF[5]); w.w = cvt_pk_bf16(qF[6], qF[7]); *(u32x4*)(gq) = w;
            w.x = cvt_pk_bf16(kF[0], kF[1]); w.y = cvt_pk_bf16(kF[2], kF[3]); w.z = cvt_pk_bf16(kF[4], kF[5]); w.w = cvt_pk_bf16(kF[6], kF[7]); *(u32x4*)(gq + 2048) = w;
            w.x = cvt_pk_bf16(qB[0], qB[1]); w.y = cvt_pk_bf16(qB[2], qB[3]); w.z = cvt_pk_bf16(qB[4], qB[5]); w.w = cvt_pk_bf16(qB[6], qB[7]); *(u32x4*)(gq + 4096) = w;
            w.x = cvt_pk_bf16(kB[0], kB[1]); w.y = cvt_pk_bf16(kB[2], kB[3]); w.z = cvt_pk_bf16(kB[4], kB[5]); w.w = cvt_pk_bf16(kB[6], kB[7]); *(u32x4*)(gq + 6144) = w;
        }
        if (F.lane == 0) {
#pragma unroll
            for (int i = 0; i < 8; ++i) { TOT[8 * w4 + i] = totF[i]; TOT[32 + 8 * w4 + i] = totB[i];
                F.dec[(size_t)(unit * 2 + 0) * 32 + 8 * w4 + i] = __expf(totF[i]); F.dec[(size_t)(unit * 2 + 1) * 32 + 8 * w4 + i] = __expf(totB[i]); } }
    }
    gla_stage_vt(g, VT, t4);
    __syncthreads();
    {
#pragma unroll
        for (int it2 = 0; it2 < 2; ++it2) { const int item = it2 * 256 + t4, dv = item >> 3, s8 = (item & 7) * 8;
            *(u32x4*)(F.GVT + (size_t)unit * 4096 + dv * 64 + s8) = *(const LAS u32x4*)(VT + dv * 72 + s8); }
    }
    const int dir = w4 >> 1, mb = w4 & 1;
    f32x4 acc[4];
#pragma unroll
    for (int nb = 0; nb < 4; ++nb) acc[nb] = (f32x4){0.f, 0.f, 0.f, 0.f};
#pragma unroll
    for (int ks = 0; ks < 2; ++ks) { const bf16x8 a = *(const LAS bf16x8*)(KT[dir] + (mb * 16 + fr) * 72 + ks * 32 + 8 * fq);
#pragma unroll
        for (int nb = 0; nb < 4; ++nb) { const bf16x8 vb = *(const LAS bf16x8*)(VT + (nb * 16 + fr) * 72 + ks * 32 + 8 * fq); acc[nb] = mfma16(a, vb, acc[nb]); } }
    f32x4 sc4;
#pragma unroll
    for (int j = 0; j < 4; ++j) sc4[j] = __expf(TOT[dir * 32 + mb * 16 + 4 * fq + j]);
#pragma unroll
    for (int nb = 0; nb < 4; ++nb) *(f32x4*)(F.dST + (size_t)(unit * 2 + dir) * 2048 + (nb * 16 + fr) * 32 + mb * 16 + 4 * fq) = acc[nb] * sc4;
    __syncthreads();
}

__device__ void phase_gla_scan(Frame& F) {
    for (int e = F.bid * 512 + F.tid; e < NBATCH * 4 * 2 * 2048; e += F.G * 512) {
        const int inner = e & 2047, dir = (e >> 11) & 1, h = (e >> 12) & 3, b = e >> 14, d = inner & 31;
        float S = 0.f;
#pragma unroll 4
        for (int step = 0; step < NCHUNK; ++step) {
            const int cc = dir == 0 ? step : (step < 4 ? 3 - step : 71 - step);
            const int unit = (b * NCHUNK + cc) * 4 + h; const size_t idx = (size_t)(unit * 2 + dir) * 2048 + inner;
            F.SinT[idx] = f2bf(S);
            S = F.dec[(size_t)(unit * 2 + dir) * 32 + d] * S + F.dST[idx];
        }
    }
}

__device__ __forceinline__ void gla_out_wave(Frame& F, int l, int unit, int tb) {
    const int fr = F.lane & 15, fq = F.lane >> 4;
    int b, cc, h, row0; gla_unit_decode(unit, b, cc, h, row0);
    const bf16_t* gq = F.GQK + (size_t)unit * 8192; const bf16_t* gv = F.GVT + (size_t)unit * 4096;
    bf16x8 qa2[2], kb2[2][4], sb2[2][4];
    union VFrag { bf16x8 v; u32x2 h2[2]; } vb2[2][4];
#pragma unroll
    for (int dir = 0; dir < 2; ++dir) {
        qa2[dir] = *(const bf16x8*)(gq + dir * 4096 + (tb * 16 + fr) * 32 + 8 * fq);
#pragma unroll
        for (int sbk = 0; sbk < 4; ++sbk) { const bool valid = dir == 0 ? (sbk <= tb) : (sbk >= tb);
            kb2[dir][sbk] = valid ? *(const bf16x8*)(gq + dir * 4096 + 2048 + (sbk * 16 + fr) * 32 + 8 * fq) : (bf16x8){0, 0, 0, 0, 0, 0, 0, 0}; }
#pragma unroll
        for (int nb = 0; nb < 4; ++nb) sb2[dir][nb] = *(const bf16x8*)(F.SinT + (size_t)(unit * 2 + dir) * 2048 + (nb * 16 + fr) * 32 + 8 * fq);
    }
#pragma unroll
    for (int ks = 0; ks < 2; ++ks)
#pragma unroll
        for (int nb = 0; nb < 4; ++nb) { vb2[ks][nb].h2[0] = *(const u32x2*)(gv + (nb * 16 + fr) * 64 + ks * 32 + 4 * fq); vb2[ks][nb].h2[1] = *(const u32x2*)(gv + (nb * 16 + fr) * 64 + ks * 32 + 16 + 4 * fq); }
    u32x2 rw4[4]; f32x4 og4[4];
    const size_t orow = (size_t)(row0 + tb * 16 + fr);
#pragma unroll
    for (int nb = 0; nb < 4; ++nb) { rw4[nb] = *(const u32x2*)(F.U + orow * NIN + C_RG + h * 64 + nb * 16 + 4 * fq); og4[nb] = *(const f32x4*)(F.IN(21) + l * 64 + nb * 16 + 4 * fq); }
    f32x4 o[4];
#pragma unroll
    for (int nb = 0; nb < 4; ++nb) o[nb] = (f32x4){0.f, 0.f, 0.f, 0.f};
#pragma unroll
    for (int dir = 0; dir < 2; ++dir) {
        const bf16x8 qa = qa2[dir];
        f32x4 at[4];
#pragma unroll
        for (int sbk = 0; sbk < 4; ++sbk) {
            const bool valid = dir == 0 ? (sbk <= tb) : (sbk >= tb);
            at[sbk] = (f32x4){0.f, 0.f, 0.f, 0.f};
            if (valid) at[sbk] = mfma16(kb2[dir][sbk], qa, at[sbk]);
            if (sbk == tb) {
#pragma unroll
                for (int j = 0; j < 4; ++j) { const bool keep = dir == 0 ? (4 * fq + j <= fr) : (4 * fq + j >= fr); at[sbk][j] = keep ? at[sbk][j] : 0.f; } }
        }
#pragma unroll
        for (int ks = 0; ks < 2; ++ks) {
            union { bf16x8 v; unsigned u[4]; } pb;
            pb.u[0] = cvt_pk_bf16(at[2 * ks][0], at[2 * ks][1]); pb.u[1] = cvt_pk_bf16(at[2 * ks][2], at[2 * ks][3]);
            pb.u[2] = cvt_pk_bf16(at[2 * ks + 1][0], at[2 * ks + 1][1]); pb.u[3] = cvt_pk_bf16(at[2 * ks + 1][2], at[2 * ks + 1][3]);
#pragma unroll
            for (int nb = 0; nb < 4; ++nb) o[nb] = mfma16(vb2[ks][nb].v, pb.v, o[nb]); }
#pragma unroll
        for (int nb = 0; nb < 4; ++nb) o[nb] = mfma16(sb2[dir][nb], qa, o[nb]);
    }
    {
        float ss = 0.f;
#pragma unroll
        for (int nb = 0; nb < 4; ++nb) ss += o[nb][0] * o[nb][0] + o[nb][1] * o[nb][1] + o[nb][2] * o[nb][2] + o[nb][3] * o[nb][3];
        ss += SHX(ss, 16); ss += SHX(ss, 32);
        const float rinv = rsqrtf(ss * (1.0f / 64.0f) + EPS);
        const size_t row = (size_t)(row0 + tb * 16 + fr);
#pragma unroll
        for (int nb = 0; nb < 4; ++nb) { const int dv = nb * 16 + 4 * fq;
            const u32x2 rw = rw4[nb]; const f32x4 og = og4[nb];
            const float r0_ = __uint_as_float(rw.x << 16), r1_ = __uint_as_float(rw.x & 0xffff0000u), r2_ = __uint_as_float(rw.y << 16), r3_ = __uint_as_float(rw.y & 0xffff0000u);
            u32x2 w; w.x = cvt_pk_bf16(o[nb][0] * rinv * og[0] * siluf_(r0_), o[nb][1] * rinv * og[1] * siluf_(r1_));
            w.y = cvt_pk_bf16(o[nb][2] * rinv * og[2] * siluf_(r2_), o[nb][3] * rinv * og[3] * siluf_(r3_));
            *(u32x2*)(F.MIX + row * DM + 768 + h * 64 + dv) = w; }
    }
}

__device__ void phase_mixers(Frame& F, int l) {
    const int n_na = 512 + (l == 0 ? 128 : 0), n_cv = 512 + (l == 0 ? 32 : 0), n_gl = NGU / 2;
    for (int it = F.bid; it < n_na + n_cv; it += F.G) {
        frame_refresh(F);
        if (it < n_na) {
            if (it < 512) {
                const int wb = it & 255, second = it >> 8, rest = wb >> 3;
                na_band(F, l, ((wb & 7) << 6) | ((rest >> 2) << 3) | ((rest & 3) * 2 + second), second == 0 || F.G != 256);
            } else na_ctx_unit(F, l, it - 512); }
        else conv_unit(F, l, it - n_na);
    }
    const int base = n_na + n_cv;
    int it = base + ((F.bid - base % F.G) + F.G) % F.G;
    frame_refresh(F);
    GlaLd cur;
    if (it < base + n_gl) gla_load(F, it - base, cur);
    for (; it < base + n_gl; it += F.G) {
        frame_refresh(F);
        GlaLd nxt = cur;
        if (it + F.G < base + n_gl) gla_load(F, it + F.G - base, nxt);
        gla_local_pair(F, l, it - base, cur);
        cur = nxt;
    }
}
__device__ void phase_gla_out(Frame& F, int l) {
    for (int it = F.bid * 8 + F.wave; it < NGU * 4; it += F.G * 8) gla_out_wave(F, l, it >> 2, it & 3);
}

#define XB_TMO      128
#define XB_XCNT(j)  (256  + 64 * (j))
#define XB_XSUB(j)  (1280 + 64 * (j))
#define XB_XGEN(j)  (2304 + 64 * (j))
#define XB_TOP      3328
#define XB_TOPGEN   3392
#define XCD_BAR_WORDS 3456
#define XB_SPIN_CAP (1u << 23)
__device__ __forceinline__ unsigned xb_ld(unsigned* p)              { return __hip_atomic_load(p, __ATOMIC_RELAXED, __HIP_MEMORY_SCOPE_AGENT); }
__device__ __forceinline__ unsigned xb_add(unsigned* p, unsigned v) { return __hip_atomic_fetch_add(p, v, __ATOMIC_RELAXED, __HIP_MEMORY_SCOPE_AGENT); }
__device__ __forceinline__ unsigned xb_xcc_id() { return (unsigned)__builtin_amdgcn_s_getreg((3 << 11) | 20) & 0xFu; }
#define XB_SPIN(cond, bar) do { unsigned _sp = 0; while (cond) { __builtin_amdgcn_s_sleep(1); \
    if ((++_sp & 255u) == 0u) { if (xb_ld(&(bar)[XB_TMO])) break; if (_sp > XB_SPIN_CAP) { atomicAdd(&(bar)[XB_TMO], 1u); break; } } } } while (0)
struct XcdBarrier { unsigned* bar; unsigned x; volatile LAS unsigned* st; };
__device__ __forceinline__ XcdBarrier xcd_barrier_post(unsigned* bar, volatile LAS unsigned* st) {
    XcdBarrier b; b.bar = bar; b.x = xb_xcc_id(); b.st = st;
    if (threadIdx.x == 0) (void)xb_add(&bar[XB_XCNT(b.x)], 1u);
    return b;
}
__device__ __forceinline__ void xcd_barrier_complete(unsigned* bar, unsigned x, unsigned& nloc, unsigned& nx) {
    const unsigned G = gridDim.x * gridDim.y * gridDim.z;
    unsigned sum, cnt, mine, sp = 0u;
    for (;;) {
        sum = 0u; cnt = 0u; mine = 0u;
#pragma unroll
        for (unsigned j = 0; j < 16; ++j) { const unsigned c = xb_ld(&bar[XB_XCNT(j)]); sum += c; cnt += (c > 0u) ? 1u : 0u; mine = (j == x) ? c : mine; }
        if (sum == G) break;
        __builtin_amdgcn_s_sleep(1);
        if ((++sp & 255u) == 0u) { if (xb_ld(&bar[XB_TMO])) break; if (sp > XB_SPIN_CAP) { atomicAdd(&bar[XB_TMO], 1u); break; } }
    }
    nloc = mine > 0u ? mine : 1u; nx = cnt > 0u ? cnt : 1u;
}
__device__ __forceinline__ void xcd_barrier(const XcdBarrier& b, const bool t0) {
    asm volatile("s_waitcnt vmcnt(0)" ::: "memory");
    __syncthreads();
    if (t0) {
        unsigned* bar = b.bar;
        __builtin_amdgcn_s_waitcnt(0);
        unsigned nloc = b.st[0], nx = b.st[1];
        if (nloc == 0u) { xcd_barrier_complete(bar, b.x, nloc, nx); b.st[0] = nloc; b.st[1] = nx; }
        const unsigned old = xb_add(&bar[XB_XSUB(b.x)], 1u);
        const unsigned gen = old / nloc;
        if (old + 1u == (gen + 1u) * nloc) {
            __builtin_amdgcn_fence(__ATOMIC_RELEASE, "agent");
            asm volatile("s_waitcnt vmcnt(0)" ::: "memory");
            const unsigned og = xb_add(&bar[XB_TOP], 1u);
            const unsigned tg = og / nx;
            if (og + 1u == (tg + 1u) * nx) xb_add(&bar[XB_TOPGEN], 1u);
            else XB_SPIN(xb_ld(&bar[XB_TOPGEN]) == tg, bar);
            __builtin_amdgcn_fence(__ATOMIC_ACQUIRE, "agent");
            xb_add(&bar[XB_XGEN(b.x)], 1u);
            asm volatile("s_waitcnt vmcnt(0)" ::: "memory");
        } else {
            XB_SPIN(xb_ld(&bar[XB_XGEN(b.x)]) == gen, bar);
            __builtin_amdgcn_fence(__ATOMIC_ACQUIRE, "agent");
            asm volatile("s_waitcnt vmcnt(0)" ::: "memory");
        }
    }
    __syncthreads();
}

constexpr int N_PHASES = 1 + 9 * DEPTH;

__device__ __forceinline__ void run_phase(Frame& F, int ph) {
#ifndef PH_MASK
#define PH_MASK 0x3ff
#endif
    if (ph == 0) { if (PH_MASK & 1) phase_setup(F); return; }
    const int l = (ph - 1) / 9, s = (ph - 1) % 9;
    const float* modl = F.mod + (size_t)l * 9 * 6144;
    const float* xlat = l == 0 ? F.IN(0) : F.out;
    const float* xctx = l == 0 ? F.IN(2) : F.XC;
    const int Mfull = l == 0 ? MTOT : NLAT;
    pg8::StaticOrder S;
    switch (s) {
    case 0: if (PH_MASK & 2) phase_prep(F, xlat, xctx, modl, 0, 1024, F.IN(6) + l * DM, MTOT, l == 0 ? 0 : 8); break;
    case 1: if (PH_MASK & 4) { pg8::Gemm g{F.H, F.WtIn + (size_t)l * NIN * DM, MTOT, NIN, DM}; S.init(MTOT, NIN, F.G, F.bid, DM); pg8::EpiBf16<0> E{F.U, NIN}; pg8::gemm_phase(F.lds, F.tid, g, S, E); } break;
    case 2: if (PH_MASK & 8) phase_mixers(F, l); break;
    case 3: if (PH_MASK & 16) phase_gla_scan(F); break;
    case 4: if (PH_MASK & 32) phase_gla_out(F, l); break;
    case 5: if (PH_MASK & 64) { pg8::Gemm g{F.MIX, F.WtOut + (size_t)l * DM * DM, Mfull, DM, DM}; S.init(NLAT, DM, F.G, F.bid, DM); if (l == 0) S.add_split(32, 4); pg8::EpiResid E{xlat, xctx, F.out, F.XC, modl, 2048, F.dST}; pg8::gemm_phase(F.lds, F.tid, g, S, E); } break;
    case 6: if (PH_MASK & 128) phase_prep(F, F.out, l == 0 ? xctx : F.XC, modl, 3072, 4096, F.IN(23) + l * DM, Mfull, l == 0 ? 4 : 0); break;
    case 7: if (PH_MASK & 256) { pg8::Gemm g{F.H, F.Wt1 + (size_t)l * DFF * DM, Mfull, DFF, DM}; S.init(Mfull, DFF, F.G, F.bid, DM); pg8::EpiBf16<1> E{F.HID, DFF}; pg8::gemm_phase(F.lds, F.tid, g, S, E); } break;
    case 8: if (PH_MASK & 512) { pg8::Gemm g{F.HID, F.Wt2 + (size_t)l * DM * DFF, Mfull, DM, DFF}; S.init(NLAT, DM, F.G, F.bid, DFF); if (l == 0) S.add_split(32, 8); pg8::EpiResid E{F.out, F.XC, F.out, F.XC, modl, 5120, F.dST}; pg8::gemm_phase(F.lds, F.tid, g, S, E); } break;
    }
}

__global__ void __launch_bounds__(512, 2) mk_fwd(Args args) {
    extern __shared__ __attribute__((aligned(16))) unsigned char lds_raw[];
    const int wave0 = __builtin_amdgcn_readfirstlane((int)threadIdx.x >> 6);
    volatile LAS unsigned* bst = (volatile LAS unsigned*)((LAS unsigned char*)lds_raw + LDS_BYTES - 16);
    if (threadIdx.x == 0) { bst[0] = 0u; bst[1] = 0u; }
    __syncthreads();
    XcdBarrier xbar; xbar.bar = (unsigned*)(args.ws + WS_BAR); xbar.x = 0; xbar.st = bst;
    if (args.ph_hi - args.ph_lo > 1) xbar = xcd_barrier_post((unsigned*)(args.ws + WS_BAR), bst);
    for (int step = args.ph_lo; step < args.ph_hi; ++step) {
        int ph = step;
#ifdef PROBE_KIND
        { const int P = PROBE_KIND == 9 ? 0 : 1 + PROBE_KIND, Q = PROBE_KIND == 9 ? 1000 : 10 + PROBE_KIND; ph = step - (step > P ? 1 : 0) - (step > Q + 1 ? 1 : 0); }
#endif
        if (step > args.ph_lo) { if (args.ph_hi < 0) cg::this_grid().sync();
            else { unsigned on2 = ~0u; asm volatile("" : "+s"(on2)); xcd_barrier(xbar, wave0 == 0 && __builtin_amdgcn_mbcnt_hi(on2, __builtin_amdgcn_mbcnt_lo(on2, 0u)) == 0u); } }
        Frame F;
        unsigned ones = ~0u; int w0 = wave0; asm volatile("" : "+s"(ones), "+s"(w0));
        int tid = w0 * 64 + (int)__builtin_amdgcn_mbcnt_hi(ones, __builtin_amdgcn_mbcnt_lo(ones, 0u)); asm volatile("" : "+v"(tid));
        int bid = blockIdx.x, G = gridDim.x; asm volatile("" : "+s"(bid), "+s"(G));
        unsigned char* ws = args.ws; float* out = args.out; asm volatile("" : "+s"(ws), "+s"(out));
        const __attribute__((address_space(4))) fptr_t* kp = (const __attribute__((address_space(4))) fptr_t*)__builtin_amdgcn_kernarg_segment_ptr(); asm volatile("" : "+s"(kp));
        { LAS unsigned char* lb = (LAS unsigned char*)lds_raw; asm volatile("" : "+s"(lb)); F.lds = lb; }
        F.tid = tid; F.lane = tid & 63; F.wave = __builtin_amdgcn_readfirstlane(tid >> 6); F.G = G; F.bid = bid;
        F.inp = kp; F.out = out; F.ws = ws;
        frame_derive(F);
        run_phase(F, ph);
    }
}

extern "C" void kernel_launch(void* const* d_in, const int* in_sizes, int n_in, void* d_out, int out_size, void* d_ws, size_t ws_size, hipStream_t stream) {
    static int grid = 0;
    if (grid == 0) {
        if (n_in != 26 || ws_size < WS_END) { fprintf(stderr, "kernel_launch: unexpected n_in %d or ws_size %zu (< %zu)\n", n_in, ws_size, (size_t)WS_END); grid = -1; return; }
        int dev = 0, cus = 0, per_cu = 0;
        hipGetDevice(&dev); hipDeviceGetAttribute(&cus, hipDeviceAttributeMultiprocessorCount, dev);
        if (hipFuncSetAttribute((const void*)mk_fwd, hipFuncAttributeMaxDynamicSharedMemorySize, LDS_BYTES) != hipSuccess) { fprintf(stderr, "kernel_launch: hipFuncSetAttribute failed\n"); grid = -1; return; }
        if (hipOccupancyMaxActiveBlocksPerMultiprocessor(&per_cu, (const void*)mk_fwd, 512, LDS_BYTES) != hipSuccess || per_cu < 1) { fprintf(stderr, "kernel_launch: occupancy query %d\n", per_cu); per_cu = 1; }
        (void)hipGetLastError();
        grid = cus;
    }
    if (grid < 0) return;
    Args a{};
    for (int i = 0; i < 26; ++i) a.in[i] = (const float*)d_in[i];
    a.out = (float*)d_out; a.ws = (unsigned char*)d_ws;
#if MK_ONE_LAUNCH
    if (hipMemsetAsync((char*)d_ws + WS_BAR, 0, 16384, stream) != hipSuccess) { fprintf(stderr, "kernel_launch: memset failed\n"); return; }
#ifdef PROBE_KIND
    a.ph_lo = 0; a.ph_hi = N_PHASES + (PROBE_KIND == 9 ? 1 : 2);
#else
    a.ph_lo = 0; a.ph_hi = N_PHASES;
#endif
    void* kargs[] = {&a};
    hipError_t e = hipLaunchCooperativeKernel((const void*)mk_fwd, dim3(grid), dim3(512), kargs, LDS_BYTES, stream);
    if (e != hipSuccess) fprintf(stderr, "cooperative launch failed: %s (grid %d)\n", hipGetErrorString(e), grid);
#else
#ifndef RUN_PHASES
#define RUN_PHASES N_PHASES
#endif
    for (int ph = 0; ph < RUN_PHASES; ++ph) {
        a.ph_lo = ph; a.ph_hi = ph + 1;
        hipLaunchKernelGGL(mk_fwd, dim3(grid), dim3(512), LDS_BYTES, stream, a);
    }
#endif
}
```

```cpp
#include <hip/hip_runtime.h>
#include <hip/hip_cooperative_groups.h>
#include <cstdio>
namespace cg = cooperative_groups;

#ifndef MK_ONE_LAUNCH
#define MK_ONE_LAUNCH 1
#endif

#define LAS __attribute__((address_space(3)))
typedef unsigned short bf16_t;
typedef short bf16x8 __attribute__((ext_vector_type(8)));
typedef float f32x4 __attribute__((ext_vector_type(4)));
typedef float f32x2 __attribute__((ext_vector_type(2)));
typedef unsigned u32x4 __attribute__((ext_vector_type(4)));
typedef unsigned u32x2 __attribute__((ext_vector_type(2)));

constexpr int DM = 1024, NBATCH = 8, SEQ = 4096, CTXL = 256, DEPTH = 2;
constexpr int NLAT = NBATCH * SEQ, NCTX = NBATCH * CTXL, MTOT = NLAT + NCTX;
constexpr int NIN = 3072, DFF = 4096, INW = 2848;
constexpr int C_QA = 0, C_KA = 512, C_VA = 1024, C_UA = 1536, C_UG = 1792, C_QG = 2048, C_KG = 2176, C_VG = 2304, C_RG = 2560, C_GF = 2816, C_GB = 2944;
constexpr float EPS = 1e-6f;
constexpr int NCHUNK = 68;
constexpr int NGU = NBATCH * NCHUNK * 4;

constexpr size_t WS_WTIN = 0;
constexpr size_t WS_WTOUT = WS_WTIN + (size_t)DEPTH * NIN * DM * 2;
constexpr size_t WS_WT1 = WS_WTOUT + (size_t)DEPTH * DM * DM * 2;
constexpr size_t WS_WT2 = WS_WT1 + (size_t)DEPTH * DFF * DM * 2;
constexpr size_t WS_WPW = WS_WT2 + (size_t)DEPTH * DFF * DM * 2;
constexpr size_t WS_MOD = WS_WPW + (size_t)DEPTH * 256 * 256 * 2;
constexpr size_t WS_ROPE = WS_MOD + (size_t)DEPTH * 9 * 6144 * 4;
constexpr size_t WS_H = WS_ROPE + 4096;
constexpr size_t WS_U = WS_H + (size_t)MTOT * DM * 2;
constexpr size_t WS_MIX = WS_U + (size_t)MTOT * NIN * 2;
constexpr size_t WS_XC = WS_MIX + (size_t)MTOT * DM * 2;
constexpr size_t WS_DST = WS_XC + (size_t)NCTX * DM * 4;
constexpr size_t WS_DEC = WS_DST + (size_t)NGU * 2 * 2048 * 4;
constexpr size_t WS_SIN = WS_DEC + (size_t)NGU * 2 * 32 * 4;
constexpr size_t WS_GQK = WS_SIN + (size_t)NGU * 2 * 2048 * 2;
constexpr size_t WS_GVT = WS_GQK + (size_t)NGU * 4 * 2048 * 2;
constexpr size_t WS_BAR = WS_GVT + (size_t)NGU * 4096 * 2;
constexpr size_t WS_END = WS_BAR + 16384;
static_assert(WS_END <= (size_t)512 * 1024 * 1024, "workspace too large");
constexpr int LDS_BYTES = 163840;

struct Args { const float* in[26]; float* out; unsigned char* ws; int ph_lo, ph_hi; };

__device__ __forceinline__ float bf2f(bf16_t b) { return __uint_as_float((unsigned)b << 16); }
__device__ __forceinline__ bf16_t f2bf(float f) { unsigned u = __float_as_uint(f); u += 0x7fffu + ((u >> 16) & 1u); return (bf16_t)(u >> 16); }
__device__ __forceinline__ unsigned cvt_pk_bf16(float lo, float hi) { unsigned r; asm volatile("v_cvt_pk_bf16_f32 %0, %1, %2" : "=v"(r) : "v"(lo), "v"(hi)); return r; }
__device__ __forceinline__ float sigmoidf_(float x) { return __builtin_amdgcn_rcpf(1.0f + __expf(-x)); }
__device__ __forceinline__ float siluf_(float x) { return x * __builtin_amdgcn_rcpf(1.0f + __expf(-x)); }
__device__ __forceinline__ float logsigmoidf_(float x) { return x < -30.f ? x : -__logf(1.0f + __expf(-x)); }
__device__ __forceinline__ f32x4 mfma16(bf16x8 a, bf16x8 b, f32x4 c) { return __builtin_amdgcn_mfma_f32_16x16x32_bf16(a, b, c, 0, 0, 0); }

__device__ __forceinline__ float wave_scan_incl(float x) {
    float t;
    t = __int_as_float(__builtin_amdgcn_update_dpp(0, __float_as_int(x), 0x111, 0xf, 0xf, true)); x += t;
    t = __int_as_float(__builtin_amdgcn_update_dpp(0, __float_as_int(x), 0x112, 0xf, 0xf, true)); x += t;
    t = __int_as_float(__builtin_amdgcn_update_dpp(0, __float_as_int(x), 0x114, 0xf, 0xf, true)); x += t;
    t = __int_as_float(__builtin_amdgcn_update_dpp(0, __float_as_int(x), 0x118, 0xf, 0xf, true)); x += t;
    t = __int_as_float(__builtin_amdgcn_update_dpp(0, __float_as_int(x), 0x142, 0xa, 0xf, false)); x += t;
    t = __int_as_float(__builtin_amdgcn_update_dpp(0, __float_as_int(x), 0x143, 0xc, 0xf, false)); x += t;
    return x;
}
#define SHX(x, m) __int_as_float(__builtin_amdgcn_ds_bpermute((F.lane ^ (m)) << 2, __float_as_int(x)))
namespace pg8 {
constexpr int BM = 256, BK = 64, HALF = 128, HTB = HALF * BK * 2, STAGE_BYTES = 8 * HTB, NXCD = 8, WGM = 8;
__host__ __device__ __forceinline__ int lds_byte(int r, int c) { const int st = (r >> 4) * 2 + (c >> 5), rr = r & 15, cc = c & 31, ob = rr * 64 + cc * 2; return st * 1024 + (ob ^ (((ob >> 9) & 1) << 5)); }
__host__ __device__ __forceinline__ void stage_rc(int b, int& R, int& C) { const int st = b / 1024, sb = b % 1024, swz = sb ^ (((sb >> 9) & 1) << 5); R = (st >> 1) * 16 + swz / 64; C = (st & 1) * 32 + (swz % 64) / 2; }
__host__ __device__ __forceinline__ int perm32(int rho) { const int n = rho >> 4, i = rho & 15; return 8 * (i >> 2) + 4 * n + (i & 3); }
struct Unit { int pm, pn, kt0, nt, split, sp; };
struct Gemm { const bf16_t* A; const bf16_t* Bt; int M, N, K; };
struct StaticOrder {
    int nM, nN, nwg, G, c, ntK, nsplit_tiles, ns;
    __device__ __forceinline__ void init(int M, int N, int G_, int c_, int K) { nM = M / BM; nN = N / BM; nwg = nM * nN; G = G_; c = c_; ntK = K / BK; nsplit_tiles = 0; ns = 1; }
    __device__ __forceinline__ void add_split(int ntiles, int ns_) { nsplit_tiles = ntiles; ns = ns_; }
    __device__ __forceinline__ bool next(int i, Unit& u) const {
        const long L = (long)i * G + c;
        const bool sp = L >= nwg;
        const int sidx = sp ? (int)(L - nwg) : 0;
        const bool ok = !sp || sidx < nsplit_tiles * ns;
        const int tile = sidx / ns, spi = sidx % ns;
        int wgid = sp ? 0 : (int)L; { const int q = nwg / NXCD, r = nwg % NXCD, xcd = wgid % NXCD, off = wgid / NXCD; wgid = (xcd < r ? xcd * (q + 1) : r * (q + 1) + (xcd - r) * q) + off; }
        const int nig = WGM * nN, gid = wgid / nig, fm = gid * WGM, gsz = (nM - fm) < WGM ? (nM - fm) : WGM;
        const int pm_f = fm + ((wgid % nig) % gsz), pn_f = (wgid % nig) / gsz;
        const int nts = ntK / ns;
        u.pm = sp ? nM + tile / nN : pm_f; u.pn = sp ? tile % nN : pn_f; u.nt = sp ? nts : ntK; u.kt0 = sp ? spi * nts : 0; u.split = sp ? 1 : 0; u.sp = spi;
        return ok;
    }
    __device__ __forceinline__ void a_ready(const Unit&) const {}
    __device__ __forceinline__ void done(const Unit&) const {}
};
template <int ACT  > struct EpiBf16 {
    static constexpr bool PERM = true;
    bf16_t* O; int ldc;
    __device__ __forceinline__ void operator()(const f32x4 (&acc)[2][2][4][2], const Unit& u, int wr, int wc, int fr, int fq) const {
        const int row0 = u.pm * BM + wr * 64 + fr; const int col0 = u.pn * BM + wc * 32 + 8 * fq;
#pragma unroll
        for (int ai = 0; ai < 2; ++ai)
#pragma unroll
            for (int m = 0; m < 4; ++m) { bf16_t* rowp = O + (size_t)(row0 + ai * HALF + m * 16) * ldc + col0;
#pragma unroll
                for (int bj = 0; bj < 2; ++bj) { f32x4 v0 = acc[ai][bj][m][0], v1 = acc[ai][bj][m][1];
                    if (ACT == 1) {
#pragma unroll
                        for (int j = 0; j < 4; ++j) { float a = fmaxf(v0[j], 0.f), b = fmaxf(v1[j], 0.f); v0[j] = a * a; v1[j] = b * b; } }
                    u32x4 w; w.x = cvt_pk_bf16(v0[0], v0[1]); w.y = cvt_pk_bf16(v0[2], v0[3]); w.z = cvt_pk_bf16(v1[0], v1[1]); w.w = cvt_pk_bf16(v1[2], v1[3]);
                    *(u32x4*)(rowp + bj * HALF) = w; } }
    }
};
struct EpiResid {
    static constexpr bool PERM = false;
    const float* base_lat; const float* base_ctx; float* out_lat; float* out_ctx; const float* mod; int goff; float* part;
    __device__ __forceinline__ void operator()(const f32x4 (&acc)[2][2][4][2], const Unit& u, int wr, int wc, int fr, int fq) const {
        const bool lat = u.pm < (NLAT / BM);
        const float* bp = lat ? base_lat + (size_t)u.pm * BM * DM : base_ctx + (size_t)(u.pm - NLAT / BM) * BM * DM;
        float* op = lat ? out_lat + (size_t)u.pm * BM * DM : out_ctx + (size_t)(u.pm - NLAT / BM) * BM * DM;
        const float* g = mod + (lat ? (u.pm >> 4) : 8) * 6144 + goff;
        const int col0 = u.pn * BM + wc * 32 + 4 * fq;
        f32x4 gv[2][2];
#pragma unroll
        for (int bj = 0; bj < 2; ++bj)
#pragma unroll
            for (int n = 0; n < 2; ++n) gv[bj][n] = *(const f32x4*)(g + col0 + bj * HALF + n * 16);
#pragma unroll
        for (int ai = 0; ai < 2; ++ai)
#pragma unroll
            for (int m = 0; m < 4; ++m) { const size_t ro = (size_t)(wr * 64 + fr + ai * HALF + m * 16) * DM + col0;
#pragma unroll
                for (int bj = 0; bj < 2; ++bj)
#pragma unroll
                    for (int n = 0; n < 2; ++n) {
                        if (u.split) *(f32x4*)(part + (size_t)u.sp * NCTX * DM + (size_t)(u.pm - NLAT / BM) * BM * DM + ro + bj * HALF + n * 16) = gv[bj][n] * acc[ai][bj][m][n];
                        else { const f32x4 bs = *(const f32x4*)(bp + ro + bj * HALF + n * 16); *(f32x4*)(op + ro + bj * HALF + n * 16) = bs + gv[bj][n] * acc[ai][bj][m][n]; } }
                asm volatile("" ::: "memory"); }
    }
};

template <class Epi, class Sched>
__device__ __forceinline__ void gemm_phase(LAS unsigned char* lds, const int tid, const Gemm g, const Sched& S, const Epi& E) {
    const int wid = __builtin_amdgcn_readfirstlane(tid >> 6), lane = tid & 63, wr = wid >> 2, wc = wid & 3, fr = lane & 15, fq = lane >> 4;
    const int K = g.K;
    unsigned voffA[2], voffB[2];
#pragma unroll
    for (int i = 0; i < 2; ++i) { int R, C; stage_rc(tid * 16 + i * 8192, R, C); const int Rb = Epi::PERM ? ((R & ~31) + perm32(R & 31)) : R;
        voffA[i] = (unsigned)(R * K + C) * 2u; voffB[i] = (unsigned)(Rb * K + C) * 2u; }
    const size_t kstep = (size_t)(BK * 2);
    const size_t hstep = (size_t)HALF * K * 2;
    const size_t tstep = 2 * hstep;
    const unsigned ldsw = (unsigned)wid * 1024u;
    const int aoff = lds_byte(wr * 64 + fr, fq * 8), boff = lds_byte(wc * 32 + fr, fq * 8);
#define PG8_SA(b, h) (((b) * 2 + (h)) * HTB)
#define PG8_SB(b, h) ((4 + (b) * 2 + (h)) * HTB)
#define PG8_STAGE(bufoff, gbase, voff) do { _Pragma("unroll") for (int _i = 0; _i < 2; ++_i) \
        __builtin_amdgcn_global_load_lds((const unsigned*)((const char*)(gbase) + (voff)[_i]), (LAS unsigned*)(lds + (bufoff) + ldsw + _i * 8192), 16, 0, 0); } while (0)
#define PG8_LDA(dst, b, h) do { _Pragma("unroll") for (int m = 0; m < 4; ++m) _Pragma("unroll") for (int k = 0; k < 2; ++k) dst[m][k] = *(const LAS bf16x8*)(lds + PG8_SA(b, h) + aoff + m * 2048 + k * 1024); } while (0)
#define PG8_LDB(dst, b, h) do { _Pragma("unroll") for (int n = 0; n < 2; ++n) _Pragma("unroll") for (int k = 0; k < 2; ++k) dst[n][k] = *(const LAS bf16x8*)(lds + PG8_SB(b, h) + boff + n * 2048 + k * 1024); } while (0)
#define PG8_MMA(ai, bj, At, Bt) do { __builtin_amdgcn_s_setprio(1); _Pragma("unroll") for (int m = 0; m < 4; ++m) _Pragma("unroll") for (int n = 0; n < 2; ++n) _Pragma("unroll") for (int k = 0; k < 2; ++k) \
        acc[ai][bj][m][n] = __builtin_amdgcn_mfma_f32_16x16x32_bf16(Bt[n][k], At[m][k], acc[ai][bj][m][n], 0, 0, 0); __builtin_amdgcn_s_setprio(0); } while (0)
#define PG8_WAIT_V(n) asm volatile("s_waitcnt vmcnt(" #n ")" ::: "memory")
#define PG8_WAIT_L(n) asm volatile("s_waitcnt lgkmcnt(" #n ")" ::: "memory")
#define PG8_BAR __builtin_amdgcn_s_barrier()
#define PG8_SCHED __builtin_amdgcn_sched_barrier(0)
    Unit cur, nxt; int ui = 0;
    if (!S.next(0, cur)) return;
    f32x4 acc[2][2][4][2];
#pragma unroll
    for (int a = 0; a < 2; ++a)
#pragma unroll
        for (int b = 0; b < 2; ++b)
#pragma unroll
            for (int m = 0; m < 4; ++m)
#pragma unroll
                for (int n = 0; n < 2; ++n) acc[a][b][m][n] = (f32x4){0.f, 0.f, 0.f, 0.f};
    bf16x8 At[4][2], B0[2][2], B1[2][2];
    const char* cA = (const char*)g.A + (size_t)cur.pm * tstep + (size_t)cur.kt0 * kstep; const char* cB = (const char*)g.Bt + (size_t)cur.pn * tstep + (size_t)cur.kt0 * kstep;
    S.a_ready(cur);
    PG8_STAGE(PG8_SB(0, 0), cB, voffB); PG8_STAGE(PG8_SA(0, 0), cA, voffA); PG8_STAGE(PG8_SB(0, 1), cB + hstep, voffB); PG8_STAGE(PG8_SA(0, 1), cA + hstep, voffA);
    if (wr == 1) PG8_BAR;
    PG8_WAIT_V(4); PG8_BAR;
    PG8_STAGE(PG8_SB(1, 0), cB + kstep, voffB); PG8_STAGE(PG8_SA(1, 0), cA + kstep, voffA); PG8_STAGE(PG8_SB(1, 1), cB + hstep + kstep, voffB);
    PG8_WAIT_V(6); PG8_BAR;
    for (;;) {
        const bool has_next = S.next(ui + 1, nxt);
        const char* nA = has_next ? (const char*)g.A + (size_t)nxt.pm * tstep + (size_t)nxt.kt0 * kstep : cA; const char* nB = has_next ? (const char*)g.Bt + (size_t)nxt.pn * tstep + (size_t)nxt.kt0 * kstep : cB;
        const int nt = cur.nt;
        for (int t = 0; t < nt; t += 2) {
            const bool last = (t == nt - 2);
            const char* a1 = cA + (size_t)(t + 1) * kstep;
            const char* a2 = last ? nA : cA + (size_t)(t + 2) * kstep; const char* b2 = last ? nB : cB + (size_t)(t + 2) * kstep;
            const char* a3 = a2 + kstep; const char* b3 = b2 + kstep;
            if (last && has_next) S.a_ready(nxt);
            PG8_LDB(B0, 0, 0); PG8_SCHED; PG8_LDA(At, 0, 0); PG8_STAGE(PG8_SA(1, 1), a1 + hstep, voffA);
            PG8_WAIT_L(8); PG8_BAR; PG8_WAIT_L(0); PG8_MMA(0, 0, At, B0); PG8_BAR; PG8_SCHED;
            PG8_LDB(B1, 0, 1); PG8_STAGE(PG8_SB(0, 0), b2, voffB);
            PG8_BAR; PG8_WAIT_L(0); PG8_MMA(0, 1, At, B1); PG8_BAR;
            PG8_LDA(At, 0, 1); PG8_STAGE(PG8_SA(0, 0), a2, voffA);
            PG8_BAR; PG8_WAIT_L(0); PG8_MMA(1, 0, At, B0); PG8_BAR; PG8_SCHED;
            PG8_STAGE(PG8_SB(0, 1), b2 + hstep, voffB);
            PG8_WAIT_V(6); PG8_BAR; PG8_MMA(1, 1, At, B1); PG8_BAR;
            PG8_LDB(B0, 1, 0); PG8_SCHED; PG8_LDA(At, 1, 0); PG8_STAGE(PG8_SA(0, 1), a2 + hstep, voffA);
            PG8_WAIT_L(8); PG8_BAR; PG8_WAIT_L(0); PG8_MMA(0, 0, At, B0); PG8_BAR; PG8_SCHED;
            PG8_LDB(B1, 1, 1); PG8_STAGE(PG8_SB(1, 0), b3, voffB);
            PG8_BAR; PG8_WAIT_L(0); PG8_MMA(0, 1, At, B1); PG8_BAR;
            PG8_LDA(At, 1, 1); PG8_STAGE(PG8_SA(1, 0), a3, voffA);
            PG8_BAR; PG8_WAIT_L(0); PG8_MMA(1, 0, At, B0); PG8_BAR; PG8_SCHED;
            PG8_STAGE(PG8_SB(1, 1), b3 + hstep, voffB);
            PG8_WAIT_V(6); PG8_BAR; PG8_MMA(1, 1, At, B1); PG8_BAR;
        }
        E(acc, cur, wr, wc, fr, fq); S.done(cur);
        if (!has_next) break;
#pragma unroll
        for (int a = 0; a < 2; ++a)
#pragma unroll
            for (int b = 0; b < 2; ++b)
#pragma unroll
                for (int m = 0; m < 4; ++m)
#pragma unroll
                    for (int n = 0; n < 2; ++n) acc[a][b][m][n] = (f32x4){0.f, 0.f, 0.f, 0.f};
        cur = nxt; cA = nA; cB = nB; ++ui;
    }
    PG8_WAIT_V(0);
    if (wr == 0) PG8_BAR;
    PG8_BAR;
#undef PG8_SA
#undef PG8_SB
#undef PG8_STAGE
#undef PG8_LDA
#undef PG8_LDB
#undef PG8_MMA
#undef PG8_WAIT_V
#undef PG8_WAIT_L
#undef PG8_BAR
#undef PG8_SCHED
}
}

typedef const float* fptr_t;
struct Frame {
    LAS unsigned char* lds; int tid, lane, wave, G, bid;
    const __attribute__((address_space(4))) fptr_t* inp; float* out; unsigned char* ws;
    __device__ __forceinline__ const float* IN(int i) const { return inp[i]; }
    bf16_t *WtIn, *WtOut, *Wt1, *Wt2, *Wpw, *H, *U, *MIX, *HID, *SinT;
    float *mod, *rope, *XC, *dST, *dec;
    bf16_t *GQK, *GVT;
};

__device__ __forceinline__ void frame_derive(Frame& F) {
    unsigned char* ws = F.ws;
    F.lane = F.tid & 63; F.wave = __builtin_amdgcn_readfirstlane(F.tid >> 6);
    F.WtIn = (bf16_t*)(ws + WS_WTIN); F.WtOut = (bf16_t*)(ws + WS_WTOUT); F.Wt1 = (bf16_t*)(ws + WS_WT1); F.Wt2 = (bf16_t*)(ws + WS_WT2); F.Wpw = (bf16_t*)(ws + WS_WPW);
    F.mod = (float*)(ws + WS_MOD); F.rope = (float*)(ws + WS_ROPE); F.H = (bf16_t*)(ws + WS_H); F.U = (bf16_t*)(ws + WS_U); F.MIX = (bf16_t*)(ws + WS_MIX); F.HID = (bf16_t*)(ws + WS_U);
    F.XC = (float*)(ws + WS_XC); F.dST = (float*)(ws + WS_DST); F.dec = (float*)(ws + WS_DEC); F.SinT = (bf16_t*)(ws + WS_SIN); F.GQK = (bf16_t*)(ws + WS_GQK); F.GVT = (bf16_t*)(ws + WS_GVT);
}
__device__ __forceinline__ void frame_refresh(Frame& F) {
    asm volatile("" : "+v"(F.tid)); asm volatile("" : "+s"(F.ws), "+s"(F.out), "+s"(F.inp), "+s"(F.bid), "+s"(F.G), "+s"(F.lds));
    frame_derive(F);
}
__device__ __forceinline__ void transpose_tile(Frame& F, const float* src, int lds_, int k0, int n0, bf16_t* dst, int ldd) {
    LAS float* T = (LAS float*)F.lds;
    const int r = F.tid >> 4, c4 = (F.tid & 15) * 4;
#pragma unroll
    for (int p = 0; p < 2; ++p) { const int rr = r + p * 32; const f32x4 v = *(const f32x4*)(src + (size_t)(k0 + rr) * lds_ + n0 + c4);
        T[rr * 65 + c4] = v[0]; T[rr * 65 + c4 + 1] = v[1]; T[rr * 65 + c4 + 2] = v[2]; T[rr * 65 + c4 + 3] = v[3]; }
    __syncthreads();
    const int n = F.tid >> 3, kk = (F.tid & 7) * 8;
    u32x4 w;
    w.x = cvt_pk_bf16(T[(kk + 0) * 65 + n], T[(kk + 1) * 65 + n]); w.y = cvt_pk_bf16(T[(kk + 2) * 65 + n], T[(kk + 3) * 65 + n]);
    w.z = cvt_pk_bf16(T[(kk + 4) * 65 + n], T[(kk + 5) * 65 + n]); w.w = cvt_pk_bf16(T[(kk + 6) * 65 + n], T[(kk + 7) * 65 + n]);
    *(u32x4*)(dst + (size_t)(n0 + n) * ldd + k0 + kk) = w;
    __syncthreads();
}

__device__ __forceinline__ void ada_tile(Frame& F, int l, int cgp) {
    LAS float* sc = (LAS float*)F.lds;
    LAS float* red = (LAS float*)(F.lds + 36864);
    const float* c = F.IN(1); const float* cc = F.IN(3);
    for (int i = F.tid; i < 9216; i += 512) { const int j = i >> 10, k = i & 1023; const float v = j < 8 ? c[j * 1024 + k] : cc[k]; sc[i] = siluf_(v); }
    __syncthreads();
    const int n0 = cgp * 64;
    const float* w = F.IN(4) + (size_t)l * 1024 * 6144 + n0 + F.lane;
    float acc[9];
#pragma unroll
    for (int j = 0; j < 9; ++j) acc[j] = 0.f;
    const int kb = F.wave * 128;
#pragma unroll 8
    for (int k = 0; k < 128; ++k) { const float wv = w[(size_t)(kb + k) * 6144];
#pragma unroll
        for (int j = 0; j < 9; ++j) acc[j] += sc[j * 1024 + kb + k] * wv; }
#pragma unroll
    for (int j = 0; j < 9; ++j) red[(F.wave * 9 + j) * 64 + F.lane] = acc[j];
    __syncthreads();
    for (int i = F.tid; i < 576; i += 512) { const int j = i >> 6, col = i & 63; float s = F.IN(5)[l * 6144 + n0 + col];
#pragma unroll
        for (int w8 = 0; w8 < 8; ++w8) s += red[(w8 * 9 + j) * 64 + col];
        F.mod[(size_t)(l * 9 + j) * 6144 + n0 + col] = s; }
    __syncthreads();
}

__device__ __forceinline__ void gate_tile(Frame& F, int l, int kb) {
    const int k = kb * 64 + (F.tid & 63);
    const float* wrow = F.IN(7) + ((size_t)l * 1024 + k) * INW + 2816;
    float z[32];
#pragma unroll
    for (int i = 0; i < 8; ++i) { const f32x4 v = *(const f32x4*)(wrow + 4 * i); z[4 * i] = v[0]; z[4 * i + 1] = v[1]; z[4 * i + 2] = v[2]; z[4 * i + 3] = v[3]; }
    for (int idx = 0; idx < 32; ++idx) {
        const int n = (F.tid >> 6) + 8 * idx, dir = n >> 7, nn = n & 127;
        const float* gw = (dir ? F.IN(19) : F.IN(17)) + (size_t)l * 16 * 128 + nn;
        float s = 0.f;
        if (dir == 0) {
#pragma unroll
            for (int r = 0; r < 16; ++r) s += z[r] * gw[r * 128];
        } else {
#pragma unroll
            for (int r = 0; r < 16; ++r) s += z[16 + r] * gw[r * 128];
        }
        F.WtIn[((size_t)l * NIN + 2816 + n) * DM + k] = f2bf(s);
    }
}

__device__ void phase_setup(Frame& F) {
    constexpr int N_ADA = 192, N_GATE = 32, N_ROPE = 1, TPL = 704 + 256 + 1024 + 1024 + 16, N_TR = 2 * TPL;
    constexpr int N_ITEMS = N_ADA + N_GATE + N_ROPE + N_TR;
    for (int it = F.bid; it < N_ITEMS; it += F.G) {
        frame_refresh(F);
        if (it < N_ADA) { ada_tile(F, it / 96, it % 96); continue; }
        int i = it - N_ADA;
        if (i < N_GATE) { gate_tile(F, i >> 4, i & 15); continue; }
        i -= N_GATE;
        if (i < N_ROPE) {
            const int p = F.tid >> 3, f = F.tid & 7;
            const float inv = powf(10000.0f, -(float)f / 8.0f); const float ang = (float)p * inv;
            F.rope[F.tid] = cosf(ang); F.rope[512 + F.tid] = sinf(ang);
            continue; }
        i -= N_ROPE;
        const int l = i / TPL; int j = i % TPL;
        if (j < 704) { transpose_tile(F, F.IN(7) + (size_t)l * DM * INW, INW, (j / 44) * 64, (j % 44) * 64, F.WtIn + (size_t)l * NIN * DM, DM); continue; }
        j -= 704;
        if (j < 256) { transpose_tile(F, F.IN(22) + (size_t)l * DM * DM, DM, (j / 16) * 64, (j % 16) * 64, F.WtOut + (size_t)l * DM * DM, DM); continue; }
        j -= 256;
        if (j < 1024) { transpose_tile(F, F.IN(24) + (size_t)l * DM * DFF, DFF, (j / 64) * 64, (j % 64) * 64, F.Wt1 + (size_t)l * DFF * DM, DM); continue; }
        j -= 1024;
        if (j < 1024) { transpose_tile(F, F.IN(25) + (size_t)l * DFF * DM, DM, (j / 16) * 64, (j % 16) * 64, F.Wt2 + (size_t)l * DM * DFF, DFF); continue; }
        j -= 1024;
        transpose_tile(F, F.IN(15) + (size_t)l * 65536, 256, (j / 4) * 64, (j % 4) * 64, F.Wpw + (size_t)l * 65536, 256);
    }
}

__device__ void phase_prep(Frame& F, const float* src_lat, const float* src_ctx, const float* modl, int off_sh, int off_sc, const float* gvec, int M, int nparts) {
    for (int row = F.bid * 8 + F.wave; row < M; row += F.G * 8) {
        const float* xp = row < NLAT ? src_lat + (size_t)row * DM : src_ctx + (size_t)(row - NLAT) * DM;
        const float* mp = modl + (row < NLAT ? (row >> 12) : 8) * 6144;
        f32x4 v[4]; float ss = 0.f;
#pragma unroll
        for (int i = 0; i < 4; ++i) { v[i] = *(const f32x4*)(xp + i * 256 + F.lane * 4);
            if (nparts > 0 && row >= NLAT) {
                const float* pp = F.dST + (size_t)(row - NLAT) * DM + i * 256 + F.lane * 4;
                for (int sp = 0; sp < nparts; ++sp) v[i] += *(const f32x4*)(pp + (size_t)sp * NCTX * DM);
                *(f32x4*)(F.XC + (size_t)(row - NLAT) * DM + i * 256 + F.lane * 4) = v[i]; }
            ss += v[i][0] * v[i][0] + v[i][1] * v[i][1] + v[i][2] * v[i][2] + v[i][3] * v[i][3]; }
#pragma unroll
        for (int o = 1; o < 64; o <<= 1) ss += SHX(ss, o);
        const float r = rsqrtf(ss * (1.0f / DM) + EPS);
#pragma unroll
        for (int i = 0; i < 4; ++i) { const int c = i * 256 + F.lane * 4;
            const f32x4 g = *(const f32x4*)(gvec + c), sh = *(const f32x4*)(mp + off_sh + c), sc = *(const f32x4*)(mp + off_sc + c);
            f32x4 y;
#pragma unroll
            for (int j = 0; j < 4; ++j) y[j] = v[i][j] * r * g[j] * (1.0f + sc[j]) + sh[j];
            u32x2 w; w.x = cvt_pk_bf16(y[0], y[1]); w.y = cvt_pk_bf16(y[2], y[3]);
            *(u32x2*)(F.H + (size_t)row * DM + c) = w; }
    }
}

constexpr int NSLOT = 11;
constexpr int VTL_STRIDE = NSLOT * 64 + 8, VTC_STRIDE = 264;
constexpr int NA_VTL = 0, NA_VTC = NA_VTL + 64 * VTL_STRIDE * 2, NA_RPB = NA_VTC + 64 * VTC_STRIDE * 2, NA_RKL = NA_RPB + 1920, NA_RKC = NA_RKL + NSLOT * 64 * 4, NA_GQ = NA_RKC + 1024, NA_KC = NA_GQ + 256, NA_END = NA_KC + 32768;
static_assert(NA_END <= LDS_BYTES - 16, "na lds");

__device__ __forceinline__ float sumsq8(bf16x8 v) { float s = 0.f;
#pragma unroll
    for (int i = 0; i < 8; ++i) { const float f = bf2f((bf16_t)v[i]); s += f * f; } return s; }

__device__ __forceinline__ void na_qfrag(Frame& F, int h, const bf16_t* qrowp, bf16x8 (&qf)[2]) {
    const int fq = F.lane >> 4;
    const bf16x8 q0 = *(const bf16x8*)(qrowp + C_QA + h * 64 + 8 * fq), q1 = *(const bf16x8*)(qrowp + C_QA + h * 64 + 32 + 8 * fq);
    float ss = sumsq8(q0) + sumsq8(q1); ss += SHX(ss, 16); ss += SHX(ss, 32);
    const float rq = rsqrtf(ss * (1.0f / 64.0f) + EPS);
    LAS float* GQ = (LAS float*)(F.lds + NA_GQ);
    const f32x4 g0 = *(const LAS f32x4*)(GQ + 8 * fq), g1 = *(const LAS f32x4*)(GQ + 8 * fq + 4), g2 = *(const LAS f32x4*)(GQ + 32 + 8 * fq), g3 = *(const LAS f32x4*)(GQ + 36 + 8 * fq);
#pragma unroll
    for (int i = 0; i < 4; ++i) {
        qf[0][i] = (short)f2bf(bf2f((bf16_t)q0[i]) * rq * g0[i]); qf[0][4 + i] = (short)f2bf(bf2f((bf16_t)q0[4 + i]) * rq * g1[i]);
        qf[1][i] = (short)f2bf(bf2f((bf16_t)q1[i]) * rq * g2[i]); qf[1][4 + i] = (short)f2bf(bf2f((bf16_t)q1[4 + i]) * rq * g3[i]); }
}

template <bool LOCAL>
__device__ __forceinline__ void na_wave(Frame& F, int h, const bf16x8 (&qf)[2], const bf16_t* kbase  ,
                                        int qb, int kc0, int ro0, LAS bf16_t* VT, int vstride, int vrow0, f32x4 (&o)[4], float& mrow, float& lrow) {
    constexpr int ntile = 16, tile_base = 0;
    const int fr = F.lane & 15, fq = F.lane >> 4;
    const unsigned klane = (unsigned)(fr * NIN + C_KA + h * 64 + 8 * fq);
    bf16x8 kb[4][2][2];
#define NA_LOADB(bi, buf) do { _Pragma("unroll") for (int tt = 0; tt < 2; ++tt) { const int t_ = (bi) * 2 + tt; if (t_ < ntile) { \
        const bf16_t* tbp = LOCAL ? kbase + (size_t)((t_ >> 1) * 64 + (t_ & 1) * 16) * NIN : kbase + (size_t)((tile_base + t_) * 16) * NIN; \
        if (LOCAL) { kb[buf][tt][0] = *(const bf16x8*)(tbp + klane); kb[buf][tt][1] = *(const bf16x8*)(tbp + klane + 32); } \
        else { kb[buf][tt][0] = *(const LAS bf16x8*)(F.lds + NA_KC + ((t_ * 2) * 64 + F.lane) * 16); kb[buf][tt][1] = *(const LAS bf16x8*)(F.lds + NA_KC + ((t_ * 2 + 1) * 64 + F.lane) * 16); } } } } while (0)
    if (LOCAL) { NA_LOADB(0, 0); NA_LOADB(1, 1); NA_LOADB(2, 2); }
    LAS float* rpb = (LAS float*)(F.lds + NA_RPB);
    LAS float* RKL = (LAS float*)(F.lds + NA_RKL); LAS float* RKC = (LAS float*)(F.lds + NA_RKC);
    int bo[2][4];
    if (LOCAL) {
        const int qcol = 16 * qb + fr; int cs = qcol - 8; cs = cs < 0 ? 0 : (cs > 48 ? 48 : cs);
#pragma unroll
        for (int hc = 0; hc < 2; ++hc)
#pragma unroll
            for (int j = 0; j < 4; ++j) { const int keycol = kc0 + 16 * hc + 4 * fq + j; bo[hc][j] = (keycol >= cs && keycol < cs + 16) ? keycol - qcol + 15 : 31; }
    }
    f32x4 sc[16];
#pragma unroll
    for (int bi = 0; bi < 8; ++bi) {
        asm volatile("" ::: "memory");
        if (LOCAL && bi + 3 < 8) NA_LOADB(bi + 3, (bi + 3) & 3);
        asm volatile("" ::: "memory");
#pragma unroll
        for (int tt = 0; tt < 2; ++tt) {
            const int t = bi * 2 + tt;
            sc[t] = (f32x4){-1e30f, -1e30f, -1e30f, -1e30f};
            if (t < ntile) {
                const f32x4 rk = LOCAL ? *(const LAS f32x4*)(RKL + ((vrow0 + (t >> 1)) % NSLOT) * 64 + kc0 + 16 * (t & 1) + 4 * fq) : *(const LAS f32x4*)(RKC + (tile_base + t) * 16 + 4 * fq);
                f32x4 a = (f32x4){0.f, 0.f, 0.f, 0.f};
                if (LOCAL) { a = mfma16(kb[bi & 3][tt][0], qf[0], a); a = mfma16(kb[bi & 3][tt][1], qf[1], a); }
                else { a = mfma16(*(const LAS bf16x8*)(F.lds + NA_KC + ((t * 2) * 64 + F.lane) * 16), qf[0], a); a = mfma16(*(const LAS bf16x8*)(F.lds + NA_KC + ((t * 2 + 1) * 64 + F.lane) * 16), qf[1], a); }
#pragma unroll
                for (int j = 0; j < 4; ++j) {
                    float sv = a[j] * rk[j];
                    if (LOCAL) sv += rpb[(ro0 + (t >> 1)) * 32 + bo[t & 1][j]];
                    sc[t][j] = sv;
                }
            }
        }
    }
#undef NA_LOADB
    {
        float m = -1e30f;
#pragma unroll
        for (int t = 0; t < 16; ++t) m = fmaxf(fmaxf(fmaxf(m, sc[t][0]), fmaxf(sc[t][1], sc[t][2])), sc[t][3]);
        m = fmaxf(m, SHX(m, 16)); m = fmaxf(m, SHX(m, 32));
        float sm = 0.f;
#pragma unroll
        for (int t = 0; t < 16; ++t)
#pragma unroll
            for (int j = 0; j < 4; ++j) { const float p = __builtin_amdgcn_exp2f(sc[t][j] - m); sc[t][j] = p; sm += p; }
        sm += SHX(sm, 16); sm += SHX(sm, 32);
        mrow = m; lrow = sm;
    }
    int vo[LOCAL ? 1 : 2][2][4];
#pragma unroll
    for (int par = 0; par < (LOCAL ? 1 : 2); ++par)
#pragma unroll
        for (int hc = 0; hc < 2; ++hc)
#pragma unroll
            for (int nb = 0; nb < 4; ++nb) { const int d = nb * 16 + fr;
                vo[par][hc][nb] = d * vstride + (((LOCAL ? kc0 : 32 * par) + 16 * hc + 4 * fq) ^ (((d >> 3) & 7) << 3)) + (LOCAL ? 0 : tile_base * 16);
                asm volatile("" : "+v"(vo[par][hc][nb])); }
#pragma unroll
    for (int nb = 0; nb < 4; ++nb) o[nb] = (f32x4){0.f, 0.f, 0.f, 0.f};
#pragma unroll
    for (int ks = 0; ks < 8; ++ks) {
        if (2 * ks < ntile) {
            union { bf16x8 v; unsigned u[4]; } pb;
            pb.u[0] = cvt_pk_bf16(sc[2 * ks][0], sc[2 * ks][1]); pb.u[1] = cvt_pk_bf16(sc[2 * ks][2], sc[2 * ks][3]);
            pb.u[2] = cvt_pk_bf16(sc[2 * ks + 1][0], sc[2 * ks + 1][1]); pb.u[3] = cvt_pk_bf16(sc[2 * ks + 1][2], sc[2 * ks + 1][3]);
            const int kso = LOCAL ? ((vrow0 + ks) % NSLOT) * 64 : (ks >> 1) * 64;
#pragma unroll
            for (int nb = 0; nb < 4; ++nb) {
                union { bf16x8 v; u32x2 h2[2]; } va;
                va.h2[0] = *(const LAS u32x2*)(VT + vo[LOCAL ? 0 : (ks & 1)][0][nb] + kso);
                va.h2[1] = *(const LAS u32x2*)(VT + vo[LOCAL ? 0 : (ks & 1)][1][nb] + kso);
                o[nb] = mfma16(va.v, pb.v, o[nb]); }
        }
    }
}

__device__ __forceinline__ void stage_ctx(Frame& F, const bf16_t* ctx0, int h, int l) {
    LAS bf16_t* VTC = (LAS bf16_t*)(F.lds + NA_VTC); LAS float* RKC = (LAS float*)(F.lds + NA_RKC);
    if (F.tid < 64) ((LAS float*)(F.lds + NA_GQ))[F.tid] = F.IN(8)[l * 64 + F.tid] * F.IN(9)[l * 64 + F.tid] * (0.125f * 1.4426950408889634f);
#pragma unroll
    for (int it = 0; it < 4; ++it) {
        const int item = it * 512 + F.tid, key = item >> 3, dg = item & 7;
        const bf16x8 v = *(const bf16x8*)(ctx0 + (size_t)key * NIN + C_VA + h * 64 + dg * 8);
        const bf16x8 kk = *(const bf16x8*)(ctx0 + (size_t)key * NIN + C_KA + h * 64 + dg * 8);
        const int kx = key ^ (dg << 3);
#pragma unroll
        for (int i = 0; i < 8; ++i) VTC[(dg * 8 + i) * VTC_STRIDE + kx] = (bf16_t)v[i];
        *(LAS bf16x8*)(F.lds + NA_KC + ((((key >> 4) * 2 + (dg >> 2)) * 64) + (dg & 3) * 16 + (key & 15)) * 16) = kk;
        float ss = sumsq8(kk); ss += SHX(ss, 1); ss += SHX(ss, 2); ss += SHX(ss, 4);
        if (dg == 0) RKC[key] = rsqrtf(ss * (1.0f / 64.0f) + EPS);
    }
}

__device__ __forceinline__ void na_store(Frame& F, int h, int qrow0, const f32x4 (&o)[4], float inv) {
    const int fr = F.lane & 15, fq = F.lane >> 4;
    bf16_t* op = F.MIX + (size_t)(qrow0 + fr) * DM + h * 64 + 4 * fq;
#pragma unroll
    for (int nb = 0; nb < 4; ++nb) { const f32x4 r = o[nb] * inv; u32x2 w; w.x = cvt_pk_bf16(r[0], r[1]); w.y = cvt_pk_bf16(r[2], r[3]); *(u32x2*)(op + nb * 16) = w; }
}

__device__ __forceinline__ void na_band(Frame& F, int l, int unit, bool stage_shared) {
    const int qb = F.wave & 3, half = F.wave >> 2;
    const int b = unit >> 6, h = (unit >> 3) & 7, R = (unit & 7) * 8;
    LAS bf16_t* VTL = (LAS bf16_t*)(F.lds + NA_VTL); LAS bf16_t* VTC = (LAS bf16_t*)(F.lds + NA_VTC); LAS float* RKL = (LAS float*)(F.lds + NA_RKL);
    const bf16_t* lat = F.U + (size_t)(b * SEQ) * NIN; const bf16_t* ctx0 = F.U + (size_t)(NLAT + b * CTXL) * NIN;
    const int skey = F.tid >> 3, sdg = F.tid & 7, skx = skey ^ (sdg << 3);
    const bf16_t* vsrc = lat + (size_t)skey * NIN + C_VA + h * 64 + sdg * 8;
    const bf16_t* ksrc = lat + (size_t)skey * NIN + C_KA + h * 64 + sdg * 8;
#define NA_R0(r_) ((r_) - 4 < 0 ? 0 : ((r_) - 4 > 56 ? 56 : (r_) - 4))
    int hi = NA_R0(R + 1) + 7;
    {
        for (int krow = NA_R0(R); krow <= hi; ++krow) { const bf16x8 v = *(const bf16x8*)(vsrc + (size_t)krow * 64 * NIN), kk = *(const bf16x8*)(ksrc + (size_t)krow * 64 * NIN);
            LAS bf16_t* dst = VTL + (sdg * 8) * VTL_STRIDE + (krow % NSLOT) * 64 + skx;
#pragma unroll
            for (int i = 0; i < 8; ++i) dst[i * VTL_STRIDE] = (bf16_t)v[i];
            float ss = sumsq8(kk); ss += SHX(ss, 1); ss += SHX(ss, 2); ss += SHX(ss, 4);
            if (sdg == 0) RKL[(krow % NSLOT) * 64 + skey] = rsqrtf(ss * (1.0f / 64.0f) + EPS); }
        if (stage_shared) stage_ctx(F, ctx0, h, l);
        LAS float* rpb = (LAS float*)(F.lds + NA_RPB); const float* src = F.IN(10) + ((size_t)l * 8 + h) * 465; if (stage_shared && F.tid < 480) { const int rr_ = F.tid >> 5, cc_ = F.tid & 31; rpb[F.tid] = cc_ < 31 ? src[rr_ * 31 + cc_] * 1.4426950408889634f : -1e30f; }
    }
    __syncthreads();
    int kc0 = 16 * qb - 8; kc0 = kc0 < 0 ? 0 : (kc0 > 32 ? 32 : kc0);
    for (int it2 = 0; it2 < 4; ++it2) {
        asm volatile("" : "+v"(F.lane)); const bf16_t* ctxp = ctx0; asm volatile("" : "+s"(ctxp));
        const int rA = R + 2 * it2, r = rA + half, r0 = NA_R0(r);
        int newhi = it2 < 3 ? NA_R0(rA + 3) + 7 : hi; newhi = newhi > 63 ? 63 : newhi;
        const int nnew = newhi - hi;
        bf16x8 pv0 = (bf16x8){0, 0, 0, 0, 0, 0, 0, 0}, pv1 = pv0, pk0 = pv0, pk1 = pv0;
        if (nnew > 0) { pv0 = *(const bf16x8*)(vsrc + (size_t)(hi + 1) * 64 * NIN); pk0 = *(const bf16x8*)(ksrc + (size_t)(hi + 1) * 64 * NIN); }
        if (nnew > 1) { pv1 = *(const bf16x8*)(vsrc + (size_t)(hi + 2) * 64 * NIN); pk1 = *(const bf16x8*)(ksrc + (size_t)(hi + 2) * 64 * NIN); }
        const int fr = F.lane & 15;
        const int qrow0 = b * SEQ + r * 64 + 16 * qb;
        bf16x8 qf[2];
        na_qfrag(F, h, F.U + (size_t)(qrow0 + fr) * NIN, qf);
        f32x4 oacc[4]; float mrun = -1e30f, lrun = 0.f;
#pragma unroll
        for (int nb = 0; nb < 4; ++nb) oacc[nb] = (f32x4){0.f, 0.f, 0.f, 0.f};
#pragma unroll 1
        for (int ph2 = 0; ph2 < 2; ++ph2) {
            asm volatile("" : "+v"(F.lane) :: "memory");
            f32x4 o[4]; float m1, l1;
            if (ph2 == 0) na_wave<false>(F, h, qf, ctxp, qb, 0, 0, VTC, VTC_STRIDE, 0, o, m1, l1);
            else {
                if (nnew > 0) { const int slot = (hi + 1) % NSLOT; LAS bf16_t* dst = VTL + (sdg * 8) * VTL_STRIDE + slot * 64 + skx;
#pragma unroll
                    for (int i = 0; i < 8; ++i) dst[i * VTL_STRIDE] = (bf16_t)pv0[i];
                    float ss = sumsq8(pk0); ss += SHX(ss, 1); ss += SHX(ss, 2); ss += SHX(ss, 4);
                    if (sdg == 0) RKL[slot * 64 + skey] = rsqrtf(ss * (1.0f / 64.0f) + EPS); }
                if (nnew > 1) { const int slot = (hi + 2) % NSLOT; LAS bf16_t* dst = VTL + (sdg * 8) * VTL_STRIDE + slot * 64 + skx;
#pragma unroll
                    for (int i = 0; i < 8; ++i) dst[i * VTL_STRIDE] = (bf16_t)pv1[i];
                    float ss = sumsq8(pk1); ss += SHX(ss, 1); ss += SHX(ss, 2); ss += SHX(ss, 4);
                    if (sdg == 0) RKL[slot * 64 + skey] = rsqrtf(ss * (1.0f / 64.0f) + EPS); }
                na_wave<true>(F, h, qf, lat + (size_t)(r0 * 64 + kc0) * NIN, qb, kc0, r0 - r + 7, VTL, VTL_STRIDE, r0, o, m1, l1);
            }
            const float M = fmaxf(mrun, m1), a1 = __builtin_amdgcn_exp2f(mrun - M), a2 = __builtin_amdgcn_exp2f(m1 - M);
#pragma unroll
            for (int nb = 0; nb < 4; ++nb) oacc[nb] = oacc[nb] * a1 + o[nb] * a2;
            lrun = lrun * a1 + l1 * a2; mrun = M;
        }
        na_store(F, h, qrow0, oacc, 1.0f / lrun);
        hi = newhi;
        __syncthreads();
    }
#undef NA_R0
}

__device__ __forceinline__ void na_ctx_unit(Frame& F, int l, int u2) {
    const int fr = F.lane & 15;
    const int b = u2 >> 4, qblk = (u2 >> 3) & 1, h = u2 & 7;
    LAS bf16_t* VTC = (LAS bf16_t*)(F.lds + NA_VTC);
    const bf16_t* ctx0 = F.U + (size_t)(NLAT + b * CTXL) * NIN;
    stage_ctx(F, ctx0, h, l);
    __syncthreads();
    const int qrow0 = NLAT + b * CTXL + qblk * 128 + 16 * F.wave;
    bf16x8 qf[2];
    na_qfrag(F, h, F.U + (size_t)(qrow0 + fr) * NIN, qf);
    f32x4 o[4]; float m1, l1;
    na_wave<false>(F, h, qf, ctx0, 0, 0, 0, VTC, VTC_STRIDE, 0, o, m1, l1);
    na_store(F, h, qrow0, o, 1.0f / l1);
    __syncthreads();
}

constexpr int CV_G = 0, CV_ACT = 65536, CV_END = 96256;
static_assert(CV_ACT + 64 * 264 * 2 <= LDS_BYTES, "conv lds");
__device__ __forceinline__ void conv_unit(Frame& F, int l, int unit) {
    const int fr = F.lane & 15, fq = F.lane >> 4;
    int row0, seq0, seqn;
    if (unit < 512) { row0 = unit * 64; seq0 = (unit >> 6) * SEQ; seqn = SEQ; } else { const int u2 = unit - 512; row0 = NLAT + u2 * 64; seq0 = NLAT + (u2 >> 2) * CTXL; seqn = CTXL; }
    LAS float* G = (LAS float*)(F.lds + CV_G);
    for (int item = F.tid; item < 94 * 32; item += 512) {
        const int i = item >> 5, c8 = (item & 31) * 8; const int row = row0 - 15 + i;
        f32x4 g0 = (f32x4){0.f, 0.f, 0.f, 0.f}, g1 = g0;
        if (row >= seq0 && row < seq0 + seqn) {
            const bf16x8 a = *(const bf16x8*)(F.U + (size_t)row * NIN + C_UA + c8), g = *(const bf16x8*)(F.U + (size_t)row * NIN + C_UG + c8);
#pragma unroll
            for (int e = 0; e < 4; ++e) { g0[e] = bf2f((bf16_t)a[e]) * sigmoidf_(bf2f((bf16_t)g[e])); g1[e] = bf2f((bf16_t)a[4 + e]) * sigmoidf_(bf2f((bf16_t)g[4 + e])); }
        }
        *(LAS f32x4*)(G + i * 256 + c8) = g0; *(LAS f32x4*)(G + i * 256 + c8 + 4) = g1;
    }
    __syncthreads();
    const int ch = F.tid & 255, tg = F.tid >> 8;
    float acc[32];
    {
        float w[31];
        const float* cw = F.IN(11) + (size_t)l * 31 * 256 + ch;
#pragma unroll
        for (int j = 0; j < 31; ++j) w[j] = cw[j * 256];
        const float cb = F.IN(12)[l * 256 + ch];
#pragma unroll
        for (int tb = 0; tb < 4; ++tb) {
            float xr[38];
#pragma unroll
            for (int i = 0; i < 38; ++i) xr[i] = G[(tg * 32 + tb * 8 + i) * 256 + ch];
#pragma unroll
            for (int o = 0; o < 8; ++o) { float a = cb;
#pragma unroll
                for (int j = 0; j < 31; ++j) a += w[j] * xr[o + j];
                acc[tb * 8 + o] = a; }
        }
    }
    __syncthreads();
#pragma unroll
    for (int t = 0; t < 32; ++t) G[(tg * 32 + t) * 256 + ch] = acc[t];
    __syncthreads();
    LAS bf16_t* ACT = (LAS bf16_t*)(F.lds + CV_ACT);
    {
        const f32x4 lg = *(const f32x4*)(F.IN(13) + l * 256 + F.lane * 4), lb = *(const f32x4*)(F.IN(14) + l * 256 + F.lane * 4);
#pragma unroll
        for (int tt = 0; tt < 8; ++tt) { const int t = F.wave * 8 + tt;
            const f32x4 v = *(const LAS f32x4*)(G + t * 256 + F.lane * 4);
            float s = v[0] + v[1] + v[2] + v[3];
#pragma unroll
            for (int o = 1; o < 64; o <<= 1) s += SHX(s, o);
            const float mu = s * (1.0f / 256.0f);
            const f32x4 dv = v - mu; float q = dv[0] * dv[0] + dv[1] * dv[1] + dv[2] * dv[2] + dv[3] * dv[3];
#pragma unroll
            for (int o = 1; o < 64; o <<= 1) q += SHX(q, o);
            const float rs = rsqrtf(q * (1.0f / 256.0f) + EPS);
            float y[4];
#pragma unroll
            for (int e = 0; e < 4; ++e) y[e] = siluf_(dv[e] * rs * lg[e] + lb[e]);
            u32x2 w; w.x = cvt_pk_bf16(y[0], y[1]); w.y = cvt_pk_bf16(y[2], y[3]);
            *(LAS u32x2*)(ACT + t * 264 + F.lane * 4) = w; }
    }
    __syncthreads();
    f32x4 o[4][2];
#pragma unroll
    for (int mb = 0; mb < 4; ++mb) { o[mb][0] = (f32x4){0.f, 0.f, 0.f, 0.f}; o[mb][1] = o[mb][0]; }
    const bf16_t* wp = F.Wpw + (size_t)l * 65536 + (size_t)(F.wave * 32 + fr) * 256 + 8 * fq;
#pragma unroll
    for (int ks = 0; ks < 8; ++ks) {
        const bf16x8 b0 = *(const bf16x8*)(wp + ks * 32), b1 = *(const bf16x8*)(wp + 16 * 256 + ks * 32);
#pragma unroll
        for (int mb = 0; mb < 4; ++mb) { const bf16x8 a = *(const LAS bf16x8*)(ACT + (mb * 16 + fr) * 264 + ks * 32 + 8 * fq);
            o[mb][0] = mfma16(b0, a, o[mb][0]); o[mb][1] = mfma16(b1, a, o[mb][1]); }
    }
#pragma unroll
    for (int nn = 0; nn < 2; ++nn) { const int n = F.wave * 32 + nn * 16 + 4 * fq; const f32x4 pb = *(const f32x4*)(F.IN(16) + l * 256 + n);
#pragma unroll
        for (int mb = 0; mb < 4; ++mb) { const f32x4 r = o[mb][nn] + pb; u32x2 w; w.x = cvt_pk_bf16(r[0], r[1]); w.y = cvt_pk_bf16(r[2], r[3]);
            *(u32x2*)(F.MIX + (size_t)(row0 + mb * 16 + fr) * DM + 512 + n) = w; } }
    __syncthreads();
}

struct GlaLd { bf16x8 af, ab, qo, qp, ko, kp, v0, v1; };
__device__ __forceinline__ void gla_unit_decode(int unit, int& b, int& cc, int& h, int& row0);
__device__ __forceinline__ void gla_load(Frame& F, int pair, GlaLd& g) {
    const int slot = F.wave >> 2, w4 = F.wave & 3, t4 = F.tid & 255;
    int b, cc, h, row0; gla_unit_decode(pair * 2 + slot, b, cc, h, row0);
    const bf16_t* rp = F.U + (size_t)(row0 + F.lane) * NIN;
    g.af = *(const bf16x8*)(rp + C_GF + h * 32 + 8 * w4); g.ab = *(const bf16x8*)(rp + C_GB + h * 32 + 8 * w4);
    g.qo = *(const bf16x8*)(rp + C_QG + h * 32 + 8 * w4); g.qp = *(const bf16x8*)(rp + C_QG + h * 32 + 8 * (w4 ^ 1));
    g.ko = *(const bf16x8*)(rp + C_KG + h * 32 + 8 * w4); g.kp = *(const bf16x8*)(rp + C_KG + h * 32 + 8 * (w4 ^ 1));
    g.v0 = *(const bf16x8*)(F.U + (size_t)(row0 + (t4 >> 3)) * NIN + C_VG + h * 64 + (t4 & 7) * 8);
    g.v1 = *(const bf16x8*)(F.U + (size_t)(row0 + 32 + (t4 >> 3)) * NIN + C_VG + h * 64 + (t4 & 7) * 8);
}
__device__ __forceinline__ void gla_prep(Frame& F, const GlaLd& g, int l, int b, int cc, int h, int row0, int w4, float (&qF)[8], float (&kF)[8], float (&qB)[8], float (&kB)[8], float (&totF)[8], float (&totB)[8]) {
    const int lane = F.lane;
    const bf16x8 af = g.af, ab = g.ab, qo = g.qo, qp = g.qp, ko = g.ko, kp = g.kp;
    const float* gbf = F.IN(18) + l * 128 + h * 32 + 8 * w4; const float* gbb = F.IN(20) + l * 128 + h * 32 + 8 * w4;
    const bool isctx = cc < 4;
    const int p = (w4 < 2) ? (cc - 4) : lane;
    const float qscale = 0.17677669529663687f;
#pragma unroll
    for (int i = 0; i < 8; ++i) {
        const float laf = logsigmoidf_(bf2f((bf16_t)af[i]) + gbf[i]) * (1.0f / 16.0f), lab = logsigmoidf_(bf2f((bf16_t)ab[i]) + gbb[i]) * (1.0f / 16.0f);
        const float cf = wave_scan_incl(laf), pb = wave_scan_incl(lab);
        totF[i] = __int_as_float(__builtin_amdgcn_readlane(__float_as_int(cf), 63)); totB[i] = __int_as_float(__builtin_amdgcn_readlane(__float_as_int(pb), 63));
        const float cb = totB[i] - pb + lab;
        float q = bf2f((bf16_t)qo[i]), k = bf2f((bf16_t)ko[i]);
        if (!isctx) {
            const float cs = F.rope[p * 8 + i], sn = F.rope[512 + p * 8 + i];
            const float q2 = bf2f((bf16_t)qp[i]), k2 = bf2f((bf16_t)kp[i]);
            if (w4 & 1) { q = q2 * sn + q * cs; k = k2 * sn + k * cs; } else { q = q * cs - q2 * sn; k = k * cs - k2 * sn; }
        }
        q *= qscale;
        const float ef = __expf(cf), eb = __expf(cb);
        qF[i] = q * ef; kF[i] = k * __expf(-cf); qB[i] = q * eb; kB[i] = k * __expf(-cb);
    }
}
__device__ __forceinline__ void gla_unit_decode(int unit, int& b, int& cc, int& h, int& row0) {
    h = unit & 3; const int t = unit >> 2; cc = t % NCHUNK; b = t / NCHUNK;
    row0 = cc < 4 ? NLAT + b * CTXL + cc * 64 : b * SEQ + (cc - 4) * 64;
}
__device__ __forceinline__ void gla_stage_vt(const GlaLd& g, LAS bf16_t* VT, int t4) {
    const int s = t4 >> 3, dg = t4 & 7;
#pragma unroll
    for (int i = 0; i < 8; ++i) { VT[(dg * 8 + i) * 72 + s] = (bf16_t)g.v0[i]; VT[(dg * 8 + i) * 72 + 32 + s] = (bf16_t)g.v1[i]; }
}

constexpr int GL_SLOT = 18432 + 256;
__device__ __forceinline__ void gla_local_pair(Frame& F, int l, int pair, const GlaLd& g) {
    const int fr = F.lane & 15, fq = F.lane >> 4;
    const int slot = F.wave >> 2, w4 = F.wave & 3, t4 = F.tid & 255;
    const int unit = pair * 2 + slot; int b, cc, h, row0; gla_unit_decode(unit, b, cc, h, row0);
    LAS unsigned char* sb = F.lds + slot * GL_SLOT;
    LAS bf16_t* KT[2] = {(LAS bf16_t*)sb, (LAS bf16_t*)(sb + 4608)}; LAS bf16_t* VT = (LAS bf16_t*)(sb + 9216); LAS float* TOT = (LAS float*)(sb + 18432);
    {
        float qF[8], kF[8], qB[8], kB[8], totF[8], totB[8];
        gla_prep(F, g, l, b, cc, h, row0, w4, qF, kF, qB, kB, totF, totB);
#pragma unroll
        for (int i = 0; i < 8; ++i) { KT[0][(8 * w4 + i) * 72 + F.lane] = f2bf(kF[i]); KT[1][(8 * w4 + i) * 72 + F.lane] = f2bf(kB[i]); }
        {
            bf16_t* gq = F.GQK + (size_t)unit * 8192 + F.lane * 32 + 8 * w4; u32x4 w;
            w.x = cvt_pk_bf16(qF[0], qF[1]); w.y = cvt_pk_bf16(qF[2], qF[3]); w.z = cvt_pk_bf16(qF[4], qF[5]); w.w = cvt_pk_bf16(qF[6], qF[7]); *(u32x4*)(gq) = w;
            w.x = cvt_pk_bf16(kF[0], kF[1]); w.y = cvt_pk_bf16(kF[2], kF[3]); w.z = cvt_pk_bf16(kF[4], kF[5]); w.w = cvt_pk_bf16(kF[6], kF[7]); *(u32x4*)(gq + 2048) = w;
            w.x = cvt_pk_bf16(qB[0], qB[1]); w.y = cvt_pk_bf16(qB[2], qB[3]); w.z = cvt_pk_bf16(qB[4], qB[5]); w.w = cvt_pk_bf16(qB[6], qB[7]); *(u32x4*)(gq + 4096) = w;
            w.x = cvt_pk_bf16(kB[0], kB[1]); w.y = cvt_pk_bf16(kB[2], kB[3]); w.z = cvt_pk_bf16(kB[4], kB[5]); w.w = cvt_pk_bf16(kB[6], kB[7]); *(u32x4*)(gq + 6144) = w;
        }
        if (F.lane == 0) {
#pragma unroll
            for (int i = 0; i < 8; ++i) { TOT[8 * w4 + i] = totF[i]; TOT[32 + 8 * w4 + i] = totB[i];
                F.dec[(size_t)(unit * 2 + 0) * 32 + 8 * w4 + i] = __expf(totF[i]); F.dec[(size_t)(unit * 2 + 1) * 32 + 8 * w4 + i] = __expf(totB[i]); } }
    }
    gla_stage_vt(g, VT, t4);
    __syncthreads();
    {
#pragma unroll
        for (int it2 = 0; it2 < 2; ++it2) { const int item = it2 * 256 + t4, dv = item >> 3, s8 = (item & 7) * 8;
            *(u32x4*)(F.GVT + (size_t)unit * 4096 + dv * 64 + s8) = *(const LAS u32x4*)(VT + dv * 72 + s8); }
    }
    const int dir = w4 >> 1, mb = w4 & 1;
    f32x4 acc[4];
#pragma unroll
    for (int nb = 0; nb < 4; ++nb) acc[nb] = (f32x4){0.f, 0.f, 0.f, 0.f};
#pragma unroll
    for (int ks = 0; ks < 2; ++ks) { const bf16x8 a = *(const LAS bf16x8*)(KT[dir] + (mb * 16 + fr) * 72 + ks * 32 + 8 * fq);
#pragma unroll
        for (int nb = 0; nb < 4; ++nb) { const bf16x8 vb = *(const LAS bf16x8*)(VT + (nb * 16 + fr) * 72 + ks * 32 + 8 * fq); acc[nb] = mfma16(a, vb, acc[nb]); } }
    f32x4 sc4;
#pragma unroll
    for (int j = 0; j < 4; ++j) sc4[j] = __expf(TOT[dir * 32 + mb * 16 + 4 * fq + j]);
#pragma unroll
    for (int nb = 0; nb < 4; ++nb) *(f32x4*)(F.dST + (size_t)(unit * 2 + dir) * 2048 + (nb * 16 + fr) * 32 + mb * 16 + 4 * fq) = acc[nb] * sc4;
    __syncthreads();
}

__device__ void phase_gla_scan(Frame& F) {
    for (int e = F.bid * 512 + F.tid; e < NBATCH * 4 * 2 * 2048; e += F.G * 512) {
        const int inner = e & 2047, dir = (e >> 11) & 1, h = (e >> 12) & 3, b = e >> 14, d = inner & 31;
        float S = 0.f;
#pragma unroll 4
        for (int step = 0; step < NCHUNK; ++step) {
            const int cc = dir == 0 ? step : (step < 4 ? 3 - step : 71 - step);
            const int unit = (b * NCHUNK + cc) * 4 + h; const size_t idx = (size_t)(unit * 2 + dir) * 2048 + inner;
            F.SinT[idx] = f2bf(S);
            S = F.dec[(size_t)(unit * 2 + dir) * 32 + d] * S + F.dST[idx];
        }
    }
}

__device__ __forceinline__ void gla_out_wave(Frame& F, int l, int unit, int tb) {
    const int fr = F.lane & 15, fq = F.lane >> 4;
    int b, cc, h, row0; gla_unit_decode(unit, b, cc, h, row0);
    LAS bf16_t* ATT = (LAS bf16_t*)(F.lds + F.wave * 2304);
    const bf16_t* gq = F.GQK + (size_t)unit * 8192; const bf16_t* gv = F.GVT + (size_t)unit * 4096;
    bf16x8 qa2[2], kb2[2][4], vb2[2][4], sb2[2][4];
#pragma unroll
    for (int dir = 0; dir < 2; ++dir) {
        qa2[dir] = *(const bf16x8*)(gq + dir * 4096 + (tb * 16 + fr) * 32 + 8 * fq);
#pragma unroll
        for (int sbk = 0; sbk < 4; ++sbk) { const bool valid = dir == 0 ? (sbk <= tb) : (sbk >= tb);
            kb2[dir][sbk] = valid ? *(const bf16x8*)(gq + dir * 4096 + 2048 + (sbk * 16 + fr) * 32 + 8 * fq) : (bf16x8){0, 0, 0, 0, 0, 0, 0, 0}; }
#pragma unroll
        for (int nb = 0; nb < 4; ++nb) sb2[dir][nb] = *(const bf16x8*)(F.SinT + (size_t)(unit * 2 + dir) * 2048 + (nb * 16 + fr) * 32 + 8 * fq);
    }
#pragma unroll
    for (int ks = 0; ks < 2; ++ks)
#pragma unroll
        for (int nb = 0; nb < 4; ++nb) vb2[ks][nb] = *(const bf16x8*)(gv + (nb * 16 + fr) * 64 + ks * 32 + 8 * fq);
    u32x2 rw4[4]; f32x4 og4[4];
    const size_t orow = (size_t)(row0 + tb * 16 + fr);
#pragma unroll
    for (int nb = 0; nb < 4; ++nb) { rw4[nb] = *(const u32x2*)(F.U + orow * NIN + C_RG + h * 64 + nb * 16 + 4 * fq); og4[nb] = *(const f32x4*)(F.IN(21) + l * 64 + nb * 16 + 4 * fq); }
    f32x4 o[4];
#pragma unroll
    for (int nb = 0; nb < 4; ++nb) o[nb] = (f32x4){0.f, 0.f, 0.f, 0.f};
#pragma unroll
    for (int dir = 0; dir < 2; ++dir) {
        const bf16x8 qa = qa2[dir];
#pragma unroll
        for (int sbk = 0; sbk < 4; ++sbk) {
            const bool valid = dir == 0 ? (sbk <= tb) : (sbk >= tb);
            f32x4 a = (f32x4){0.f, 0.f, 0.f, 0.f};
            if (valid) a = mfma16(qa, kb2[dir][sbk], a);
#pragma unroll
            for (int j = 0; j < 4; ++j) { float v = a[j];
                if (sbk == tb) { const bool keep = dir == 0 ? (fr <= 4 * fq + j) : (fr >= 4 * fq + j); v = keep ? v : 0.f; }
                ATT[(4 * fq + j) * 72 + sbk * 16 + fr] = f2bf(v); }
        }
        asm volatile("s_waitcnt lgkmcnt(0)" ::: "memory");
#pragma unroll
        for (int ks = 0; ks < 2; ++ks) { const bf16x8 pa = *(const LAS bf16x8*)(ATT + fr * 72 + ks * 32 + 8 * fq);
#pragma unroll
            for (int nb = 0; nb < 4; ++nb) o[nb] = mfma16(vb2[ks][nb], pa, o[nb]); }
#pragma unroll
        for (int nb = 0; nb < 4; ++nb) o[nb] = mfma16(sb2[dir][nb], qa, o[nb]);
        asm volatile("s_waitcnt lgkmcnt(0)" ::: "memory");
    }
    {
        float ss = 0.f;
#pragma unroll
        for (int nb = 0; nb < 4; ++nb) ss += o[nb][0] * o[nb][0] + o[nb][1] * o[nb][1] + o[nb][2] * o[nb][2] + o[nb][3] * o[nb][3];
        ss += SHX(ss, 16); ss += SHX(ss, 32);
        const float rinv = rsqrtf(ss * (1.0f / 64.0f) + EPS);
        const size_t row = (size_t)(row0 + tb * 16 + fr);
#pragma unroll
        for (int nb = 0; nb < 4; ++nb) { const int dv = nb * 16 + 4 * fq;
            const u32x2 rw = rw4[nb]; const f32x4 og = og4[nb];
            const float r0_ = __uint_as_float(rw.x << 16), r1_ = __uint_as_float(rw.x & 0xffff0000u), r2_ = __uint_as_float(rw.y << 16), r3_ = __uint_as_float(rw.y & 0xffff0000u);
            u32x2 w; w.x = cvt_pk_bf16(o[nb][0] * rinv * og[0] * siluf_(r0_), o[nb][1] * rinv * og[1] * siluf_(r1_));
            w.y = cvt_pk_bf16(o[nb][2] * rinv * og[2] * siluf_(r2_), o[nb][3] * rinv * og[3] * siluf_(r3_));
            *(u32x2*)(F.MIX + row * DM + 768 + h * 64 + dv) = w; }
    }
}

__device__ void phase_mixers(Frame& F, int l) {
    const int n_na = 512 + (l == 0 ? 128 : 0), n_cv = 512 + (l == 0 ? 32 : 0), n_gl = NGU / 2;
    for (int it = F.bid; it < n_na + n_cv; it += F.G) {
        frame_refresh(F);
        if (it < n_na) {
            if (it < 512) {
                const int wb = it & 255, second = it >> 8, rest = wb >> 3;
                na_band(F, l, ((wb & 7) << 6) | ((rest >> 2) << 3) | ((rest & 3) * 2 + second), second == 0 || F.G != 256);
            } else na_ctx_unit(F, l, it - 512); }
        else conv_unit(F, l, it - n_na);
    }
    const int base = n_na + n_cv;
    int it = base + ((F.bid - base % F.G) + F.G) % F.G;
    frame_refresh(F);
    GlaLd cur;
    if (it < base + n_gl) gla_load(F, it - base, cur);
    for (; it < base + n_gl; it += F.G) {
        frame_refresh(F);
        GlaLd nxt = cur;
        if (it + F.G < base + n_gl) gla_load(F, it + F.G - base, nxt);
        gla_local_pair(F, l, it - base, cur);
        cur = nxt;
    }
}
__device__ void phase_gla_out(Frame& F, int l) {
    const bool last = l == DEPTH - 1; const int nit = last ? NBATCH * 64 * 4 * 4 : NGU * 4;
    for (int it = F.bid * 8 + F.wave; it < nit; it += F.G * 8) {
        const int u = it >> 2, rem = u & 255;
        const int unit = last ? (((u >> 8) * NCHUNK + 4 + (rem >> 2)) * 4 + (rem & 3)) : u;
        gla_out_wave(F, l, unit, it & 3);
    }
}

#define XB_TMO      128
#define XB_XCNT(j)  (256  + 64 * (j))
#define XB_XSUB(j)  (1280 + 64 * (j))
#define XB_XGEN(j)  (2304 + 64 * (j))
#define XB_TOP      3328
#define XB_TOPGEN   3392
#define XCD_BAR_WORDS 3456
#define XB_SPIN_CAP (1u << 23)
__device__ __forceinline__ unsigned xb_ld(unsigned* p)              { return __hip_atomic_load(p, __ATOMIC_RELAXED, __HIP_MEMORY_SCOPE_AGENT); }
__device__ __forceinline__ unsigned xb_add(unsigned* p, unsigned v) { return __hip_atomic_fetch_add(p, v, __ATOMIC_RELAXED, __HIP_MEMORY_SCOPE_AGENT); }
__device__ __forceinline__ unsigned xb_xcc_id() { return (unsigned)__builtin_amdgcn_s_getreg((3 << 11) | 20) & 0xFu; }
#define XB_SPIN(cond, bar) do { unsigned _sp = 0; while (cond) { __builtin_amdgcn_s_sleep(1); \
    if ((++_sp & 255u) == 0u) { if (xb_ld(&(bar)[XB_TMO])) break; if (_sp > XB_SPIN_CAP) { atomicAdd(&(bar)[XB_TMO], 1u); break; } } } } while (0)
struct XcdBarrier { unsigned* bar; unsigned x; volatile LAS unsigned* st; };
__device__ __forceinline__ XcdBarrier xcd_barrier_post(unsigned* bar, volatile LAS unsigned* st) {
    XcdBarrier b; b.bar = bar; b.x = xb_xcc_id(); b.st = st;
    if (threadIdx.x == 0) (void)xb_add(&bar[XB_XCNT(b.x)], 1u);
    return b;
}
__device__ __forceinline__ void xcd_barrier_complete(unsigned* bar, unsigned x, unsigned& nloc, unsigned& nx) {
    const unsigned G = gridDim.x * gridDim.y * gridDim.z;
    unsigned sum, cnt, mine, sp = 0u;
    for (;;) {
        sum = 0u; cnt = 0u; mine = 0u;
#pragma unroll
        for (unsigned j = 0; j < 16; ++j) { const unsigned c = xb_ld(&bar[XB_XCNT(j)]); sum += c; cnt += (c > 0u) ? 1u : 0u; mine = (j == x) ? c : mine; }
        if (sum == G) break;
        __builtin_amdgcn_s_sleep(1);
        if ((++sp & 255u) == 0u) { if (xb_ld(&bar[XB_TMO])) break; if (sp > XB_SPIN_CAP) { atomicAdd(&bar[XB_TMO], 1u); break; } }
    }
    nloc = mine > 0u ? mine : 1u; nx = cnt > 0u ? cnt : 1u;
}
__device__ __forceinline__ void xcd_barrier(const XcdBarrier& b, const bool t0) {
    asm volatile("s_waitcnt vmcnt(0)" ::: "memory");
    __syncthreads();
    if (t0) {
        unsigned* bar = b.bar;
        __builtin_amdgcn_s_waitcnt(0);
        unsigned nloc = b.st[0], nx = b.st[1];
        if (nloc == 0u) { xcd_barrier_complete(bar, b.x, nloc, nx); b.st[0] = nloc; b.st[1] = nx; }
        const unsigned old = xb_add(&bar[XB_XSUB(b.x)], 1u);
        const unsigned gen = old / nloc;
        if (old + 1u == (gen + 1u) * nloc) {
            __builtin_amdgcn_fence(__ATOMIC_RELEASE, "agent");
            asm volatile("s_waitcnt vmcnt(0)" ::: "memory");
            const unsigned og = xb_add(&bar[XB_TOP], 1u);
            const unsigned tg = og / nx;
            if (og + 1u == (tg + 1u) * nx) xb_add(&bar[XB_TOPGEN], 1u);
            else XB_SPIN(xb_ld(&bar[XB_TOPGEN]) == tg, bar);
            __builtin_amdgcn_fence(__ATOMIC_ACQUIRE, "agent");
            xb_add(&bar[XB_XGEN(b.x)], 1u);
            asm volatile("s_waitcnt vmcnt(0)" ::: "memory");
        } else {
            XB_SPIN(xb_ld(&bar[XB_XGEN(b.x)]) == gen, bar);
            __builtin_amdgcn_fence(__ATOMIC_ACQUIRE, "agent");
            asm volatile("s_waitcnt vmcnt(0)" ::: "memory");
        }
    }
    __syncthreads();
}

constexpr int N_PHASES = 1 + 9 * DEPTH;

__device__ __forceinline__ void run_phase(Frame& F, int ph) {
#ifndef PH_MASK
#define PH_MASK 0x3ff
#endif
    if (ph == 0) { if (PH_MASK & 1) phase_setup(F); return; }
    const int l = (ph - 1) / 9, s = (ph - 1) % 9;
    const float* modl = F.mod + (size_t)l * 9 * 6144;
    const float* xlat = l == 0 ? F.IN(0) : F.out;
    const float* xctx = l == 0 ? F.IN(2) : F.XC;
    const int Mfull = l == 0 ? MTOT : NLAT;
    pg8::StaticOrder S;
    switch (s) {
    case 0: if (PH_MASK & 2) phase_prep(F, xlat, xctx, modl, 0, 1024, F.IN(6) + l * DM, MTOT, l == 0 ? 0 : 8); break;
    case 1: if (PH_MASK & 4) { pg8::Gemm g{F.H, F.WtIn + (size_t)l * NIN * DM, MTOT, NIN, DM}; S.init(MTOT, NIN, F.G, F.bid, DM); pg8::EpiBf16<0> E{F.U, NIN}; pg8::gemm_phase(F.lds, F.tid, g, S, E); } break;
    case 2: if (PH_MASK & 8) phase_mixers(F, l); break;
    case 3: if (PH_MASK & 16) phase_gla_scan(F); break;
    case 4: if (PH_MASK & 32) phase_gla_out(F, l); break;
    case 5: if (PH_MASK & 64) { pg8::Gemm g{F.MIX, F.WtOut + (size_t)l * DM * DM, Mfull, DM, DM}; S.init(NLAT, DM, F.G, F.bid, DM); if (l == 0) S.add_split(32, 4); pg8::EpiResid E{xlat, xctx, F.out, F.XC, modl, 2048, F.dST}; pg8::gemm_phase(F.lds, F.tid, g, S, E); } break;
    case 6: if (PH_MASK & 128) phase_prep(F, F.out, l == 0 ? xctx : F.XC, modl, 3072, 4096, F.IN(23) + l * DM, Mfull, l == 0 ? 4 : 0); break;
    case 7: if (PH_MASK & 256) { pg8::Gemm g{F.H, F.Wt1 + (size_t)l * DFF * DM, Mfull, DFF, DM}; S.init(Mfull, DFF, F.G, F.bid, DM); pg8::EpiBf16<1> E{F.HID, DFF}; pg8::gemm_phase(F.lds, F.tid, g, S, E); } break;
    case 8: if (PH_MASK & 512) { pg8::Gemm g{F.HID, F.Wt2 + (size_t)l * DM * DFF, Mfull, DM, DFF}; S.init(NLAT, DM, F.G, F.bid, DFF); if (l == 0) S.add_split(32, 8); pg8::EpiResid E{F.out, F.XC, F.out, F.XC, modl, 5120, F.dST}; pg8::gemm_phase(F.lds, F.tid, g, S, E); } break;
    }
}

__global__ void __launch_bounds__(512, 2) mk_fwd(Args args) {
    extern __shared__ __attribute__((aligned(16))) unsigned char lds_raw[];
    const int wave0 = __builtin_amdgcn_readfirstlane((int)threadIdx.x >> 6);
    volatile LAS unsigned* bst = (volatile LAS unsigned*)((LAS unsigned char*)lds_raw + LDS_BYTES - 16);
    if (threadIdx.x == 0) { bst[0] = 0u; bst[1] = 0u; }
    __syncthreads();
    XcdBarrier xbar; xbar.bar = (unsigned*)(args.ws + WS_BAR); xbar.x = 0; xbar.st = bst;
    if (args.ph_hi - args.ph_lo > 1) xbar = xcd_barrier_post((unsigned*)(args.ws + WS_BAR), bst);
    for (int step = args.ph_lo; step < args.ph_hi; ++step) {
        int ph = step;
#ifdef PROBE_KIND
        { const int P = PROBE_KIND == 9 ? 0 : 1 + PROBE_KIND, Q = PROBE_KIND == 9 ? 1000 : 10 + PROBE_KIND; ph = step - (step > P ? 1 : 0) - (step > Q + 1 ? 1 : 0); }
#endif
        if (step > args.ph_lo) { if (args.ph_hi < 0) cg::this_grid().sync();
            else { unsigned on2 = ~0u; asm volatile("" : "+s"(on2)); xcd_barrier(xbar, wave0 == 0 && __builtin_amdgcn_mbcnt_hi(on2, __builtin_amdgcn_mbcnt_lo(on2, 0u)) == 0u); } }
        Frame F;
        unsigned ones = ~0u; int w0 = wave0; asm volatile("" : "+s"(ones), "+s"(w0));
        int tid = w0 * 64 + (int)__builtin_amdgcn_mbcnt_hi(ones, __builtin_amdgcn_mbcnt_lo(ones, 0u)); asm volatile("" : "+v"(tid));
        int bid = blockIdx.x, G = gridDim.x; asm volatile("" : "+s"(bid), "+s"(G));
        unsigned char* ws = args.ws; float* out = args.out; asm volatile("" : "+s"(ws), "+s"(out));
        const __attribute__((address_space(4))) fptr_t* kp = (const __attribute__((address_space(4))) fptr_t*)__builtin_amdgcn_kernarg_segment_ptr(); asm volatile("" : "+s"(kp));
        { LAS unsigned char* lb = (LAS unsigned char*)lds_raw; asm volatile("" : "+s"(lb)); F.lds = lb; }
        F.tid = tid; F.lane = tid & 63; F.wave = __builtin_amdgcn_readfirstlane(tid >> 6); F.G = G; F.bid = bid;
        F.inp = kp; F.out = out; F.ws = ws;
        frame_derive(F);
        run_phase(F, ph);
    }
}

extern "C" void kernel_launch(void* const* d_in, const int* in_sizes, int n_in, void* d_out, int out_size, void* d_ws, size_t ws_size, hipStream_t stream) {
    static int grid = 0;
    if (grid == 0) {
        if (n_in != 26 || ws_size < WS_END) { fprintf(stderr, "kernel_launch: unexpected n_in %d or ws_size %zu (< %zu)\n", n_in, ws_size, (size_t)WS_END); grid = -1; return; }
        int dev = 0, cus = 0, per_cu = 0;
        hipGetDevice(&dev); hipDeviceGetAttribute(&cus, hipDeviceAttributeMultiprocessorCount, dev);
        if (hipFuncSetAttribute((const void*)mk_fwd, hipFuncAttributeMaxDynamicSharedMemorySize, LDS_BYTES) != hipSuccess) { fprintf(stderr, "kernel_launch: hipFuncSetAttribute failed\n"); grid = -1; return; }
        if (hipOccupancyMaxActiveBlocksPerMultiprocessor(&per_cu, (const void*)mk_fwd, 512, LDS_BYTES) != hipSuccess || per_cu < 1) { fprintf(stderr, "kernel_launch: occupancy query %d\n", per_cu); per_cu = 1; }
        (void)hipGetLastError();
        grid = cus;
    }
    if (grid < 0) return;
    Args a{};
    for (int i = 0; i < 26; ++i) a.in[i] = (const float*)d_in[i];
    a.out = (float*)d_out; a.ws = (unsigned char*)d_ws;
#if MK_ONE_LAUNCH
    if (hipMemsetAsync((char*)d_ws + WS_BAR, 0, 16384, stream) != hipSuccess) { fprintf(stderr, "kernel_launch: memset failed\n"); return; }
#ifdef PROBE_KIND
    a.ph_lo = 0; a.ph_hi = N_PHASES + (PROBE_KIND == 9 ? 1 : 2);
#else
    a.ph_lo = 0; a.ph_hi = N_PHASES;
#endif
    void* kargs[] = {&a};
    hipError_t e = hipLaunchCooperativeKernel((const void*)mk_fwd, dim3(grid), dim3(512), kargs, LDS_BYTES, stream);
    if (e != hipSuccess) fprintf(stderr, "cooperative launch failed: %s (grid %d)\n", hipGetErrorString(e), grid);
#else
#ifndef RUN_PHASES
#define RUN_PHASES N_PHASES
#endif
    for (int ph = 0; ph < RUN_PHASES; ++ph) {
        a.ph_lo = ph; a.ph_hi = ph + 1;
        hipLaunchKernelGGL(mk_fwd, dim3(grid), dim3(512), LDS_BYTES, stream, a);
    }
#endif
}
```

```cpp
#include <hip/hip_runtime.h>
#include <hip/hip_cooperative_groups.h>
#include <cstdio>
namespace cg = cooperative_groups;

#ifndef MK_ONE_LAUNCH
#define MK_ONE_LAUNCH 1
#endif

#define LAS __attribute__((address_space(3)))
typedef unsigned short bf16_t;
typedef short bf16x8 __attribute__((ext_vector_type(8)));
typedef float f32x4 __attribute__((ext_vector_type(4)));
typedef float f32x2 __attribute__((ext_vector_type(2)));
typedef unsigned u32x4 __attribute__((ext_vector_type(4)));
typedef unsigned u32x2 __attribute__((ext_vector_type(2)));

constexpr int DM = 1024, NBATCH = 8, SEQ = 4096, CTXL = 256, DEPTH = 2;
constexpr int NLAT = NBATCH * SEQ, NCTX = NBATCH * CTXL, MTOT = NLAT + NCTX;
constexpr int NIN = 3072, DFF = 4096, INW = 2848;
constexpr int C_QA = 0, C_KA = 512, C_VA = 1024, C_UA = 1536, C_UG = 1792, C_QG = 2048, C_KG = 2176, C_VG = 2304, C_RG = 2560, C_GF = 2816, C_GB = 2944;
constexpr float EPS = 1e-6f;
constexpr int NCHUNK = 68;
constexpr int NGU = NBATCH * NCHUNK * 4;

constexpr size_t WS_WTIN = 0;
constexpr size_t WS_WTOUT = WS_WTIN + (size_t)DEPTH * NIN * DM * 2;
constexpr size_t WS_WT1 = WS_WTOUT + (size_t)DEPTH * DM * DM * 2;
constexpr size_t WS_WT2 = WS_WT1 + (size_t)DEPTH * DFF * DM * 2;
constexpr size_t WS_WPW = WS_WT2 + (size_t)DEPTH * DFF * DM * 2;
constexpr size_t WS_MOD = WS_WPW + (size_t)DEPTH * 256 * 256 * 2;
constexpr size_t WS_ROPE = WS_MOD + (size_t)DEPTH * 9 * 6144 * 4;
constexpr size_t WS_H = WS_ROPE + 4096;
constexpr size_t WS_U = WS_H + (size_t)MTOT * DM * 2;
constexpr size_t WS_MIX = WS_U + (size_t)MTOT * NIN * 2;
constexpr size_t WS_XC = WS_MIX + (size_t)MTOT * DM * 2;
constexpr size_t WS_DST = WS_XC + (size_t)NCTX * DM * 4;
constexpr size_t WS_DEC = WS_DST + (size_t)NGU * 2 * 2048 * 4;
constexpr size_t WS_SIN = WS_DEC + (size_t)NGU * 2 * 32 * 4;
constexpr size_t WS_GQK = WS_SIN + (size_t)NGU * 2 * 2048 * 2;
constexpr size_t WS_GVT = WS_GQK + (size_t)NGU * 4 * 2048 * 2;
constexpr size_t WS_BAR = WS_GVT + (size_t)NGU * 4096 * 2;
constexpr size_t WS_END = WS_BAR + 16384;
static_assert(WS_END <= (size_t)512 * 1024 * 1024, "workspace too large");
constexpr int LDS_BYTES = 163840;

struct Args { const float* in[26]; float* out; unsigned char* ws; int ph_lo, ph_hi; };

__device__ __forceinline__ float bf2f(bf16_t b) { return __uint_as_float((unsigned)b << 16); }
__device__ __forceinline__ bf16_t f2bf(float f) { unsigned u = __float_as_uint(f); u += 0x7fffu + ((u >> 16) & 1u); return (bf16_t)(u >> 16); }
__device__ __forceinline__ unsigned cvt_pk_bf16(float lo, float hi) { unsigned r; asm volatile("v_cvt_pk_bf16_f32 %0, %1, %2" : "=v"(r) : "v"(lo), "v"(hi)); return r; }
__device__ __forceinline__ float sigmoidf_(float x) { return __builtin_amdgcn_rcpf(1.0f + __expf(-x)); }
__device__ __forceinline__ float siluf_(float x) { return x * __builtin_amdgcn_rcpf(1.0f + __expf(-x)); }
__device__ __forceinline__ float logsigmoidf_(float x) { return x < -30.f ? x : -__logf(1.0f + __expf(-x)); }
__device__ __forceinline__ f32x4 mfma16(bf16x8 a, bf16x8 b, f32x4 c) { return __builtin_amdgcn_mfma_f32_16x16x32_bf16(a, b, c, 0, 0, 0); }

__device__ __forceinline__ float wave_scan_incl(float x) {
    float t;
    t = __int_as_float(__builtin_amdgcn_update_dpp(0, __float_as_int(x), 0x111, 0xf, 0xf, true)); x += t;
    t = __int_as_float(__builtin_amdgcn_update_dpp(0, __float_as_int(x), 0x112, 0xf, 0xf, true)); x += t;
    t = __int_as_float(__builtin_amdgcn_update_dpp(0, __float_as_int(x), 0x114, 0xf, 0xf, true)); x += t;
    t = __int_as_float(__builtin_amdgcn_update_dpp(0, __float_as_int(x), 0x118, 0xf, 0xf, true)); x += t;
    t = __int_as_float(__builtin_amdgcn_update_dpp(0, __float_as_int(x), 0x142, 0xa, 0xf, false)); x += t;
    t = __int_as_float(__builtin_amdgcn_update_dpp(0, __float_as_int(x), 0x143, 0xc, 0xf, false)); x += t;
    return x;
}
#define SHX(x, m) __int_as_float(__builtin_amdgcn_ds_bpermute((F.lane ^ (m)) << 2, __float_as_int(x)))
namespace pg8 {
constexpr int BM = 256, BK = 64, HALF = 128, HTB = HALF * BK * 2, STAGE_BYTES = 8 * HTB, NXCD = 8, WGM = 8;
__host__ __device__ __forceinline__ int lds_byte(int r, int c) { const int st = (r >> 4) * 2 + (c >> 5), rr = r & 15, cc = c & 31, ob = rr * 64 + cc * 2; return st * 1024 + (ob ^ (((ob >> 9) & 1) << 5)); }
__host__ __device__ __forceinline__ void stage_rc(int b, int& R, int& C) { const int st = b / 1024, sb = b % 1024, swz = sb ^ (((sb >> 9) & 1) << 5); R = (st >> 1) * 16 + swz / 64; C = (st & 1) * 32 + (swz % 64) / 2; }
__host__ __device__ __forceinline__ int perm32(int rho) { const int n = rho >> 4, i = rho & 15; return 8 * (i >> 2) + 4 * n + (i & 3); }
struct Unit { int pm, pn, kt0, nt, split, sp; };
struct Gemm { const bf16_t* A; const bf16_t* Bt; int M, N, K; };
struct StaticOrder {
    int nM, nN, nwg, G, c, ntK, nsplit_tiles, ns;
    __device__ __forceinline__ void init(int M, int N, int G_, int c_, int K) { nM = M / BM; nN = N / BM; nwg = nM * nN; G = G_; c = c_; ntK = K / BK; nsplit_tiles = 0; ns = 1; }
    __device__ __forceinline__ void add_split(int ntiles, int ns_) { nsplit_tiles = ntiles; ns = ns_; }
    __device__ __forceinline__ bool next(int i, Unit& u) const {
        const long L = (long)i * G + c;
        const bool sp = L >= nwg;
        const int sidx = sp ? (int)(L - nwg) : 0;
        const bool ok = !sp || sidx < nsplit_tiles * ns;
        const int tile = sidx / ns, spi = sidx % ns;
        int wgid = sp ? 0 : (int)L; { const int q = nwg / NXCD, r = nwg % NXCD, xcd = wgid % NXCD, off = wgid / NXCD; wgid = (xcd < r ? xcd * (q + 1) : r * (q + 1) + (xcd - r) * q) + off; }
        const int nig = WGM * nN, gid = wgid / nig, fm = gid * WGM, gsz = (nM - fm) < WGM ? (nM - fm) : WGM;
        const int pm_f = fm + ((wgid % nig) % gsz), pn_f = (wgid % nig) / gsz;
        const int nts = ntK / ns;
        u.pm = sp ? nM + tile / nN : pm_f; u.pn = sp ? tile % nN : pn_f; u.nt = sp ? nts : ntK; u.kt0 = sp ? spi * nts : 0; u.split = sp ? 1 : 0; u.sp = spi;
        return ok;
    }
    __device__ __forceinline__ void a_ready(const Unit&) const {}
    __device__ __forceinline__ void done(const Unit&) const {}
};
template <int ACT  > struct EpiBf16 {
    static constexpr bool PERM = true;
    bf16_t* O; int ldc;
    __device__ __forceinline__ void operator()(const f32x4 (&acc)[2][2][4][2], const Unit& u, int wr, int wc, int fr, int fq) const {
        const int row0 = u.pm * BM + wr * 64 + fr; const int col0 = u.pn * BM + wc * 32 + 8 * fq;
#pragma unroll
        for (int ai = 0; ai < 2; ++ai)
#pragma unroll
            for (int m = 0; m < 4; ++m) { bf16_t* rowp = O + (size_t)(row0 + ai * HALF + m * 16) * ldc + col0;
#pragma unroll
                for (int bj = 0; bj < 2; ++bj) { f32x4 v0 = acc[ai][bj][m][0], v1 = acc[ai][bj][m][1];
                    if (ACT == 1) {
#pragma unroll
                        for (int j = 0; j < 4; ++j) { float a = fmaxf(v0[j], 0.f), b = fmaxf(v1[j], 0.f); v0[j] = a * a; v1[j] = b * b; } }
                    u32x4 w; w.x = cvt_pk_bf16(v0[0], v0[1]); w.y = cvt_pk_bf16(v0[2], v0[3]); w.z = cvt_pk_bf16(v1[0], v1[1]); w.w = cvt_pk_bf16(v1[2], v1[3]);
                    *(u32x4*)(rowp + bj * HALF) = w; } }
    }
};
struct EpiResid {
    static constexpr bool PERM = false;
    const float* base_lat; const float* base_ctx; float* out_lat; float* out_ctx; const float* mod; int goff; float* part;
    __device__ __forceinline__ void operator()(const f32x4 (&acc)[2][2][4][2], const Unit& u, int wr, int wc, int fr, int fq) const {
        const bool lat = u.pm < (NLAT / BM);
        const float* bp = lat ? base_lat + (size_t)u.pm * BM * DM : base_ctx + (size_t)(u.pm - NLAT / BM) * BM * DM;
        float* op = lat ? out_lat + (size_t)u.pm * BM * DM : out_ctx + (size_t)(u.pm - NLAT / BM) * BM * DM;
        const float* g = mod + (lat ? (u.pm >> 4) : 8) * 6144 + goff;
        const int col0 = u.pn * BM + wc * 32 + 4 * fq;
        f32x4 gv[2][2];
#pragma unroll
        for (int bj = 0; bj < 2; ++bj)
#pragma unroll
            for (int n = 0; n < 2; ++n) gv[bj][n] = *(const f32x4*)(g + col0 + bj * HALF + n * 16);
#pragma unroll
        for (int ai = 0; ai < 2; ++ai)
#pragma unroll
            for (int m = 0; m < 4; ++m) { const size_t ro = (size_t)(wr * 64 + fr + ai * HALF + m * 16) * DM + col0;
#pragma unroll
                for (int bj = 0; bj < 2; ++bj)
#pragma unroll
                    for (int n = 0; n < 2; ++n) {
                        if (u.split) *(f32x4*)(part + (size_t)u.sp * NCTX * DM + (size_t)(u.pm - NLAT / BM) * BM * DM + ro + bj * HALF + n * 16) = gv[bj][n] * acc[ai][bj][m][n];
                        else { const f32x4 bs = *(const f32x4*)(bp + ro + bj * HALF + n * 16); *(f32x4*)(op + ro + bj * HALF + n * 16) = bs + gv[bj][n] * acc[ai][bj][m][n]; } }
                asm volatile("" ::: "memory"); }
    }
};

template <class Epi, class Sched>
__device__ __forceinline__ void gemm_phase(LAS unsigned char* lds, const int tid, const Gemm g, const Sched& S, const Epi& E) {
    const int wid = __builtin_amdgcn_readfirstlane(tid >> 6), lane = tid & 63, wr = wid >> 2, wc = wid & 3, fr = lane & 15, fq = lane >> 4;
    const int K = g.K;
    unsigned voffA[2], voffB[2];
#pragma unroll
    for (int i = 0; i < 2; ++i) { int R, C; stage_rc(tid * 16 + i * 8192, R, C); const int Rb = Epi::PERM ? ((R & ~31) + perm32(R & 31)) : R;
        voffA[i] = (unsigned)(R * K + C) * 2u; voffB[i] = (unsigned)(Rb * K + C) * 2u; }
    const size_t kstep = (size_t)(BK * 2);
    const size_t hstep = (size_t)HALF * K * 2;
    const size_t tstep = 2 * hstep;
    const unsigned ldsw = (unsigned)wid * 1024u;
    const int aoff = lds_byte(wr * 64 + fr, fq * 8), boff = lds_byte(wc * 32 + fr, fq * 8);
#define PG8_SA(b, h) (((b) * 2 + (h)) * HTB)
#define PG8_SB(b, h) ((4 + (b) * 2 + (h)) * HTB)
#define PG8_STAGE(bufoff, gbase, voff) do { _Pragma("unroll") for (int _i = 0; _i < 2; ++_i) \
        __builtin_amdgcn_global_load_lds((const unsigned*)((const char*)(gbase) + (voff)[_i]), (LAS unsigned*)(lds + (bufoff) + ldsw + _i * 8192), 16, 0, 0); } while (0)
#define PG8_LDA(dst, b, h) do { _Pragma("unroll") for (int m = 0; m < 4; ++m) _Pragma("unroll") for (int k = 0; k < 2; ++k) dst[m][k] = *(const LAS bf16x8*)(lds + PG8_SA(b, h) + aoff + m * 2048 + k * 1024); } while (0)
#define PG8_LDB(dst, b, h) do { _Pragma("unroll") for (int n = 0; n < 2; ++n) _Pragma("unroll") for (int k = 0; k < 2; ++k) dst[n][k] = *(const LAS bf16x8*)(lds + PG8_SB(b, h) + boff + n * 2048 + k * 1024); } while (0)
#define PG8_MMA(ai, bj, At, Bt) do { __builtin_amdgcn_s_setprio(1); _Pragma("unroll") for (int m = 0; m < 4; ++m) _Pragma("unroll") for (int n = 0; n < 2; ++n) _Pragma("unroll") for (int k = 0; k < 2; ++k) \
        acc[ai][bj][m][n] = __builtin_amdgcn_mfma_f32_16x16x32_bf16(Bt[n][k], At[m][k], acc[ai][bj][m][n], 0, 0, 0); __builtin_amdgcn_s_setprio(0); } while (0)
#define PG8_WAIT_V(n) asm volatile("s_waitcnt vmcnt(" #n ")" ::: "memory")
#define PG8_WAIT_L(n) asm volatile("s_waitcnt lgkmcnt(" #n ")" ::: "memory")
#define PG8_BAR __builtin_amdgcn_s_barrier()
#define PG8_SCHED __builtin_amdgcn_sched_barrier(0)
    Unit cur, nxt; int ui = 0;
    if (!S.next(0, cur)) return;
    f32x4 acc[2][2][4][2];
#pragma unroll
    for (int a = 0; a < 2; ++a)
#pragma unroll
        for (int b = 0; b < 2; ++b)
#pragma unroll
            for (int m = 0; m < 4; ++m)
#pragma unroll
                for (int n = 0; n < 2; ++n) acc[a][b][m][n] = (f32x4){0.f, 0.f, 0.f, 0.f};
    bf16x8 At[4][2], B0[2][2], B1[2][2];
    const char* cA = (const char*)g.A + (size_t)cur.pm * tstep + (size_t)cur.kt0 * kstep; const char* cB = (const char*)g.Bt + (size_t)cur.pn * tstep + (size_t)cur.kt0 * kstep;
    S.a_ready(cur);
    PG8_STAGE(PG8_SB(0, 0), cB, voffB); PG8_STAGE(PG8_SA(0, 0), cA, voffA); PG8_STAGE(PG8_SB(0, 1), cB + hstep, voffB); PG8_STAGE(PG8_SA(0, 1), cA + hstep, voffA);
    if (wr == 1) PG8_BAR;
    PG8_WAIT_V(4); PG8_BAR;
    PG8_STAGE(PG8_SB(1, 0), cB + kstep, voffB); PG8_STAGE(PG8_SA(1, 0), cA + kstep, voffA); PG8_STAGE(PG8_SB(1, 1), cB + hstep + kstep, voffB);
    PG8_WAIT_V(6); PG8_BAR;
    for (;;) {
        const bool has_next = S.next(ui + 1, nxt);
        const char* nA = has_next ? (const char*)g.A + (size_t)nxt.pm * tstep + (size_t)nxt.kt0 * kstep : cA; const char* nB = has_next ? (const char*)g.Bt + (size_t)nxt.pn * tstep + (size_t)nxt.kt0 * kstep : cB;
        const int nt = cur.nt;
        for (int t = 0; t < nt; t += 2) {
            const bool last = (t == nt - 2);
            const char* a1 = cA + (size_t)(t + 1) * kstep;
            const char* a2 = last ? nA : cA + (size_t)(t + 2) * kstep; const char* b2 = last ? nB : cB + (size_t)(t + 2) * kstep;
            const char* a3 = a2 + kstep; const char* b3 = b2 + kstep;
            if (last && has_next) S.a_ready(nxt);
            PG8_LDB(B0, 0, 0); PG8_SCHED; PG8_LDA(At, 0, 0); PG8_STAGE(PG8_SA(1, 1), a1 + hstep, voffA);
            PG8_WAIT_L(8); PG8_BAR; PG8_WAIT_L(0); PG8_MMA(0, 0, At, B0); PG8_BAR; PG8_SCHED;
            PG8_LDB(B1, 0, 1); PG8_STAGE(PG8_SB(0, 0), b2, voffB);
            PG8_BAR; PG8_WAIT_L(0); PG8_MMA(0, 1, At, B1); PG8_BAR;
            PG8_LDA(At, 0, 1); PG8_STAGE(PG8_SA(0, 0), a2, voffA);
            PG8_BAR; PG8_WAIT_L(0); PG8_MMA(1, 0, At, B0); PG8_BAR; PG8_SCHED;
            PG8_STAGE(PG8_SB(0, 1), b2 + hstep, voffB);
            PG8_WAIT_V(6); PG8_BAR; PG8_MMA(1, 1, At, B1); PG8_BAR;
            PG8_LDB(B0, 1, 0); PG8_SCHED; PG8_LDA(At, 1, 0); PG8_STAGE(PG8_SA(0, 1), a2 + hstep, voffA);
            PG8_WAIT_L(8); PG8_BAR; PG8_WAIT_L(0); PG8_MMA(0, 0, At, B0); PG8_BAR; PG8_SCHED;
            PG8_LDB(B1, 1, 1); PG8_STAGE(PG8_SB(1, 0), b3, voffB);
            PG8_BAR; PG8_WAIT_L(0); PG8_MMA(0, 1, At, B1); PG8_BAR;
            PG8_LDA(At, 1, 1); PG8_STAGE(PG8_SA(1, 0), a3, voffA);
            PG8_BAR; PG8_WAIT_L(0); PG8_MMA(1, 0, At, B0); PG8_BAR; PG8_SCHED;
            PG8_STAGE(PG8_SB(1, 1), b3 + hstep, voffB);
            PG8_WAIT_V(6); PG8_BAR; PG8_MMA(1, 1, At, B1); PG8_BAR;
        }
        E(acc, cur, wr, wc, fr, fq); S.done(cur);
        if (!has_next) break;
#pragma unroll
        for (int a = 0; a < 2; ++a)
#pragma unroll
            for (int b = 0; b < 2; ++b)
#pragma unroll
                for (int m = 0; m < 4; ++m)
#pragma unroll
                    for (int n = 0; n < 2; ++n) acc[a][b][m][n] = (f32x4){0.f, 0.f, 0.f, 0.f};
        cur = nxt; cA = nA; cB = nB; ++ui;
    }
    PG8_WAIT_V(0);
    if (wr == 0) PG8_BAR;
    PG8_BAR;
#undef PG8_SA
#undef PG8_SB
#undef PG8_STAGE
#undef PG8_LDA
#undef PG8_LDB
#undef PG8_MMA
#undef PG8_WAIT_V
#undef PG8_WAIT_L
#undef PG8_BAR
#undef PG8_SCHED
}
}

typedef const float* fptr_t;
struct Frame {
    LAS unsigned char* lds; int tid, lane, wave, G, bid;
    const __attribute__((address_space(4))) fptr_t* inp; float* out; unsigned char* ws;
    __device__ __forceinline__ const float* IN(int i) const { return inp[i]; }
    bf16_t *WtIn, *WtOut, *Wt1, *Wt2, *Wpw, *H, *U, *MIX, *HID, *SinT;
    float *mod, *rope, *XC, *dST, *dec;
    bf16_t *GQK, *GVT;
};

__device__ __forceinline__ void frame_derive(Frame& F) {
    unsigned char* ws = F.ws;
    F.lane = F.tid & 63; F.wave = __builtin_amdgcn_readfirstlane(F.tid >> 6);
    F.WtIn = (bf16_t*)(ws + WS_WTIN); F.WtOut = (bf16_t*)(ws + WS_WTOUT); F.Wt1 = (bf16_t*)(ws + WS_WT1); F.Wt2 = (bf16_t*)(ws + WS_WT2); F.Wpw = (bf16_t*)(ws + WS_WPW);
    F.mod = (float*)(ws + WS_MOD); F.rope = (float*)(ws + WS_ROPE); F.H = (bf16_t*)(ws + WS_H); F.U = (bf16_t*)(ws + WS_U); F.MIX = (bf16_t*)(ws + WS_MIX); F.HID = (bf16_t*)(ws + WS_U);
    F.XC = (float*)(ws + WS_XC); F.dST = (float*)(ws + WS_DST); F.dec = (float*)(ws + WS_DEC); F.SinT = (bf16_t*)(ws + WS_SIN); F.GQK = (bf16_t*)(ws + WS_GQK); F.GVT = (bf16_t*)(ws + WS_GVT);
}
__device__ __forceinline__ void frame_refresh(Frame& F) {
    asm volatile("" : "+v"(F.tid)); asm volatile("" : "+s"(F.ws), "+s"(F.out), "+s"(F.inp), "+s"(F.bid), "+s"(F.G), "+s"(F.lds));
    frame_derive(F);
}
__device__ __forceinline__ void transpose_tile(Frame& F, const float* src, int lds_, int k0, int n0, bf16_t* dst, int ldd) {
    LAS float* T = (LAS float*)F.lds;
    const int r = F.tid >> 4, c4 = (F.tid & 15) * 4;
#pragma unroll
    for (int p = 0; p < 2; ++p) { const int rr = r + p * 32; const f32x4 v = *(const f32x4*)(src + (size_t)(k0 + rr) * lds_ + n0 + c4);
        T[rr * 65 + c4] = v[0]; T[rr * 65 + c4 + 1] = v[1]; T[rr * 65 + c4 + 2] = v[2]; T[rr * 65 + c4 + 3] = v[3]; }
    __syncthreads();
    const int n = F.tid >> 3, kk = (F.tid & 7) * 8;
    u32x4 w;
    w.x = cvt_pk_bf16(T[(kk + 0) * 65 + n], T[(kk + 1) * 65 + n]); w.y = cvt_pk_bf16(T[(kk + 2) * 65 + n], T[(kk + 3) * 65 + n]);
    w.z = cvt_pk_bf16(T[(kk + 4) * 65 + n], T[(kk + 5) * 65 + n]); w.w = cvt_pk_bf16(T[(kk + 6) * 65 + n], T[(kk + 7) * 65 + n]);
    *(u32x4*)(dst + (size_t)(n0 + n) * ldd + k0 + kk) = w;
    __syncthreads();
}

__device__ __forceinline__ void ada_tile(Frame& F, int l, int cgp) {
    LAS float* sc = (LAS float*)F.lds;
    LAS float* red = (LAS float*)(F.lds + 36864);
    const float* c = F.IN(1); const float* cc = F.IN(3);
    for (int i = F.tid; i < 9216; i += 512) { const int j = i >> 10, k = i & 1023; const float v = j < 8 ? c[j * 1024 + k] : cc[k]; sc[i] = siluf_(v); }
    __syncthreads();
    const int n0 = cgp * 64;
    const float* w = F.IN(4) + (size_t)l * 1024 * 6144 + n0 + F.lane;
    float acc[9];
#pragma unroll
    for (int j = 0; j < 9; ++j) acc[j] = 0.f;
    const int kb = F.wave * 128;
#pragma unroll 8
    for (int k = 0; k < 128; ++k) { const float wv = w[(size_t)(kb + k) * 6144];
#pragma unroll
        for (int j = 0; j < 9; ++j) acc[j] += sc[j * 1024 + kb + k] * wv; }
#pragma unroll
    for (int j = 0; j < 9; ++j) red[(F.wave * 9 + j) * 64 + F.lane] = acc[j];
    __syncthreads();
    for (int i = F.tid; i < 576; i += 512) { const int j = i >> 6, col = i & 63; float s = F.IN(5)[l * 6144 + n0 + col];
#pragma unroll
        for (int w8 = 0; w8 < 8; ++w8) s += red[(w8 * 9 + j) * 64 + col];
        F.mod[(size_t)(l * 9 + j) * 6144 + n0 + col] = s; }
    __syncthreads();
}

__device__ __forceinline__ void gate_tile(Frame& F, int l, int kb) {
    const int k = kb * 64 + (F.tid & 63);
    const float* wrow = F.IN(7) + ((size_t)l * 1024 + k) * INW + 2816;
    float z[32];
#pragma unroll
    for (int i = 0; i < 8; ++i) { const f32x4 v = *(const f32x4*)(wrow + 4 * i); z[4 * i] = v[0]; z[4 * i + 1] = v[1]; z[4 * i + 2] = v[2]; z[4 * i + 3] = v[3]; }
    for (int idx = 0; idx < 32; ++idx) {
        const int n = (F.tid >> 6) + 8 * idx, dir = n >> 7, nn = n & 127;
        const float* gw = (dir ? F.IN(19) : F.IN(17)) + (size_t)l * 16 * 128 + nn;
        float s = 0.f;
        if (dir == 0) {
#pragma unroll
            for (int r = 0; r < 16; ++r) s += z[r] * gw[r * 128];
        } else {
#pragma unroll
            for (int r = 0; r < 16; ++r) s += z[16 + r] * gw[r * 128];
        }
        F.WtIn[((size_t)l * NIN + 2816 + n) * DM + k] = f2bf(s);
    }
}

__device__ void phase_setup(Frame& F) {
    constexpr int N_ADA = 192, N_GATE = 32, N_ROPE = 1, TPL = 704 + 256 + 1024 + 1024 + 16, N_TR = 2 * TPL;
    constexpr int N_ITEMS = N_ADA + N_GATE + N_ROPE + N_TR;
    for (int it = F.bid; it < N_ITEMS; it += F.G) {
        frame_refresh(F);
        if (it < N_ADA) { ada_tile(F, it / 96, it % 96); continue; }
        int i = it - N_ADA;
        if (i < N_GATE) { gate_tile(F, i >> 4, i & 15); continue; }
        i -= N_GATE;
        if (i < N_ROPE) {
            const int p = F.tid >> 3, f = F.tid & 7;
            const float inv = powf(10000.0f, -(float)f / 8.0f); const float ang = (float)p * inv;
            F.rope[F.tid] = cosf(ang); F.rope[512 + F.tid] = sinf(ang);
            continue; }
        i -= N_ROPE;
        const int l = i / TPL; int j = i % TPL;
        if (j < 704) { transpose_tile(F, F.IN(7) + (size_t)l * DM * INW, INW, (j / 44) * 64, (j % 44) * 64, F.WtIn + (size_t)l * NIN * DM, DM); continue; }
        j -= 704;
        if (j < 256) { transpose_tile(F, F.IN(22) + (size_t)l * DM * DM, DM, (j / 16) * 64, (j % 16) * 64, F.WtOut + (size_t)l * DM * DM, DM); continue; }
        j -= 256;
        if (j < 1024) { transpose_tile(F, F.IN(24) + (size_t)l * DM * DFF, DFF, (j / 64) * 64, (j % 64) * 64, F.Wt1 + (size_t)l * DFF * DM, DM); continue; }
        j -= 1024;
        if (j < 1024) { transpose_tile(F, F.IN(25) + (size_t)l * DFF * DM, DM, (j / 16) * 64, (j % 16) * 64, F.Wt2 + (size_t)l * DM * DFF, DFF); continue; }
        j -= 1024;
        transpose_tile(F, F.IN(15) + (size_t)l * 65536, 256, (j / 4) * 64, (j % 4) * 64, F.Wpw + (size_t)l * 65536, 256);
    }
}

__device__ void phase_prep(Frame& F, const float* src_lat, const float* src_ctx, const float* modl, int off_sh, int off_sc, const float* gvec, int M, int nparts) {
    for (int row = F.bid * 8 + F.wave; row < M; row += F.G * 8) {
        const float* xp = row < NLAT ? src_lat + (size_t)row * DM : src_ctx + (size_t)(row - NLAT) * DM;
        const float* mp = modl + (row < NLAT ? (row >> 12) : 8) * 6144;
        f32x4 v[4]; float ss = 0.f;
#pragma unroll
        for (int i = 0; i < 4; ++i) { v[i] = *(const f32x4*)(xp + i * 256 + F.lane * 4);
            if (nparts > 0 && row >= NLAT) {
                const float* pp = F.dST + (size_t)(row - NLAT) * DM + i * 256 + F.lane * 4;
                for (int sp = 0; sp < nparts; ++sp) v[i] += *(const f32x4*)(pp + (size_t)sp * NCTX * DM);
                *(f32x4*)(F.XC + (size_t)(row - NLAT) * DM + i * 256 + F.lane * 4) = v[i]; }
            ss += v[i][0] * v[i][0] + v[i][1] * v[i][1] + v[i][2] * v[i][2] + v[i][3] * v[i][3]; }
#pragma unroll
        for (int o = 1; o < 64; o <<= 1) ss += SHX(ss, o);
        const float r = rsqrtf(ss * (1.0f / DM) + EPS);
#pragma unroll
        for (int i = 0; i < 4; ++i) { const int c = i * 256 + F.lane * 4;
            const f32x4 g = *(const f32x4*)(gvec + c), sh = *(const f32x4*)(mp + off_sh + c), sc = *(const f32x4*)(mp + off_sc + c);
            f32x4 y;
#pragma unroll
            for (int j = 0; j < 4; ++j) y[j] = v[i][j] * r * g[j] * (1.0f + sc[j]) + sh[j];
            u32x2 w; w.x = cvt_pk_bf16(y[0], y[1]); w.y = cvt_pk_bf16(y[2], y[3]);
            *(u32x2*)(F.H + (size_t)row * DM + c) = w; }
    }
}

constexpr int NSLOT = 11;
constexpr int VTL_STRIDE = NSLOT * 64 + 8, VTC_STRIDE = 264;
constexpr int NA_VTL = 0, NA_VTC = NA_VTL + 64 * VTL_STRIDE * 2, NA_RPB = NA_VTC + 64 * VTC_STRIDE * 2, NA_RKL = NA_RPB + 1920, NA_RKC = NA_RKL + NSLOT * 64 * 4, NA_GQ = NA_RKC + 1024, NA_KC = NA_GQ + 256, NA_END = NA_KC + 32768;
static_assert(NA_END <= LDS_BYTES - 16, "na lds");

__device__ __forceinline__ float sumsq8(bf16x8 v) { float s = 0.f;
#pragma unroll
    for (int i = 0; i < 8; ++i) { const float f = bf2f((bf16_t)v[i]); s += f * f; } return s; }

__device__ __forceinline__ void na_qfrag(Frame& F, int h, const bf16_t* qrowp, bf16x8 (&qf)[2]) {
    const int fq = F.lane >> 4;
    const bf16x8 q0 = *(const bf16x8*)(qrowp + C_QA + h * 64 + 8 * fq), q1 = *(const bf16x8*)(qrowp + C_QA + h * 64 + 32 + 8 * fq);
    float ss = sumsq8(q0) + sumsq8(q1); ss += SHX(ss, 16); ss += SHX(ss, 32);
    const float rq = rsqrtf(ss * (1.0f / 64.0f) + EPS);
    LAS float* GQ = (LAS float*)(F.lds + NA_GQ);
    const f32x4 g0 = *(const LAS f32x4*)(GQ + 8 * fq), g1 = *(const LAS f32x4*)(GQ + 8 * fq + 4), g2 = *(const LAS f32x4*)(GQ + 32 + 8 * fq), g3 = *(const LAS f32x4*)(GQ + 36 + 8 * fq);
#pragma unroll
    for (int i = 0; i < 4; ++i) {
        qf[0][i] = (short)f2bf(bf2f((bf16_t)q0[i]) * rq * g0[i]); qf[0][4 + i] = (short)f2bf(bf2f((bf16_t)q0[4 + i]) * rq * g1[i]);
        qf[1][i] = (short)f2bf(bf2f((bf16_t)q1[i]) * rq * g2[i]); qf[1][4 + i] = (short)f2bf(bf2f((bf16_t)q1[4 + i]) * rq * g3[i]); }
}

template <bool LOCAL>
__device__ __forceinline__ void na_wave(Frame& F, int h, const bf16x8 (&qf)[2], const bf16_t* kbase  ,
                                        int qb, int kc0, int ro0, LAS bf16_t* VT, int vstride, int vrow0, f32x4 (&o)[4], float& mrow, float& lrow) {
    constexpr int ntile = 16, tile_base = 0;
    const int fr = F.lane & 15, fq = F.lane >> 4;
    const unsigned klane = (unsigned)(fr * NIN + C_KA + h * 64 + 8 * fq);
    bf16x8 kb[4][2][2];
#define NA_LOADB(bi, buf) do { _Pragma("unroll") for (int tt = 0; tt < 2; ++tt) { const int t_ = (bi) * 2 + tt; if (t_ < ntile) { \
        const bf16_t* tbp = LOCAL ? kbase + (size_t)((t_ >> 1) * 64 + (t_ & 1) * 16) * NIN : kbase + (size_t)((tile_base + t_) * 16) * NIN; \
        if (LOCAL) { kb[buf][tt][0] = *(const bf16x8*)(tbp + klane); kb[buf][tt][1] = *(const bf16x8*)(tbp + klane + 32); } \
        else { kb[buf][tt][0] = *(const LAS bf16x8*)(F.lds + NA_KC + ((t_ * 2) * 64 + F.lane) * 16); kb[buf][tt][1] = *(const LAS bf16x8*)(F.lds + NA_KC + ((t_ * 2 + 1) * 64 + F.lane) * 16); } } } } while (0)
    if (LOCAL) { NA_LOADB(0, 0); NA_LOADB(1, 1); NA_LOADB(2, 2); }
    LAS float* rpb = (LAS float*)(F.lds + NA_RPB);
    LAS float* RKL = (LAS float*)(F.lds + NA_RKL); LAS float* RKC = (LAS float*)(F.lds + NA_RKC);
    int bo[2][4];
    if (LOCAL) {
        const int qcol = 16 * qb + fr; int cs = qcol - 8; cs = cs < 0 ? 0 : (cs > 48 ? 48 : cs);
#pragma unroll
        for (int hc = 0; hc < 2; ++hc)
#pragma unroll
            for (int j = 0; j < 4; ++j) { const int keycol = kc0 + 16 * hc + 4 * fq + j; bo[hc][j] = (keycol >= cs && keycol < cs + 16) ? keycol - qcol + 15 : 31; }
    }
    f32x4 sc[16];
#pragma unroll
    for (int bi = 0; bi < 8; ++bi) {
        asm volatile("" ::: "memory");
        if (LOCAL && bi + 3 < 8) NA_LOADB(bi + 3, (bi + 3) & 3);
        asm volatile("" ::: "memory");
#pragma unroll
        for (int tt = 0; tt < 2; ++tt) {
            const int t = bi * 2 + tt;
            sc[t] = (f32x4){-1e30f, -1e30f, -1e30f, -1e30f};
            if (t < ntile) {
                const f32x4 rk = LOCAL ? *(const LAS f32x4*)(RKL + ((vrow0 + (t >> 1)) % NSLOT) * 64 + kc0 + 16 * (t & 1) + 4 * fq) : *(const LAS f32x4*)(RKC + (tile_base + t) * 16 + 4 * fq);
                f32x4 a = (f32x4){0.f, 0.f, 0.f, 0.f};
                if (LOCAL) { a = mfma16(kb[bi & 3][tt][0], qf[0], a); a = mfma16(kb[bi & 3][tt][1], qf[1], a); }
                else { a = mfma16(*(const LAS bf16x8*)(F.lds + NA_KC + ((t * 2) * 64 + F.lane) * 16), qf[0], a); a = mfma16(*(const LAS bf16x8*)(F.lds + NA_KC + ((t * 2 + 1) * 64 + F.lane) * 16), qf[1], a); }
#pragma unroll
                for (int j = 0; j < 4; ++j) {
                    float sv = a[j] * rk[j];
                    if (LOCAL) sv += rpb[(ro0 + (t >> 1)) * 32 + bo[t & 1][j]];
                    sc[t][j] = sv;
                }
            }
        }
    }
#undef NA_LOADB
    {
        float m = -1e30f;
#pragma unroll
        for (int t = 0; t < 16; ++t) m = fmaxf(fmaxf(fmaxf(m, sc[t][0]), fmaxf(sc[t][1], sc[t][2])), sc[t][3]);
        m = fmaxf(m, SHX(m, 16)); m = fmaxf(m, SHX(m, 32));
        float sm = 0.f;
#pragma unroll
        for (int t = 0; t < 16; ++t)
#pragma unroll
            for (int j = 0; j < 4; ++j) { const float p = __builtin_amdgcn_exp2f(sc[t][j] - m); sc[t][j] = p; sm += p; }
        sm += SHX(sm, 16); sm += SHX(sm, 32);
        mrow = m; lrow = sm;
    }
    int vo[LOCAL ? 1 : 2][2][4];
#pragma unroll
    for (int par = 0; par < (LOCAL ? 1 : 2); ++par)
#pragma unroll
        for (int hc = 0; hc < 2; ++hc)
#pragma unroll
            for (int nb = 0; nb < 4; ++nb) { const int d = nb * 16 + fr;
                vo[par][hc][nb] = d * vstride + (((LOCAL ? kc0 : 32 * par) + 16 * hc + 4 * fq) ^ (((d >> 3) & 7) << 3)) + (LOCAL ? 0 : tile_base * 16);
                asm volatile("" : "+v"(vo[par][hc][nb])); }
#pragma unroll
    for (int nb = 0; nb < 4; ++nb) o[nb] = (f32x4){0.f, 0.f, 0.f, 0.f};
#pragma unroll
    for (int ks = 0; ks < 8; ++ks) {
        if (2 * ks < ntile) {
            union { bf16x8 v; unsigned u[4]; } pb;
            pb.u[0] = cvt_pk_bf16(sc[2 * ks][0], sc[2 * ks][1]); pb.u[1] = cvt_pk_bf16(sc[2 * ks][2], sc[2 * ks][3]);
            pb.u[2] = cvt_pk_bf16(sc[2 * ks + 1][0], sc[2 * ks + 1][1]); pb.u[3] = cvt_pk_bf16(sc[2 * ks + 1][2], sc[2 * ks + 1][3]);
            const int kso = LOCAL ? ((vrow0 + ks) % NSLOT) * 64 : (ks >> 1) * 64;
#pragma unroll
            for (int nb = 0; nb < 4; ++nb) {
                union { bf16x8 v; u32x2 h2[2]; } va;
                va.h2[0] = *(const LAS u32x2*)(VT + vo[LOCAL ? 0 : (ks & 1)][0][nb] + kso);
                va.h2[1] = *(const LAS u32x2*)(VT + vo[LOCAL ? 0 : (ks & 1)][1][nb] + kso);
                o[nb] = mfma16(va.v, pb.v, o[nb]); }
        }
    }
}

__device__ __forceinline__ void stage_ctx(Frame& F, const bf16_t* ctx0, int h, int l) {
    LAS bf16_t* VTC = (LAS bf16_t*)(F.lds + NA_VTC); LAS float* RKC = (LAS float*)(F.lds + NA_RKC);
    if (F.tid < 64) ((LAS float*)(F.lds + NA_GQ))[F.tid] = F.IN(8)[l * 64 + F.tid] * F.IN(9)[l * 64 + F.tid] * (0.125f * 1.4426950408889634f);
#pragma unroll
    for (int it = 0; it < 4; ++it) {
        const int item = it * 512 + F.tid, key = item >> 3, dg = item & 7;
        const bf16x8 v = *(const bf16x8*)(ctx0 + (size_t)key * NIN + C_VA + h * 64 + dg * 8);
        const bf16x8 kk = *(const bf16x8*)(ctx0 + (size_t)key * NIN + C_KA + h * 64 + dg * 8);
        const int kx = key ^ (dg << 3);
#pragma unroll
        for (int i = 0; i < 8; ++i) VTC[(dg * 8 + i) * VTC_STRIDE + kx] = (bf16_t)v[i];
        *(LAS bf16x8*)(F.lds + NA_KC + ((((key >> 4) * 2 + (dg >> 2)) * 64) + (dg & 3) * 16 + (key & 15)) * 16) = kk;
        float ss = sumsq8(kk); ss += SHX(ss, 1); ss += SHX(ss, 2); ss += SHX(ss, 4);
        if (dg == 0) RKC[key] = rsqrtf(ss * (1.0f / 64.0f) + EPS);
    }
}

__device__ __forceinline__ void na_store(Frame& F, int h, int qrow0, const f32x4 (&o)[4], float inv) {
    const int fr = F.lane & 15, fq = F.lane >> 4;
    bf16_t* op = F.MIX + (size_t)(qrow0 + fr) * DM + h * 64 + 4 * fq;
#pragma unroll
    for (int nb = 0; nb < 4; ++nb) { const f32x4 r = o[nb] * inv; u32x2 w; w.x = cvt_pk_bf16(r[0], r[1]); w.y = cvt_pk_bf16(r[2], r[3]); *(u32x2*)(op + nb * 16) = w; }
}

__device__ __forceinline__ void na_band(Frame& F, int l, int unit, bool stage_shared) {
    const int qb = F.wave & 3, half = F.wave >> 2;
    const int b = unit >> 6, h = (unit >> 3) & 7, R = (unit & 7) * 8;
    LAS bf16_t* VTL = (LAS bf16_t*)(F.lds + NA_VTL); LAS bf16_t* VTC = (LAS bf16_t*)(F.lds + NA_VTC); LAS float* RKL = (LAS float*)(F.lds + NA_RKL);
    const bf16_t* lat = F.U + (size_t)(b * SEQ) * NIN; const bf16_t* ctx0 = F.U + (size_t)(NLAT + b * CTXL) * NIN;
    const int skey = F.tid >> 3, sdg = F.tid & 7, skx = skey ^ (sdg << 3);
    const bf16_t* vsrc = lat + (size_t)skey * NIN + C_VA + h * 64 + sdg * 8;
    const bf16_t* ksrc = lat + (size_t)skey * NIN + C_KA + h * 64 + sdg * 8;
#define NA_R0(r_) ((r_) - 4 < 0 ? 0 : ((r_) - 4 > 56 ? 56 : (r_) - 4))
    int hi = NA_R0(R + 1) + 7;
    {
        for (int krow = NA_R0(R); krow <= hi; ++krow) { const bf16x8 v = *(const bf16x8*)(vsrc + (size_t)krow * 64 * NIN), kk = *(const bf16x8*)(ksrc + (size_t)krow * 64 * NIN);
            LAS bf16_t* dst = VTL + (sdg * 8) * VTL_STRIDE + (krow % NSLOT) * 64 + skx;
#pragma unroll
            for (int i = 0; i < 8; ++i) dst[i * VTL_STRIDE] = (bf16_t)v[i];
            float ss = sumsq8(kk); ss += SHX(ss, 1); ss += SHX(ss, 2); ss += SHX(ss, 4);
            if (sdg == 0) RKL[(krow % NSLOT) * 64 + skey] = rsqrtf(ss * (1.0f / 64.0f) + EPS); }
        if (stage_shared) stage_ctx(F, ctx0, h, l);
        LAS float* rpb = (LAS float*)(F.lds + NA_RPB); const float* src = F.IN(10) + ((size_t)l * 8 + h) * 465; if (stage_shared && F.tid < 480) { const int rr_ = F.tid >> 5, cc_ = F.tid & 31; rpb[F.tid] = cc_ < 31 ? src[rr_ * 31 + cc_] * 1.4426950408889634f : -1e30f; }
    }
    __syncthreads();
    int kc0 = 16 * qb - 8; kc0 = kc0 < 0 ? 0 : (kc0 > 32 ? 32 : kc0);
    for (int it2 = 0; it2 < 4; ++it2) {
        asm volatile("" : "+v"(F.lane)); const bf16_t* ctxp = ctx0; asm volatile("" : "+s"(ctxp));
        const int rA = R + 2 * it2, r = rA + half, r0 = NA_R0(r);
        int newhi = it2 < 3 ? NA_R0(rA + 3) + 7 : hi; newhi = newhi > 63 ? 63 : newhi;
        const int nnew = newhi - hi;
        bf16x8 pv0 = (bf16x8){0, 0, 0, 0, 0, 0, 0, 0}, pv1 = pv0, pk0 = pv0, pk1 = pv0;
        if (nnew > 0) { pv0 = *(const bf16x8*)(vsrc + (size_t)(hi + 1) * 64 * NIN); pk0 = *(const bf16x8*)(ksrc + (size_t)(hi + 1) * 64 * NIN); }
        if (nnew > 1) { pv1 = *(const bf16x8*)(vsrc + (size_t)(hi + 2) * 64 * NIN); pk1 = *(const bf16x8*)(ksrc + (size_t)(hi + 2) * 64 * NIN); }
        const int fr = F.lane & 15;
        const int qrow0 = b * SEQ + r * 64 + 16 * qb;
        bf16x8 qf[2];
        na_qfrag(F, h, F.U + (size_t)(qrow0 + fr) * NIN, qf);
        f32x4 oacc[4]; float mrun = -1e30f, lrun = 0.f;
#pragma unroll
        for (int nb = 0; nb < 4; ++nb) oacc[nb] = (f32x4){0.f, 0.f, 0.f, 0.f};
#pragma unroll 1
        for (int ph2 = 0; ph2 < 2; ++ph2) {
            asm volatile("" : "+v"(F.lane) :: "memory");
            f32x4 o[4]; float m1, l1;
            if (ph2 == 0) na_wave<false>(F, h, qf, ctxp, qb, 0, 0, VTC, VTC_STRIDE, 0, o, m1, l1);
            else {
                if (nnew > 0) { const int slot = (hi + 1) % NSLOT; LAS bf16_t* dst = VTL + (sdg * 8) * VTL_STRIDE + slot * 64 + skx;
#pragma unroll
                    for (int i = 0; i < 8; ++i) dst[i * VTL_STRIDE] = (bf16_t)pv0[i];
                    float ss = sumsq8(pk0); ss += SHX(ss, 1); ss += SHX(ss, 2); ss += SHX(ss, 4);
                    if (sdg == 0) RKL[slot * 64 + skey] = rsqrtf(ss * (1.0f / 64.0f) + EPS); }
                if (nnew > 1) { const int slot = (hi + 2) % NSLOT; LAS bf16_t* dst = VTL + (sdg * 8) * VTL_STRIDE + slot * 64 + skx;
#pragma unroll
                    for (int i = 0; i < 8; ++i) dst[i * VTL_STRIDE] = (bf16_t)pv1[i];
                    float ss = sumsq8(pk1); ss += SHX(ss, 1); ss += SHX(ss, 2); ss += SHX(ss, 4);
                    if (sdg == 0) RKL[slot * 64 + skey] = rsqrtf(ss * (1.0f / 64.0f) + EPS); }
                na_wave<true>(F, h, qf, lat + (size_t)(r0 * 64 + kc0) * NIN, qb, kc0, r0 - r + 7, VTL, VTL_STRIDE, r0, o, m1, l1);
            }
            const float M = fmaxf(mrun, m1), a1 = __builtin_amdgcn_exp2f(mrun - M), a2 = __builtin_amdgcn_exp2f(m1 - M);
#pragma unroll
            for (int nb = 0; nb < 4; ++nb) oacc[nb] = oacc[nb] * a1 + o[nb] * a2;
            lrun = lrun * a1 + l1 * a2; mrun = M;
        }
        na_store(F, h, qrow0, oacc, 1.0f / lrun);
        hi = newhi;
        __syncthreads();
    }
#undef NA_R0
}

__device__ __forceinline__ void na_ctx_unit(Frame& F, int l, int u2) {
    const int fr = F.lane & 15;
    const int b = u2 >> 4, qblk = (u2 >> 3) & 1, h = u2 & 7;
    LAS bf16_t* VTC = (LAS bf16_t*)(F.lds + NA_VTC);
    const bf16_t* ctx0 = F.U + (size_t)(NLAT + b * CTXL) * NIN;
    stage_ctx(F, ctx0, h, l);
    __syncthreads();
    const int qrow0 = NLAT + b * CTXL + qblk * 128 + 16 * F.wave;
    bf16x8 qf[2];
    na_qfrag(F, h, F.U + (size_t)(qrow0 + fr) * NIN, qf);
    f32x4 o[4]; float m1, l1;
    na_wave<false>(F, h, qf, ctx0, 0, 0, 0, VTC, VTC_STRIDE, 0, o, m1, l1);
    na_store(F, h, qrow0, o, 1.0f / l1);
    __syncthreads();
}

constexpr int CV_G = 0, CV_ACT = 65536, CV_END = 96256;
static_assert(CV_ACT + 64 * 264 * 2 <= LDS_BYTES, "conv lds");
__device__ __forceinline__ void conv_unit(Frame& F, int l, int unit) {
    const int fr = F.lane & 15, fq = F.lane >> 4;
    int row0, seq0, seqn;
    if (unit < 512) { row0 = unit * 64; seq0 = (unit >> 6) * SEQ; seqn = SEQ; } else { const int u2 = unit - 512; row0 = NLAT + u2 * 64; seq0 = NLAT + (u2 >> 2) * CTXL; seqn = CTXL; }
    LAS float* G = (LAS float*)(F.lds + CV_G);
    for (int item = F.tid; item < 94 * 32; item += 512) {
        const int i = item >> 5, c8 = (item & 31) * 8; const int row = row0 - 15 + i;
        f32x4 g0 = (f32x4){0.f, 0.f, 0.f, 0.f}, g1 = g0;
        if (row >= seq0 && row < seq0 + seqn) {
            const bf16x8 a = *(const bf16x8*)(F.U + (size_t)row * NIN + C_UA + c8), g = *(const bf16x8*)(F.U + (size_t)row * NIN + C_UG + c8);
#pragma unroll
            for (int e = 0; e < 4; ++e) { g0[e] = bf2f((bf16_t)a[e]) * sigmoidf_(bf2f((bf16_t)g[e])); g1[e] = bf2f((bf16_t)a[4 + e]) * sigmoidf_(bf2f((bf16_t)g[4 + e])); }
        }
        *(LAS f32x4*)(G + i * 256 + c8) = g0; *(LAS f32x4*)(G + i * 256 + c8 + 4) = g1;
    }
    __syncthreads();
    const int ch = F.tid & 255, tg = F.tid >> 8;
    float acc[32];
    {
        float w[31];
        const float* cw = F.IN(11) + (size_t)l * 31 * 256 + ch;
#pragma unroll
        for (int j = 0; j < 31; ++j) w[j] = cw[j * 256];
        const float cb = F.IN(12)[l * 256 + ch];
#pragma unroll
        for (int tb = 0; tb < 4; ++tb) {
            float xr[38];
#pragma unroll
            for (int i = 0; i < 38; ++i) xr[i] = G[(tg * 32 + tb * 8 + i) * 256 + ch];
#pragma unroll
            for (int o = 0; o < 8; ++o) { float a = cb;
#pragma unroll
                for (int j = 0; j < 31; ++j) a += w[j] * xr[o + j];
                acc[tb * 8 + o] = a; }
        }
    }
    __syncthreads();
#pragma unroll
    for (int t = 0; t < 32; ++t) G[(tg * 32 + t) * 256 + ch] = acc[t];
    __syncthreads();
    LAS bf16_t* ACT = (LAS bf16_t*)(F.lds + CV_ACT);
    {
        const f32x4 lg = *(const f32x4*)(F.IN(13) + l * 256 + F.lane * 4), lb = *(const f32x4*)(F.IN(14) + l * 256 + F.lane * 4);
#pragma unroll
        for (int tt = 0; tt < 8; ++tt) { const int t = F.wave * 8 + tt;
            const f32x4 v = *(const LAS f32x4*)(G + t * 256 + F.lane * 4);
            float s = v[0] + v[1] + v[2] + v[3];
#pragma unroll
            for (int o = 1; o < 64; o <<= 1) s += SHX(s, o);
            const float mu = s * (1.0f / 256.0f);
            const f32x4 dv = v - mu; float q = dv[0] * dv[0] + dv[1] * dv[1] + dv[2] * dv[2] + dv[3] * dv[3];
#pragma unroll
            for (int o = 1; o < 64; o <<= 1) q += SHX(q, o);
            const float rs = rsqrtf(q * (1.0f / 256.0f) + EPS);
            float y[4];
#pragma unroll
            for (int e = 0; e < 4; ++e) y[e] = siluf_(dv[e] * rs * lg[e] + lb[e]);
            u32x2 w; w.x = cvt_pk_bf16(y[0], y[1]); w.y = cvt_pk_bf16(y[2], y[3]);
            *(LAS u32x2*)(ACT + t * 264 + F.lane * 4) = w; }
    }
    __syncthreads();
    f32x4 o[4][2];
#pragma unroll
    for (int mb = 0; mb < 4; ++mb) { o[mb][0] = (f32x4){0.f, 0.f, 0.f, 0.f}; o[mb][1] = o[mb][0]; }
    const bf16_t* wp = F.Wpw + (size_t)l * 65536 + (size_t)(F.wave * 32 + fr) * 256 + 8 * fq;
#pragma unroll
    for (int ks = 0; ks < 8; ++ks) {
        const bf16x8 b0 = *(const bf16x8*)(wp + ks * 32), b1 = *(const bf16x8*)(wp + 16 * 256 + ks * 32);
#pragma unroll
        for (int mb = 0; mb < 4; ++mb) { const bf16x8 a = *(const LAS bf16x8*)(ACT + (mb * 16 + fr) * 264 + ks * 32 + 8 * fq);
            o[mb][0] = mfma16(b0, a, o[mb][0]); o[mb][1] = mfma16(b1, a, o[mb][1]); }
    }
#pragma unroll
    for (int nn = 0; nn < 2; ++nn) { const int n = F.wave * 32 + nn * 16 + 4 * fq; const f32x4 pb = *(const f32x4*)(F.IN(16) + l * 256 + n);
#pragma unroll
        for (int mb = 0; mb < 4; ++mb) { const f32x4 r = o[mb][nn] + pb; u32x2 w; w.x = cvt_pk_bf16(r[0], r[1]); w.y = cvt_pk_bf16(r[2], r[3]);
            *(u32x2*)(F.MIX + (size_t)(row0 + mb * 16 + fr) * DM + 512 + n) = w; } }
    __syncthreads();
}

struct GlaLd { bf16x8 af, ab, qo, qp, ko, kp, v0, v1; };
__device__ __forceinline__ void gla_unit_decode(int unit, int& b, int& cc, int& h, int& row0);
__device__ __forceinline__ void gla_load(Frame& F, int pair, GlaLd& g) {
    const int slot = F.wave >> 2, w4 = F.wave & 3, t4 = F.tid & 255;
    int b, cc, h, row0; gla_unit_decode(pair * 2 + slot, b, cc, h, row0);
    const bf16_t* rp = F.U + (size_t)(row0 + F.lane) * NIN;
    g.af = *(const bf16x8*)(rp + C_GF + h * 32 + 8 * w4); g.ab = *(const bf16x8*)(rp + C_GB + h * 32 + 8 * w4);
    g.qo = *(const bf16x8*)(rp + C_QG + h * 32 + 8 * w4); g.qp = *(const bf16x8*)(rp + C_QG + h * 32 + 8 * (w4 ^ 1));
    g.ko = *(const bf16x8*)(rp + C_KG + h * 32 + 8 * w4); g.kp = *(const bf16x8*)(rp + C_KG + h * 32 + 8 * (w4 ^ 1));
    g.v0 = *(const bf16x8*)(F.U + (size_t)(row0 + (t4 >> 3)) * NIN + C_VG + h * 64 + (t4 & 7) * 8);
    g.v1 = *(const bf16x8*)(F.U + (size_t)(row0 + 32 + (t4 >> 3)) * NIN + C_VG + h * 64 + (t4 & 7) * 8);
}
__device__ __forceinline__ void gla_prep(Frame& F, const GlaLd& g, int l, int b, int cc, int h, int row0, int w4, float (&qF)[8], float (&kF)[8], float (&qB)[8], float (&kB)[8], float (&totF)[8], float (&totB)[8]) {
    const int lane = F.lane;
    const bf16x8 af = g.af, ab = g.ab, qo = g.qo, qp = g.qp, ko = g.ko, kp = g.kp;
    const float* gbf = F.IN(18) + l * 128 + h * 32 + 8 * w4; const float* gbb = F.IN(20) + l * 128 + h * 32 + 8 * w4;
    const bool isctx = cc < 4;
    const int p = (w4 < 2) ? (cc - 4) : lane;
    const float qscale = 0.17677669529663687f;
#pragma unroll
    for (int i = 0; i < 8; ++i) {
        const float laf = logsigmoidf_(bf2f((bf16_t)af[i]) + gbf[i]) * (1.0f / 16.0f), lab = logsigmoidf_(bf2f((bf16_t)ab[i]) + gbb[i]) * (1.0f / 16.0f);
        const float cf = wave_scan_incl(laf), pb = wave_scan_incl(lab);
        totF[i] = __int_as_float(__builtin_amdgcn_readlane(__float_as_int(cf), 63)); totB[i] = __int_as_float(__builtin_amdgcn_readlane(__float_as_int(pb), 63));
        const float cb = totB[i] - pb + lab;
        float q = bf2f((bf16_t)qo[i]), k = bf2f((bf16_t)ko[i]);
        if (!isctx) {
            const float cs = F.rope[p * 8 + i], sn = F.rope[512 + p * 8 + i];
            const float q2 = bf2f((bf16_t)qp[i]), k2 = bf2f((bf16_t)kp[i]);
            if (w4 & 1) { q = q2 * sn + q * cs; k = k2 * sn + k * cs; } else { q = q * cs - q2 * sn; k = k * cs - k2 * sn; }
        }
        q *= qscale;
        const float ef = __expf(cf), eb = __expf(cb);
        qF[i] = q * ef; kF[i] = k * __expf(-cf); qB[i] = q * eb; kB[i] = k * __expf(-cb);
    }
}
__device__ __forceinline__ void gla_unit_decode(int unit, int& b, int& cc, int& h, int& row0) {
    h = unit & 3; const int t = unit >> 2; cc = t % NCHUNK; b = t / NCHUNK;
    row0 = cc < 4 ? NLAT + b * CTXL + cc * 64 : b * SEQ + (cc - 4) * 64;
}
__device__ __forceinline__ void gla_stage_vt(const GlaLd& g, LAS bf16_t* VT, int t4) {
    const int s = t4 >> 3, dg = t4 & 7;
#pragma unroll
    for (int i = 0; i < 8; ++i) { VT[(dg * 8 + i) * 72 + s] = (bf16_t)g.v0[i]; VT[(dg * 8 + i) * 72 + 32 + s] = (bf16_t)g.v1[i]; }
}

constexpr int GL_SLOT = 18432 + 256;
__device__ __forceinline__ void gla_local_pair(Frame& F, int l, int pair, const GlaLd& g) {
    const int fr = F.lane & 15, fq = F.lane >> 4;
    const int slot = F.wave >> 2, w4 = F.wave & 3, t4 = F.tid & 255;
    const int unit = pair * 2 + slot; int b, cc, h, row0; gla_unit_decode(unit, b, cc, h, row0);
    LAS unsigned char* sb = F.lds + slot * GL_SLOT;
    LAS bf16_t* KT[2] = {(LAS bf16_t*)sb, (LAS bf16_t*)(sb + 4608)}; LAS bf16_t* VT = (LAS bf16_t*)(sb + 9216); LAS float* TOT = (LAS float*)(sb + 18432);
    {
        float qF[8], kF[8], qB[8], kB[8], totF[8], totB[8];
        gla_prep(F, g, l, b, cc, h, row0, w4, qF, kF, qB, kB, totF, totB);
#pragma unroll
        for (int i = 0; i < 8; ++i) { KT[0][(8 * w4 + i) * 72 + F.lane] = f2bf(kF[i]); KT[1][(8 * w4 + i) * 72 + F.lane] = f2bf(kB[i]); }
        {
            bf16_t* gq = F.GQK + (size_t)unit * 8192 + F.lane * 32 + 8 * w4; u32x4 w;
            w.x = cvt_pk_bf16(qF[0], qF[1]); w.y = cvt_pk_bf16(qF[2], qF[3]); w.z = cvt_pk_bf16(qF[4], qF[5]); w.w = cvt_pk_bf16(qF[6], qF[7]); *(u32x4*)(gq) = w;
            w.x = cvt_pk_bf16(kF[0], kF[1]); w.y = cvt_pk_bf16(kF[2], kF[3]); w.z = cvt_pk_bf16(kF[4], kF[5]); w.w = cvt_pk_bf16(kF[6], kF[7]); *(u32x4*)(gq + 2048) = w;
            w.x = cvt_pk_bf16(qB[0], qB[1]); w.y = cvt_pk_bf16(qB[2], qB[3]); w.z = cvt_pk_bf16(qB[4], qB[5]); w.w = cvt_pk_bf16(qB[6], qB[7]); *(u32x4*)(gq + 4096) = w;
            w.x = cvt_pk_bf16(kB[0], kB[1]); w.y = cvt_pk_bf16(kB[2], kB[3]); w.z = cvt_pk_bf16(kB[4], kB[5]); w.w = cvt_pk_bf16(kB[6], kB[7]); *(u32x4*)(gq + 6144) = w;
        }
        if (F.lane == 0) {
#pragma unroll
            for (int i = 0; i < 8; ++i) { TOT[8 * w4 + i] = totF[i]; TOT[32 + 8 * w4 + i] = totB[i];
                F.dec[(size_t)(unit * 2 + 0) * 32 + 8 * w4 + i] = __expf(totF[i]); F.dec[(size_t)(unit * 2 + 1) * 32 + 8 * w4 + i] = __expf(totB[i]); } }
    }
    gla_stage_vt(g, VT, t4);
    __syncthreads();
    {
#pragma unroll
        for (int it2 = 0; it2 < 2; ++it2) { const int item = it2 * 256 + t4, dv = item >> 3, s8 = (item & 7) * 8;
            *(u32x4*)(F.GVT + (size_t)unit * 4096 + dv * 64 + s8) = *(const LAS u32x4*)(VT + dv * 72 + s8); }
    }
    const int dir = w4 >> 1, mb = w4 & 1;
    f32x4 acc[4];
#pragma unroll
    for (int nb = 0; nb < 4; ++nb) acc[nb] = (f32x4){0.f, 0.f, 0.f, 0.f};
#pragma unroll
    for (int ks = 0; ks < 2; ++ks) { const bf16x8 a = *(const LAS bf16x8*)(KT[dir] + (mb * 16 + fr) * 72 + ks * 32 + 8 * fq);
#pragma unroll
        for (int nb = 0; nb < 4; ++nb) { const bf16x8 vb = *(const LAS bf16x8*)(VT + (nb * 16 + fr) * 72 + ks * 32 + 8 * fq); acc[nb] = mfma16(a, vb, acc[nb]); } }
    f32x4 sc4;
#pragma unroll
    for (int j = 0; j < 4; ++j) sc4[j] = __expf(TOT[dir * 32 + mb * 16 + 4 * fq + j]);
#pragma unroll
    for (int nb = 0; nb < 4; ++nb) *(f32x4*)(F.dST + (size_t)(unit * 2 + dir) * 2048 + (nb * 16 + fr) * 32 + mb * 16 + 4 * fq) = acc[nb] * sc4;
    __syncthreads();
}

__device__ void phase_gla_scan(Frame& F) {
    for (int e = F.bid * 512 + F.tid; e < NBATCH * 4 * 2 * 2048; e += F.G * 512) {
        const int inner = e & 2047, dir = (e >> 11) & 1, h = (e >> 12) & 3, b = e >> 14, d = inner & 31;
        float S = 0.f;
#pragma unroll 1
        for (int half = 0; half < 2; ++half) {
            float dc[34], ds[34];
#pragma unroll
            for (int i = 0; i < 34; ++i) { const int step = half * 34 + i;
                const int cc = dir == 0 ? step : (step < 4 ? 3 - step : 71 - step);
                const int unit = (b * NCHUNK + cc) * 4 + h;
                dc[i] = F.dec[(size_t)(unit * 2 + dir) * 32 + d]; ds[i] = F.dST[(size_t)(unit * 2 + dir) * 2048 + inner]; }
#pragma unroll
            for (int i = 0; i < 34; ++i) { const int step = half * 34 + i;
                const int cc = dir == 0 ? step : (step < 4 ? 3 - step : 71 - step);
                const int unit = (b * NCHUNK + cc) * 4 + h;
                F.SinT[(size_t)(unit * 2 + dir) * 2048 + inner] = f2bf(S);
                S = dc[i] * S + ds[i]; }
        }
    }
}

__device__ __forceinline__ void gla_out_wave(Frame& F, int l, int unit, int tb) {
    const int fr = F.lane & 15, fq = F.lane >> 4;
    int b, cc, h, row0; gla_unit_decode(unit, b, cc, h, row0);
    LAS bf16_t* ATT = (LAS bf16_t*)(F.lds + F.wave * 2304);
    const bf16_t* gq = F.GQK + (size_t)unit * 8192; const bf16_t* gv = F.GVT + (size_t)unit * 4096;
    bf16x8 qa2[2], kb2[2][4], vb2[2][4], sb2[2][4];
#pragma unroll
    for (int dir = 0; dir < 2; ++dir) {
        qa2[dir] = *(const bf16x8*)(gq + dir * 4096 + (tb * 16 + fr) * 32 + 8 * fq);
#pragma unroll
        for (int sbk = 0; sbk < 4; ++sbk) { const bool valid = dir == 0 ? (sbk <= tb) : (sbk >= tb);
            kb2[dir][sbk] = valid ? *(const bf16x8*)(gq + dir * 4096 + 2048 + (sbk * 16 + fr) * 32 + 8 * fq) : (bf16x8){0, 0, 0, 0, 0, 0, 0, 0}; }
#pragma unroll
        for (int nb = 0; nb < 4; ++nb) sb2[dir][nb] = *(const bf16x8*)(F.SinT + (size_t)(unit * 2 + dir) * 2048 + (nb * 16 + fr) * 32 + 8 * fq);
    }
#pragma unroll
    for (int ks = 0; ks < 2; ++ks)
#pragma unroll
        for (int nb = 0; nb < 4; ++nb) vb2[ks][nb] = *(const bf16x8*)(gv + (nb * 16 + fr) * 64 + ks * 32 + 8 * fq);
    u32x2 rw4[4]; f32x4 og4[4];
    const size_t orow = (size_t)(row0 + tb * 16 + fr);
#pragma unroll
    for (int nb = 0; nb < 4; ++nb) { rw4[nb] = *(const u32x2*)(F.U + orow * NIN + C_RG + h * 64 + nb * 16 + 4 * fq); og4[nb] = *(const f32x4*)(F.IN(21) + l * 64 + nb * 16 + 4 * fq); }
    f32x4 o[4];
#pragma unroll
    for (int nb = 0; nb < 4; ++nb) o[nb] = (f32x4){0.f, 0.f, 0.f, 0.f};
#pragma unroll
    for (int dir = 0; dir < 2; ++dir) {
        const bf16x8 qa = qa2[dir];
#pragma unroll
        for (int sbk = 0; sbk < 4; ++sbk) {
            const bool valid = dir == 0 ? (sbk <= tb) : (sbk >= tb);
            f32x4 a = (f32x4){0.f, 0.f, 0.f, 0.f};
            if (valid) a = mfma16(qa, kb2[dir][sbk], a);
#pragma unroll
            for (int j = 0; j < 4; ++j) { float v = a[j];
                if (sbk == tb) { const bool keep = dir == 0 ? (fr <= 4 * fq + j) : (fr >= 4 * fq + j); v = keep ? v : 0.f; }
                ATT[(4 * fq + j) * 72 + sbk * 16 + fr] = f2bf(v); }
        }
        asm volatile("s_waitcnt lgkmcnt(0)" ::: "memory");
#pragma unroll
        for (int ks = 0; ks < 2; ++ks) { const bf16x8 pa = *(const LAS bf16x8*)(ATT + fr * 72 + ks * 32 + 8 * fq);
#pragma unroll
            for (int nb = 0; nb < 4; ++nb) o[nb] = mfma16(vb2[ks][nb], pa, o[nb]); }
#pragma unroll
        for (int nb = 0; nb < 4; ++nb) o[nb] = mfma16(sb2[dir][nb], qa, o[nb]);
        asm volatile("s_waitcnt lgkmcnt(0)" ::: "memory");
    }
    {
        float ss = 0.f;
#pragma unroll
        for (int nb = 0; nb < 4; ++nb) ss += o[nb][0] * o[nb][0] + o[nb][1] * o[nb][1] + o[nb][2] * o[nb][2] + o[nb][3] * o[nb][3];
        ss += SHX(ss, 16); ss += SHX(ss, 32);
        const float rinv = rsqrtf(ss * (1.0f / 64.0f) + EPS);
        const size_t row = (size_t)(row0 + tb * 16 + fr);
#pragma unroll
        for (int nb = 0; nb < 4; ++nb) { const int dv = nb * 16 + 4 * fq;
            const u32x2 rw = rw4[nb]; const f32x4 og = og4[nb];
            const float r0_ = __uint_as_float(rw.x << 16), r1_ = __uint_as_float(rw.x & 0xffff0000u), r2_ = __uint_as_float(rw.y << 16), r3_ = __uint_as_float(rw.y & 0xffff0000u);
            u32x2 w; w.x = cvt_pk_bf16(o[nb][0] * rinv * og[0] * siluf_(r0_), o[nb][1] * rinv * og[1] * siluf_(r1_));
            w.y = cvt_pk_bf16(o[nb][2] * rinv * og[2] * siluf_(r2_), o[nb][3] * rinv * og[3] * siluf_(r3_));
            *(u32x2*)(F.MIX + row * DM + 768 + h * 64 + dv) = w; }
    }
}

__device__ void phase_mixers(Frame& F, int l) {
    const int n_na = 512 + (l == 0 ? 128 : 0), n_cv = 512 + (l == 0 ? 32 : 0), n_gl = NGU / 2;
    for (int it = F.bid; it < n_na + n_cv; it += F.G) {
        frame_refresh(F);
        if (it < n_na) {
            if (it < 512) {
                const int wb = it & 255, second = it >> 8, rest = wb >> 3;
                na_band(F, l, ((wb & 7) << 6) | ((rest >> 2) << 3) | ((rest & 3) * 2 + second), second == 0 || F.G != 256);
            } else na_ctx_unit(F, l, it - 512); }
        else conv_unit(F, l, it - n_na);
    }
    const int base = n_na + n_cv;
    int it = base + ((F.bid - base % F.G) + F.G) % F.G;
    frame_refresh(F);
    GlaLd cur;
    if (it < base + n_gl) gla_load(F, it - base, cur);
    for (; it < base + n_gl; it += F.G) {
        frame_refresh(F);
        GlaLd nxt = cur;
        if (it + F.G < base + n_gl) gla_load(F, it + F.G - base, nxt);
        gla_local_pair(F, l, it - base, cur);
        cur = nxt;
    }
}
__device__ void phase_gla_out(Frame& F, int l) {
    for (int it = F.bid * 8 + F.wave; it < NGU * 4; it += F.G * 8) gla_out_wave(F, l, it >> 2, it & 3);
}

#define XB_TMO      128
#define XB_XCNT(j)  (256  + 64 * (j))
#define XB_XSUB(j)  (1280 + 64 * (j))
#define XB_XGEN(j)  (2304 + 64 * (j))
#define XB_TOP      3328
#define XB_TOPGEN   3392
#define XCD_BAR_WORDS 3456
#define XB_SPIN_CAP (1u << 23)
__device__ __forceinline__ unsigned xb_ld(unsigned* p)              { return __hip_atomic_load(p, __ATOMIC_RELAXED, __HIP_MEMORY_SCOPE_AGENT); }
__device__ __forceinline__ unsigned xb_add(unsigned* p, unsigned v) { return __hip_atomic_fetch_add(p, v, __ATOMIC_RELAXED, __HIP_MEMORY_SCOPE_AGENT); }
__device__ __forceinline__ unsigned xb_xcc_id() { return (unsigned)__builtin_amdgcn_s_getreg((3 << 11) | 20) & 0xFu; }
#define XB_SPIN(cond, bar) do { unsigned _sp = 0; while (cond) { __builtin_amdgcn_s_sleep(1); \
    if ((++_sp & 255u) == 0u) { if (xb_ld(&(bar)[XB_TMO])) break; if (_sp > XB_SPIN_CAP) { atomicAdd(&(bar)[XB_TMO], 1u); break; } } } } while (0)
struct XcdBarrier { unsigned* bar; unsigned x; volatile LAS unsigned* st; };
__device__ __forceinline__ XcdBarrier xcd_barrier_post(unsigned* bar, volatile LAS unsigned* st) {
    XcdBarrier b; b.bar = bar; b.x = xb_xcc_id(); b.st = st;
    if (threadIdx.x == 0) (void)xb_add(&bar[XB_XCNT(b.x)], 1u);
    return b;
}
__device__ __forceinline__ void xcd_barrier_complete(unsigned* bar, unsigned x, unsigned& nloc, unsigned& nx) {
    const unsigned G = gridDim.x * gridDim.y * gridDim.z;
    unsigned sum, cnt, mine, sp = 0u;
    for (;;) {
        sum = 0u; cnt = 0u; mine = 0u;
#pragma unroll
        for (unsigned j = 0; j < 16; ++j) { const unsigned c = xb_ld(&bar[XB_XCNT(j)]); sum += c; cnt += (c > 0u) ? 1u : 0u; mine = (j == x) ? c : mine; }
        if (sum == G) break;
        __builtin_amdgcn_s_sleep(1);
        if ((++sp & 255u) == 0u) { if (xb_ld(&bar[XB_TMO])) break; if (sp > XB_SPIN_CAP) { atomicAdd(&bar[XB_TMO], 1u); break; } }
    }
    nloc = mine > 0u ? mine : 1u; nx = cnt > 0u ? cnt : 1u;
}
__device__ __forceinline__ void xcd_barrier(const XcdBarrier& b, const bool t0) {
    asm volatile("s_waitcnt vmcnt(0)" ::: "memory");
    __syncthreads();
    if (t0) {
        unsigned* bar = b.bar;
        __builtin_amdgcn_s_waitcnt(0);
        unsigned nloc = b.st[0], nx = b.st[1];
        if (nloc == 0u) { xcd_barrier_complete(bar, b.x, nloc, nx); b.st[0] = nloc; b.st[1] = nx; }
        const unsigned old = xb_add(&bar[XB_XSUB(b.x)], 1u);
        const unsigned gen = old / nloc;
        if (old + 1u == (gen + 1u) * nloc) {
            __builtin_amdgcn_fence(__ATOMIC_RELEASE, "agent");
            asm volatile("s_waitcnt vmcnt(0)" ::: "memory");
            const unsigned og = xb_add(&bar[XB_TOP], 1u);
            const unsigned tg = og / nx;
            if (og + 1u == (tg + 1u) * nx) xb_add(&bar[XB_TOPGEN], 1u);
            else XB_SPIN(xb_ld(&bar[XB_TOPGEN]) == tg, bar);
            __builtin_amdgcn_fence(__ATOMIC_ACQUIRE, "agent");
            xb_add(&bar[XB_XGEN(b.x)], 1u);
            asm volatile("s_waitcnt vmcnt(0)" ::: "memory");
        } else {
            XB_SPIN(xb_ld(&bar[XB_XGEN(b.x)]) == gen, bar);
            __builtin_amdgcn_fence(__ATOMIC_ACQUIRE, "agent");
            asm volatile("s_waitcnt vmcnt(0)" ::: "memory");
        }
    }
    __syncthreads();
}

constexpr int N_PHASES = 1 + 9 * DEPTH;

__device__ __forceinline__ void run_phase(Frame& F, int ph) {
#ifndef PH_MASK
#define PH_MASK 0x3ff
#endif
    if (ph == 0) { if (PH_MASK & 1) phase_setup(F); return; }
    const int l = (ph - 1) / 9, s = (ph - 1) % 9;
    const float* modl = F.mod + (size_t)l * 9 * 6144;
    const float* xlat = l == 0 ? F.IN(0) : F.out;
    const float* xctx = l == 0 ? F.IN(2) : F.XC;
    const int Mfull = l == 0 ? MTOT : NLAT;
    pg8::StaticOrder S;
    switch (s) {
    case 0: if (PH_MASK & 2) phase_prep(F, xlat, xctx, modl, 0, 1024, F.IN(6) + l * DM, MTOT, l == 0 ? 0 : 8); break;
    case 1: if (PH_MASK & 4) { pg8::Gemm g{F.H, F.WtIn + (size_t)l * NIN * DM, MTOT, NIN, DM}; S.init(MTOT, NIN, F.G, F.bid, DM); pg8::EpiBf16<0> E{F.U, NIN}; pg8::gemm_phase(F.lds, F.tid, g, S, E); } break;
    case 2: if (PH_MASK & 8) phase_mixers(F, l); break;
    case 3: if (PH_MASK & 16) phase_gla_scan(F); break;
    case 4: if (PH_MASK & 32) phase_gla_out(F, l); break;
    case 5: if (PH_MASK & 64) { pg8::Gemm g{F.MIX, F.WtOut + (size_t)l * DM * DM, Mfull, DM, DM}; S.init(NLAT, DM, F.G, F.bid, DM); if (l == 0) S.add_split(32, 4); pg8::EpiResid E{xlat, xctx, F.out, F.XC, modl, 2048, F.dST}; pg8::gemm_phase(F.lds, F.tid, g, S, E); } break;
    case 6: if (PH_MASK & 128) phase_prep(F, F.out, l == 0 ? xctx : F.XC, modl, 3072, 4096, F.IN(23) + l * DM, Mfull, l == 0 ? 4 : 0); break;
    case 7: if (PH_MASK & 256) { pg8::Gemm g{F.H, F.Wt1 + (size_t)l * DFF * DM, Mfull, DFF, DM}; S.init(Mfull, DFF, F.G, F.bid, DM); pg8::EpiBf16<1> E{F.HID, DFF}; pg8::gemm_phase(F.lds, F.tid, g, S, E); } break;
    case 8: if (PH_MASK & 512) { pg8::Gemm g{F.HID, F.Wt2 + (size_t)l * DM * DFF, Mfull, DM, DFF}; S.init(NLAT, DM, F.G, F.bid, DFF); if (l == 0) S.add_split(32, 8); pg8::EpiResid E{F.out, F.XC, F.out, F.XC, modl, 5120, F.dST}; pg8::gemm_phase(F.lds, F.tid, g, S, E); } break;
    }
}

__global__ void __launch_bounds__(512, 2) mk_fwd(Args args) {
    extern __shared__ __attribute__((aligned(16))) unsigned char lds_raw[];
    const int wave0 = __builtin_amdgcn_readfirstlane((int)threadIdx.x >> 6);
    volatile LAS unsigned* bst = (volatile LAS unsigned*)((LAS unsigned char*)lds_raw + LDS_BYTES - 16);
    if (threadIdx.x == 0) { bst[0] = 0u; bst[1] = 0u; }
    __syncthreads();
    XcdBarrier xbar; xbar.bar = (unsigned*)(args.ws + WS_BAR); xbar.x = 0; xbar.st = bst;
    if (args.ph_hi - args.ph_lo > 1) xbar = xcd_barrier_post((unsigned*)(args.ws + WS_BAR), bst);
    for (int step = args.ph_lo; step < args.ph_hi; ++step) {
        int ph = step;
#ifdef PROBE_KIND
        { const int P = PROBE_KIND == 9 ? 0 : 1 + PROBE_KIND, Q = PROBE_KIND == 9 ? 1000 : 10 + PROBE_KIND; ph = step - (step > P ? 1 : 0) - (step > Q + 1 ? 1 : 0); }
#endif
        if (step > args.ph_lo) { if (args.ph_hi < 0) cg::this_grid().sync();
            else { unsigned on2 = ~0u; asm volatile("" : "+s"(on2)); xcd_barrier(xbar, wave0 == 0 && __builtin_amdgcn_mbcnt_hi(on2, __builtin_amdgcn_mbcnt_lo(on2, 0u)) == 0u); } }
        Frame F;
        unsigned ones = ~0u; int w0 = wave0; asm volatile("" : "+s"(ones), "+s"(w0));
        int tid = w0 * 64 + (int)__builtin_amdgcn_mbcnt_hi(ones, __builtin_amdgcn_mbcnt_lo(ones, 0u)); asm volatile("" : "+v"(tid));
        int bid = blockIdx.x, G = gridDim.x; asm volatile("" : "+s"(bid), "+s"(G));
        unsigned char* ws = args.ws; float* out = args.out; asm volatile("" : "+s"(ws), "+s"(out));
        const __attribute__((address_space(4))) fptr_t* kp = (const __attribute__((address_space(4))) fptr_t*)__builtin_amdgcn_kernarg_segment_ptr(); asm volatile("" : "+s"(kp));
        { LAS unsigned char* lb = (LAS unsigned char*)lds_raw; asm volatile("" : "+s"(lb)); F.lds = lb; }
        F.tid = tid; F.lane = tid & 63; F.wave = __builtin_amdgcn_readfirstlane(tid >> 6); F.G = G; F.bid = bid;
        F.inp = kp; F.out = out; F.ws = ws;
        frame_derive(F);
        run_phase(F, ph);
    }
}

extern "C" void kernel_launch(void* const* d_in, const int* in_sizes, int n_in, void* d_out, int out_size, void* d_ws, size_t ws_size, hipStream_t stream) {
    static int grid = 0;
    if (grid == 0) {
        if (n_in != 26 || ws_size < WS_END) { fprintf(stderr, "kernel_launch: unexpected n_in %d or ws_size %zu (< %zu)\n", n_in, ws_size, (size_t)WS_END); grid = -1; return; }
        int dev = 0, cus = 0, per_cu = 0;
        hipGetDevice(&dev); hipDeviceGetAttribute(&cus, hipDeviceAttributeMultiprocessorCount, dev);
        if (hipFuncSetAttribute((const void*)mk_fwd, hipFuncAttributeMaxDynamicSharedMemorySize, LDS_BYTES) != hipSuccess) { fprintf(stderr, "kernel_launch: hipFuncSetAttribute failed\n"); grid = -1; return; }
        if (hipOccupancyMaxActiveBlocksPerMultiprocessor(&per_cu, (const void*)mk_fwd, 512, LDS_BYTES) != hipSuccess || per_cu < 1) { fprintf(stderr, "kernel_launch: occupancy query %d\n", per_cu); per_cu = 1; }
        (void)hipGetLastError();
        grid = cus;
    }
    if (grid < 0) return;
    Args a{};
    for (int i = 0; i < 26; ++i) a.in[i] = (const float*)d_in[i];
    a.out = (float*)d_out; a.ws = (unsigned char*)d_ws;
#if MK_ONE_LAUNCH
    if (hipMemsetAsync((char*)d_ws + WS_BAR, 0, 16384, stream) != hipSuccess) { fprintf(stderr, "kernel_launch: memset failed\n"); return; }
#ifdef PROBE_KIND
    a.ph_lo = 0; a.ph_hi = N_PHASES + (PROBE_KIND == 9 ? 1 : 2);
#else
    a.ph_lo = 0; a.ph_hi = N_PHASES;
#endif
    void* kargs[] = {&a};
    hipError_t e = hipLaunchCooperativeKernel((const void*)mk_fwd, dim3(grid), dim3(512), kargs, LDS_BYTES, stream);
    if (e != hipSuccess) fprintf(stderr, "cooperative launch failed: %s (grid %d)\n", hipGetErrorString(e), grid);
#else
#ifndef RUN_PHASES
#define RUN_PHASES N_PHASES
#endif
    for (int ph = 0; ph < RUN_PHASES; ++ph) {
        a.ph_lo = ph; a.ph_hi = ph + 1;
        hipLaunchKernelGGL(mk_fwd, dim3(grid), dim3(512), LDS_BYTES, stream, a);
    }
#endif
}
```

```cpp
#include <hip/hip_runtime.h>
#include <hip/hip_cooperative_groups.h>
#include <cstdio>
namespace cg = cooperative_groups;

#ifndef MK_ONE_LAUNCH
#define MK_ONE_LAUNCH 1
#endif

#define LAS __attribute__((address_space(3)))
typedef unsigned short bf16_t;
typedef short bf16x8 __attribute__((ext_vector_type(8)));
typedef float f32x4 __attribute__((ext_vector_type(4)));
typedef float f32x2 __attribute__((ext_vector_type(2)));
typedef unsigned u32x4 __attribute__((ext_vector_type(4)));
typedef unsigned u32x2 __attribute__((ext_vector_type(2)));

constexpr int DM = 1024, NBATCH = 8, SEQ = 4096, CTXL = 256, DEPTH = 2;
constexpr int NLAT = NBATCH * SEQ, NCTX = NBATCH * CTXL, MTOT = NLAT + NCTX;
constexpr int NIN = 3072, DFF = 4096, INW = 2848;
constexpr int C_QA = 0, C_KA = 512, C_VA = 1024, C_UA = 1536, C_UG = 1792, C_QG = 2048, C_KG = 2176, C_VG = 2304, C_RG = 2560, C_GF = 2816, C_GB = 2944;
constexpr float EPS = 1e-6f;
constexpr int NCHUNK = 68;
constexpr int NGU = NBATCH * NCHUNK * 4;

constexpr size_t WS_WTIN = 0;
constexpr size_t WS_WTOUT = WS_WTIN + (size_t)DEPTH * NIN * DM * 2;
constexpr size_t WS_WT1 = WS_WTOUT + (size_t)DEPTH * DM * DM * 2;
constexpr size_t WS_WT2 = WS_WT1 + (size_t)DEPTH * DFF * DM * 2;
constexpr size_t WS_WPW = WS_WT2 + (size_t)DEPTH * DFF * DM * 2;
constexpr size_t WS_MOD = WS_WPW + (size_t)DEPTH * 256 * 256 * 2;
constexpr size_t WS_ROPE = WS_MOD + (size_t)DEPTH * 9 * 6144 * 4;
constexpr size_t WS_H = WS_ROPE + 4096;
constexpr size_t WS_U = WS_H + (size_t)MTOT * DM * 2;
constexpr size_t WS_MIX = WS_U + (size_t)MTOT * NIN * 2;
constexpr size_t WS_XC = WS_MIX + (size_t)MTOT * DM * 2;
constexpr size_t WS_DST = WS_XC + (size_t)NCTX * DM * 4;
constexpr size_t WS_DEC = WS_DST + (size_t)NGU * 2 * 2048 * 4;
constexpr size_t WS_SIN = WS_DEC + (size_t)NGU * 2 * 32 * 4;
constexpr size_t WS_GQK = WS_SIN + (size_t)NGU * 2 * 2048 * 2;
constexpr size_t WS_GVT = WS_GQK + (size_t)NGU * 4 * 2048 * 2;
constexpr size_t WS_BAR = WS_GVT + (size_t)NGU * 4096 * 2;
constexpr size_t WS_END = WS_BAR + 16384;
static_assert(WS_END <= (size_t)512 * 1024 * 1024, "workspace too large");
constexpr int LDS_BYTES = 163840;

struct Args { const float* in[26]; float* out; unsigned char* ws; int ph_lo, ph_hi; };

__device__ __forceinline__ float bf2f(bf16_t b) { return __uint_as_float((unsigned)b << 16); }
__device__ __forceinline__ bf16_t f2bf(float f) { unsigned u = __float_as_uint(f); u += 0x7fffu + ((u >> 16) & 1u); return (bf16_t)(u >> 16); }
__device__ __forceinline__ unsigned cvt_pk_bf16(float lo, float hi) { unsigned r; asm volatile("v_cvt_pk_bf16_f32 %0, %1, %2" : "=v"(r) : "v"(lo), "v"(hi)); return r; }
__device__ __forceinline__ float sigmoidf_(float x) { return __builtin_amdgcn_rcpf(1.0f + __expf(-x)); }
__device__ __forceinline__ float siluf_(float x) { return x * __builtin_amdgcn_rcpf(1.0f + __expf(-x)); }
__device__ __forceinline__ float logsigmoidf_(float x) { return x < -30.f ? x : -__logf(1.0f + __expf(-x)); }
__device__ __forceinline__ f32x4 mfma16(bf16x8 a, bf16x8 b, f32x4 c) { return __builtin_amdgcn_mfma_f32_16x16x32_bf16(a, b, c, 0, 0, 0); }

__device__ __forceinline__ float wave_scan_incl(float x) {
    float t;
    t = __int_as_float(__builtin_amdgcn_update_dpp(0, __float_as_int(x), 0x111, 0xf, 0xf, true)); x += t;
    t = __int_as_float(__builtin_amdgcn_update_dpp(0, __float_as_int(x), 0x112, 0xf, 0xf, true)); x += t;
    t = __int_as_float(__builtin_amdgcn_update_dpp(0, __float_as_int(x), 0x114, 0xf, 0xf, true)); x += t;
    t = __int_as_float(__builtin_amdgcn_update_dpp(0, __float_as_int(x), 0x118, 0xf, 0xf, true)); x += t;
    t = __int_as_float(__builtin_amdgcn_update_dpp(0, __float_as_int(x), 0x142, 0xa, 0xf, false)); x += t;
    t = __int_as_float(__builtin_amdgcn_update_dpp(0, __float_as_int(x), 0x143, 0xc, 0xf, false)); x += t;
    return x;
}
#define SHX(x, m) __int_as_float(__builtin_amdgcn_ds_bpermute((F.lane ^ (m)) << 2, __float_as_int(x)))
namespace pg8 {
constexpr int BM = 256, BK = 64, HALF = 128, HTB = HALF * BK * 2, STAGE_BYTES = 8 * HTB, NXCD = 8, WGM = 8;
__host__ __device__ __forceinline__ int lds_byte(int r, int c) { const int st = (r >> 4) * 2 + (c >> 5), rr = r & 15, cc = c & 31, ob = rr * 64 + cc * 2; return st * 1024 + (ob ^ (((ob >> 9) & 1) << 5)); }
__host__ __device__ __forceinline__ void stage_rc(int b, int& R, int& C) { const int st = b / 1024, sb = b % 1024, swz = sb ^ (((sb >> 9) & 1) << 5); R = (st >> 1) * 16 + swz / 64; C = (st & 1) * 32 + (swz % 64) / 2; }
__host__ __device__ __forceinline__ int perm32(int rho) { const int n = rho >> 4, i = rho & 15; return 8 * (i >> 2) + 4 * n + (i & 3); }
struct Unit { int pm, pn, kt0, nt, split, sp; };
struct Gemm { const bf16_t* A; const bf16_t* Bt; int M, N, K; };
struct StaticOrder {
    int nM, nN, nwg, G, c, ntK, nsplit_tiles, ns;
    __device__ __forceinline__ void init(int M, int N, int G_, int c_, int K) { nM = M / BM; nN = N / BM; nwg = nM * nN; G = G_; c = c_; ntK = K / BK; nsplit_tiles = 0; ns = 1; }
    __device__ __forceinline__ void add_split(int ntiles, int ns_) { nsplit_tiles = ntiles; ns = ns_; }
    __device__ __forceinline__ bool next(int i, Unit& u) const {
        const long L = (long)i * G + c;
        const bool sp = L >= nwg;
        const int sidx = sp ? (int)(L - nwg) : 0;
        const bool ok = !sp || sidx < nsplit_tiles * ns;
        const int tile = sidx / ns, spi = sidx % ns;
        int wgid = sp ? 0 : (int)L; { const int q = nwg / NXCD, r = nwg % NXCD, xcd = wgid % NXCD, off = wgid / NXCD; wgid = (xcd < r ? xcd * (q + 1) : r * (q + 1) + (xcd - r) * q) + off; }
        const int nig = WGM * nN, gid = wgid / nig, fm = gid * WGM, gsz = (nM - fm) < WGM ? (nM - fm) : WGM;
        const int pm_f = fm + ((wgid % nig) % gsz), pn_f = (wgid % nig) / gsz;
        const int nts = ntK / ns;
        u.pm = sp ? nM + tile / nN : pm_f; u.pn = sp ? tile % nN : pn_f; u.nt = sp ? nts : ntK; u.kt0 = sp ? spi * nts : 0; u.split = sp ? 1 : 0; u.sp = spi;
        return ok;
    }
    __device__ __forceinline__ void a_ready(const Unit&) const {}
    __device__ __forceinline__ void done(const Unit&) const {}
};
template <int ACT  > struct EpiBf16 {
    static constexpr bool PERM = true;
    bf16_t* O; int ldc;
    __device__ __forceinline__ void operator()(const f32x4 (&acc)[2][2][4][2], const Unit& u, int wr, int wc, int fr, int fq) const {
        const int row0 = u.pm * BM + wr * 64 + fr; const int col0 = u.pn * BM + wc * 32 + 8 * fq;
#pragma unroll
        for (int ai = 0; ai < 2; ++ai)
#pragma unroll
            for (int m = 0; m < 4; ++m) { bf16_t* rowp = O + (size_t)(row0 + ai * HALF + m * 16) * ldc + col0;
#pragma unroll
                for (int bj = 0; bj < 2; ++bj) { f32x4 v0 = acc[ai][bj][m][0], v1 = acc[ai][bj][m][1];
                    if (ACT == 1) {
#pragma unroll
                        for (int j = 0; j < 4; ++j) { float a = fmaxf(v0[j], 0.f), b = fmaxf(v1[j], 0.f); v0[j] = a * a; v1[j] = b * b; } }
                    u32x4 w; w.x = cvt_pk_bf16(v0[0], v0[1]); w.y = cvt_pk_bf16(v0[2], v0[3]); w.z = cvt_pk_bf16(v1[0], v1[1]); w.w = cvt_pk_bf16(v1[2], v1[3]);
                    *(u32x4*)(rowp + bj * HALF) = w; } }
    }
};
struct EpiResid {
    static constexpr bool PERM = false;
    const float* base_lat; const float* base_ctx; float* out_lat; float* out_ctx; const float* mod; int goff; float* part;
    __device__ __forceinline__ void operator()(const f32x4 (&acc)[2][2][4][2], const Unit& u, int wr, int wc, int fr, int fq) const {
        const bool lat = u.pm < (NLAT / BM);
        const float* bp = lat ? base_lat + (size_t)u.pm * BM * DM : base_ctx + (size_t)(u.pm - NLAT / BM) * BM * DM;
        float* op = lat ? out_lat + (size_t)u.pm * BM * DM : out_ctx + (size_t)(u.pm - NLAT / BM) * BM * DM;
        const float* g = mod + (lat ? (u.pm >> 4) : 8) * 6144 + goff;
        const int col0 = u.pn * BM + wc * 32 + 4 * fq;
        f32x4 gv[2][2];
#pragma unroll
        for (int bj = 0; bj < 2; ++bj)
#pragma unroll
            for (int n = 0; n < 2; ++n) gv[bj][n] = *(const f32x4*)(g + col0 + bj * HALF + n * 16);
#pragma unroll
        for (int ai = 0; ai < 2; ++ai)
#pragma unroll
            for (int m = 0; m < 4; ++m) { const size_t ro = (size_t)(wr * 64 + fr + ai * HALF + m * 16) * DM + col0;
#pragma unroll
                for (int bj = 0; bj < 2; ++bj)
#pragma unroll
                    for (int n = 0; n < 2; ++n) {
                        if (u.split) *(f32x4*)(part + (size_t)u.sp * NCTX * DM + (size_t)(u.pm - NLAT / BM) * BM * DM + ro + bj * HALF + n * 16) = gv[bj][n] * acc[ai][bj][m][n];
                        else { const f32x4 bs = *(const f32x4*)(bp + ro + bj * HALF + n * 16); *(f32x4*)(op + ro + bj * HALF + n * 16) = bs + gv[bj][n] * acc[ai][bj][m][n]; } }
                asm volatile("" ::: "memory"); }
    }
};

template <class Epi, class Sched>
__device__ __forceinline__ void gemm_phase(LAS unsigned char* lds, const int tid, const Gemm g, const Sched& S, const Epi& E) {
    const int wid = __builtin_amdgcn_readfirstlane(tid >> 6), lane = tid & 63, wr = wid >> 2, wc = wid & 3, fr = lane & 15, fq = lane >> 4;
    const int K = g.K;
    unsigned voffA[2], voffB[2];
#pragma unroll
    for (int i = 0; i < 2; ++i) { int R, C; stage_rc(tid * 16 + i * 8192, R, C); const int Rb = Epi::PERM ? ((R & ~31) + perm32(R & 31)) : R;
        voffA[i] = (unsigned)(R * K + C) * 2u; voffB[i] = (unsigned)(Rb * K + C) * 2u; }
    const size_t kstep = (size_t)(BK * 2);
    const size_t hstep = (size_t)HALF * K * 2;
    const size_t tstep = 2 * hstep;
    const unsigned ldsw = (unsigned)wid * 1024u;
    const int aoff = lds_byte(wr * 64 + fr, fq * 8), boff = lds_byte(wc * 32 + fr, fq * 8);
#define PG8_SA(b, h) (((b) * 2 + (h)) * HTB)
#define PG8_SB(b, h) ((4 + (b) * 2 + (h)) * HTB)
#define PG8_STAGE(bufoff, gbase, voff) do { _Pragma("unroll") for (int _i = 0; _i < 2; ++_i) \
        __builtin_amdgcn_global_load_lds((const unsigned*)((const char*)(gbase) + (voff)[_i]), (LAS unsigned*)(lds + (bufoff) + ldsw + _i * 8192), 16, 0, 0); } while (0)
#define PG8_LDA(dst, b, h) do { _Pragma("unroll") for (int m = 0; m < 4; ++m) _Pragma("unroll") for (int k = 0; k < 2; ++k) dst[m][k] = *(const LAS bf16x8*)(lds + PG8_SA(b, h) + aoff + m * 2048 + k * 1024); } while (0)
#define PG8_LDB(dst, b, h) do { _Pragma("unroll") for (int n = 0; n < 2; ++n) _Pragma("unroll") for (int k = 0; k < 2; ++k) dst[n][k] = *(const LAS bf16x8*)(lds + PG8_SB(b, h) + boff + n * 2048 + k * 1024); } while (0)
#define PG8_MMA(ai, bj, At, Bt) do { __builtin_amdgcn_s_setprio(1); _Pragma("unroll") for (int m = 0; m < 4; ++m) _Pragma("unroll") for (int n = 0; n < 2; ++n) _Pragma("unroll") for (int k = 0; k < 2; ++k) \
        acc[ai][bj][m][n] = __builtin_amdgcn_mfma_f32_16x16x32_bf16(Bt[n][k], At[m][k], acc[ai][bj][m][n], 0, 0, 0); __builtin_amdgcn_s_setprio(0); } while (0)
#define PG8_WAIT_V(n) asm volatile("s_waitcnt vmcnt(" #n ")" ::: "memory")
#define PG8_WAIT_L(n) asm volatile("s_waitcnt lgkmcnt(" #n ")" ::: "memory")
#define PG8_BAR __builtin_amdgcn_s_barrier()
#define PG8_SCHED __builtin_amdgcn_sched_barrier(0)
    Unit cur, nxt; int ui = 0;
    if (!S.next(0, cur)) return;
    f32x4 acc[2][2][4][2];
#pragma unroll
    for (int a = 0; a < 2; ++a)
#pragma unroll
        for (int b = 0; b < 2; ++b)
#pragma unroll
            for (int m = 0; m < 4; ++m)
#pragma unroll
                for (int n = 0; n < 2; ++n) acc[a][b][m][n] = (f32x4){0.f, 0.f, 0.f, 0.f};
    bf16x8 At[4][2], B0[2][2], B1[2][2];
    const char* cA = (const char*)g.A + (size_t)cur.pm * tstep + (size_t)cur.kt0 * kstep; const char* cB = (const char*)g.Bt + (size_t)cur.pn * tstep + (size_t)cur.kt0 * kstep;
    S.a_ready(cur);
    PG8_STAGE(PG8_SB(0, 0), cB, voffB); PG8_STAGE(PG8_SA(0, 0), cA, voffA); PG8_STAGE(PG8_SB(0, 1), cB + hstep, voffB); PG8_STAGE(PG8_SA(0, 1), cA + hstep, voffA);
    if (wr == 1) PG8_BAR;
    PG8_WAIT_V(4); PG8_BAR;
    PG8_STAGE(PG8_SB(1, 0), cB + kstep, voffB); PG8_STAGE(PG8_SA(1, 0), cA + kstep, voffA); PG8_STAGE(PG8_SB(1, 1), cB + hstep + kstep, voffB);
    PG8_WAIT_V(6); PG8_BAR;
    for (;;) {
        const bool has_next = S.next(ui + 1, nxt);
        const char* nA = has_next ? (const char*)g.A + (size_t)nxt.pm * tstep + (size_t)nxt.kt0 * kstep : cA; const char* nB = has_next ? (const char*)g.Bt + (size_t)nxt.pn * tstep + (size_t)nxt.kt0 * kstep : cB;
        const int nt = cur.nt;
        for (int t = 0; t < nt; t += 2) {
            const bool last = (t == nt - 2);
            const char* a1 = cA + (size_t)(t + 1) * kstep;
            const char* a2 = last ? nA : cA + (size_t)(t + 2) * kstep; const char* b2 = last ? nB : cB + (size_t)(t + 2) * kstep;
            const char* a3 = a2 + kstep; const char* b3 = b2 + kstep;
            if (last && has_next) S.a_ready(nxt);
            PG8_LDB(B0, 0, 0); PG8_SCHED; PG8_LDA(At, 0, 0); PG8_STAGE(PG8_SA(1, 1), a1 + hstep, voffA);
            PG8_WAIT_L(8); PG8_BAR; PG8_WAIT_L(0); PG8_MMA(0, 0, At, B0); PG8_BAR; PG8_SCHED;
            PG8_LDB(B1, 0, 1); PG8_STAGE(PG8_SB(0, 0), b2, voffB);
            PG8_BAR; PG8_WAIT_L(0); PG8_MMA(0, 1, At, B1); PG8_BAR;
            PG8_LDA(At, 0, 1); PG8_STAGE(PG8_SA(0, 0), a2, voffA);
            PG8_BAR; PG8_WAIT_L(0); PG8_MMA(1, 0, At, B0); PG8_BAR; PG8_SCHED;
            PG8_STAGE(PG8_SB(0, 1), b2 + hstep, voffB);
            PG8_WAIT_V(6); PG8_BAR; PG8_MMA(1, 1, At, B1); PG8_BAR;
            PG8_LDB(B0, 1, 0); PG8_SCHED; PG8_LDA(At, 1, 0); PG8_STAGE(PG8_SA(0, 1), a2 + hstep, voffA);
            PG8_WAIT_L(8); PG8_BAR; PG8_WAIT_L(0); PG8_MMA(0, 0, At, B0); PG8_BAR; PG8_SCHED;
            PG8_LDB(B1, 1, 1); PG8_STAGE(PG8_SB(1, 0), b3, voffB);
            PG8_BAR; PG8_WAIT_L(0); PG8_MMA(0, 1, At, B1); PG8_BAR;
            PG8_LDA(At, 1, 1); PG8_STAGE(PG8_SA(1, 0), a3, voffA);
            PG8_BAR; PG8_WAIT_L(0); PG8_MMA(1, 0, At, B0); PG8_BAR; PG8_SCHED;
            PG8_STAGE(PG8_SB(1, 1), b3 + hstep, voffB);
            PG8_WAIT_V(6); PG8_BAR; PG8_MMA(1, 1, At, B1); PG8_BAR;
        }
        E(acc, cur, wr, wc, fr, fq); S.done(cur);
        if (!has_next) break;
#pragma unroll
        for (int a = 0; a < 2; ++a)
#pragma unroll
            for (int b = 0; b < 2; ++b)
#pragma unroll
                for (int m = 0; m < 4; ++m)
#pragma unroll
                    for (int n = 0; n < 2; ++n) acc[a][b][m][n] = (f32x4){0.f, 0.f, 0.f, 0.f};
        cur = nxt; cA = nA; cB = nB; ++ui;
    }
    PG8_WAIT_V(0);
    if (wr == 0) PG8_BAR;
    PG8_BAR;
#undef PG8_SA
#undef PG8_SB
#undef PG8_STAGE
#undef PG8_LDA
#undef PG8_LDB
#undef PG8_MMA
#undef PG8_WAIT_V
#undef PG8_WAIT_L
#undef PG8_BAR
#undef PG8_SCHED
}
}

typedef const float* fptr_t;
struct Frame {
    LAS unsigned char* lds; int tid, lane, wave, G, bid;
    const __attribute__((address_space(4))) fptr_t* inp; float* out; unsigned char* ws;
    __device__ __forceinline__ const float* IN(int i) const { return inp[i]; }
    bf16_t *WtIn, *WtOut, *Wt1, *Wt2, *Wpw, *H, *U, *MIX, *HID, *SinT;
    float *mod, *rope, *XC, *dST, *dec;
    bf16_t *GQK, *GVT;
};

__device__ __forceinline__ void frame_derive(Frame& F) {
    unsigned char* ws = F.ws;
    F.lane = F.tid & 63; F.wave = __builtin_amdgcn_readfirstlane(F.tid >> 6);
    F.WtIn = (bf16_t*)(ws + WS_WTIN); F.WtOut = (bf16_t*)(ws + WS_WTOUT); F.Wt1 = (bf16_t*)(ws + WS_WT1); F.Wt2 = (bf16_t*)(ws + WS_WT2); F.Wpw = (bf16_t*)(ws + WS_WPW);
    F.mod = (float*)(ws + WS_MOD); F.rope = (float*)(ws + WS_ROPE); F.H = (bf16_t*)(ws + WS_H); F.U = (bf16_t*)(ws + WS_U); F.MIX = (bf16_t*)(ws + WS_MIX); F.HID = (bf16_t*)(ws + WS_U);
    F.XC = (float*)(ws + WS_XC); F.dST = (float*)(ws + WS_DST); F.dec = (float*)(ws + WS_DEC); F.SinT = (bf16_t*)(ws + WS_SIN); F.GQK = (bf16_t*)(ws + WS_GQK); F.GVT = (bf16_t*)(ws + WS_GVT);
}
__device__ __forceinline__ void frame_refresh(Frame& F) {
    asm volatile("" : "+v"(F.tid)); asm volatile("" : "+s"(F.ws), "+s"(F.out), "+s"(F.inp), "+s"(F.bid), "+s"(F.G), "+s"(F.lds));
    frame_derive(F);
}
__device__ __forceinline__ void transpose_tile(Frame& F, const float* src, int lds_, int k0, int n0, bf16_t* dst, int ldd) {
    LAS float* T = (LAS float*)F.lds;
    const int r = F.tid >> 4, c4 = (F.tid & 15) * 4;
#pragma unroll
    for (int p = 0; p < 2; ++p) { const int rr = r + p * 32; const f32x4 v = *(const f32x4*)(src + (size_t)(k0 + rr) * lds_ + n0 + c4);
        T[rr * 65 + c4] = v[0]; T[rr * 65 + c4 + 1] = v[1]; T[rr * 65 + c4 + 2] = v[2]; T[rr * 65 + c4 + 3] = v[3]; }
    __syncthreads();
    const int n = F.tid >> 3, kk = (F.tid & 7) * 8;
    u32x4 w;
    w.x = cvt_pk_bf16(T[(kk + 0) * 65 + n], T[(kk + 1) * 65 + n]); w.y = cvt_pk_bf16(T[(kk + 2) * 65 + n], T[(kk + 3) * 65 + n]);
    w.z = cvt_pk_bf16(T[(kk + 4) * 65 + n], T[(kk + 5) * 65 + n]); w.w = cvt_pk_bf16(T[(kk + 6) * 65 + n], T[(kk + 7) * 65 + n]);
    *(u32x4*)(dst + (size_t)(n0 + n) * ldd + k0 + kk) = w;
    __syncthreads();
}

__device__ __forceinline__ void ada_tile(Frame& F, int l, int cgp) {
    LAS float* sc = (LAS float*)F.lds;
    LAS float* red = (LAS float*)(F.lds + 36864);
    const float* c = F.IN(1); const float* cc = F.IN(3);
    for (int i = F.tid; i < 9216; i += 512) { const int j = i >> 10, k = i & 1023; const float v = j < 8 ? c[j * 1024 + k] : cc[k]; sc[i] = siluf_(v); }
    __syncthreads();
    const int n0 = cgp * 64;
    const float* w = F.IN(4) + (size_t)l * 1024 * 6144 + n0 + F.lane;
    float acc[9];
#pragma unroll
    for (int j = 0; j < 9; ++j) acc[j] = 0.f;
    const int kb = F.wave * 128;
#pragma unroll 8
    for (int k = 0; k < 128; ++k) { const float wv = w[(size_t)(kb + k) * 6144];
#pragma unroll
        for (int j = 0; j < 9; ++j) acc[j] += sc[j * 1024 + kb + k] * wv; }
#pragma unroll
    for (int j = 0; j < 9; ++j) red[(F.wave * 9 + j) * 64 + F.lane] = acc[j];
    __syncthreads();
    for (int i = F.tid; i < 576; i += 512) { const int j = i >> 6, col = i & 63; float s = F.IN(5)[l * 6144 + n0 + col];
#pragma unroll
        for (int w8 = 0; w8 < 8; ++w8) s += red[(w8 * 9 + j) * 64 + col];
        F.mod[(size_t)(l * 9 + j) * 6144 + n0 + col] = s; }
    __syncthreads();
}

__device__ __forceinline__ void gate_tile(Frame& F, int l, int kb) {
    const int k = kb * 64 + (F.tid & 63);
    const float* wrow = F.IN(7) + ((size_t)l * 1024 + k) * INW + 2816;
    float z[32];
#pragma unroll
    for (int i = 0; i < 8; ++i) { const f32x4 v = *(const f32x4*)(wrow + 4 * i); z[4 * i] = v[0]; z[4 * i + 1] = v[1]; z[4 * i + 2] = v[2]; z[4 * i + 3] = v[3]; }
    for (int idx = 0; idx < 32; ++idx) {
        const int n = (F.tid >> 6) + 8 * idx, dir = n >> 7, nn = n & 127;
        const float* gw = (dir ? F.IN(19) : F.IN(17)) + (size_t)l * 16 * 128 + nn;
        float s = 0.f;
        if (dir == 0) {
#pragma unroll
            for (int r = 0; r < 16; ++r) s += z[r] * gw[r * 128];
        } else {
#pragma unroll
            for (int r = 0; r < 16; ++r) s += z[16 + r] * gw[r * 128];
        }
        F.WtIn[((size_t)l * NIN + 2816 + n) * DM + k] = f2bf(s);
    }
}

__device__ void phase_setup(Frame& F) {
    constexpr int N_ADA = 192, N_GATE = 32, N_ROPE = 1, TPL = 704 + 256 + 1024 + 1024 + 16, N_TR = 2 * TPL;
    constexpr int N_ITEMS = N_ADA + N_GATE + N_ROPE + N_TR;
    for (int it = F.bid; it < N_ITEMS; it += F.G) {
        frame_refresh(F);
        if (it < N_ADA) { ada_tile(F, it / 96, it % 96); continue; }
        int i = it - N_ADA;
        if (i < N_GATE) { gate_tile(F, i >> 4, i & 15); continue; }
        i -= N_GATE;
        if (i < N_ROPE) {
            const int p = F.tid >> 3, f = F.tid & 7;
            const float inv = powf(10000.0f, -(float)f / 8.0f); const float ang = (float)p * inv;
            F.rope[F.tid] = cosf(ang); F.rope[512 + F.tid] = sinf(ang);
            continue; }
        i -= N_ROPE;
        const int l = i / TPL; int j = i % TPL;
        if (j < 704) { transpose_tile(F, F.IN(7) + (size_t)l * DM * INW, INW, (j / 44) * 64, (j % 44) * 64, F.WtIn + (size_t)l * NIN * DM, DM); continue; }
        j -= 704;
        if (j < 256) { transpose_tile(F, F.IN(22) + (size_t)l * DM * DM, DM, (j / 16) * 64, (j % 16) * 64, F.WtOut + (size_t)l * DM * DM, DM); continue; }
        j -= 256;
        if (j < 1024) { transpose_tile(F, F.IN(24) + (size_t)l * DM * DFF, DFF, (j / 64) * 64, (j % 64) * 64, F.Wt1 + (size_t)l * DFF * DM, DM); continue; }
        j -= 1024;
        if (j < 1024) { transpose_tile(F, F.IN(25) + (size_t)l * DFF * DM, DM, (j / 16) * 64, (j % 16) * 64, F.Wt2 + (size_t)l * DM * DFF, DFF); continue; }
        j -= 1024;
        transpose_tile(F, F.IN(15) + (size_t)l * 65536, 256, (j / 4) * 64, (j % 4) * 64, F.Wpw + (size_t)l * 65536, 256);
    }
}

__device__ void phase_prep(Frame& F, const float* src_lat, const float* src_ctx, const float* modl, int off_sh, int off_sc, const float* gvec, int M, int nparts) {
    for (int row = F.bid * 8 + F.wave; row < M; row += F.G * 8) {
        const float* xp = row < NLAT ? src_lat + (size_t)row * DM : src_ctx + (size_t)(row - NLAT) * DM;
        const float* mp = modl + (row < NLAT ? (row >> 12) : 8) * 6144;
        f32x4 v[4], gq[4], shq[4], scq[4]; float ss = 0.f;
#pragma unroll
        for (int i = 0; i < 4; ++i) { const int c = i * 256 + F.lane * 4;
            gq[i] = *(const f32x4*)(gvec + c); shq[i] = *(const f32x4*)(mp + off_sh + c); scq[i] = *(const f32x4*)(mp + off_sc + c); }
#pragma unroll
        for (int i = 0; i < 4; ++i) { v[i] = *(const f32x4*)(xp + i * 256 + F.lane * 4);
            if (nparts > 0 && row >= NLAT) {
                const float* pp = F.dST + (size_t)(row - NLAT) * DM + i * 256 + F.lane * 4;
                for (int sp = 0; sp < nparts; ++sp) v[i] += *(const f32x4*)(pp + (size_t)sp * NCTX * DM);
                *(f32x4*)(F.XC + (size_t)(row - NLAT) * DM + i * 256 + F.lane * 4) = v[i]; }
            ss += v[i][0] * v[i][0] + v[i][1] * v[i][1] + v[i][2] * v[i][2] + v[i][3] * v[i][3]; }
#pragma unroll
        for (int o = 1; o < 64; o <<= 1) ss += SHX(ss, o);
        const float r = rsqrtf(ss * (1.0f / DM) + EPS);
#pragma unroll
        for (int i = 0; i < 4; ++i) { const int c = i * 256 + F.lane * 4;
            const f32x4 g = gq[i], sh = shq[i], sc = scq[i];
            f32x4 y;
#pragma unroll
            for (int j = 0; j < 4; ++j) y[j] = v[i][j] * r * g[j] * (1.0f + sc[j]) + sh[j];
            u32x2 w; w.x = cvt_pk_bf16(y[0], y[1]); w.y = cvt_pk_bf16(y[2], y[3]);
            *(u32x2*)(F.H + (size_t)row * DM + c) = w; }
    }
}

constexpr int NSLOT = 11;
constexpr int VTL_STRIDE = NSLOT * 64 + 8, VTC_STRIDE = 264;
constexpr int NA_VTL = 0, NA_VTC = NA_VTL + 64 * VTL_STRIDE * 2, NA_RPB = NA_VTC + 64 * VTC_STRIDE * 2, NA_RKL = NA_RPB + 1920, NA_RKC = NA_RKL + NSLOT * 64 * 4, NA_GQ = NA_RKC + 1024, NA_KC = NA_GQ + 256, NA_END = NA_KC + 32768;
static_assert(NA_END <= LDS_BYTES - 16, "na lds");

__device__ __forceinline__ float sumsq8(bf16x8 v) { float s = 0.f;
#pragma unroll
    for (int i = 0; i < 8; ++i) { const float f = bf2f((bf16_t)v[i]); s += f * f; } return s; }

__device__ __forceinline__ void na_qfrag(Frame& F, int h, const bf16_t* qrowp, bf16x8 (&qf)[2]) {
    const int fq = F.lane >> 4;
    const bf16x8 q0 = *(const bf16x8*)(qrowp + C_QA + h * 64 + 8 * fq), q1 = *(const bf16x8*)(qrowp + C_QA + h * 64 + 32 + 8 * fq);
    float ss = sumsq8(q0) + sumsq8(q1); ss += SHX(ss, 16); ss += SHX(ss, 32);
    const float rq = rsqrtf(ss * (1.0f / 64.0f) + EPS);
    LAS float* GQ = (LAS float*)(F.lds + NA_GQ);
    const f32x4 g0 = *(const LAS f32x4*)(GQ + 8 * fq), g1 = *(const LAS f32x4*)(GQ + 8 * fq + 4), g2 = *(const LAS f32x4*)(GQ + 32 + 8 * fq), g3 = *(const LAS f32x4*)(GQ + 36 + 8 * fq);
#pragma unroll
    for (int i = 0; i < 4; ++i) {
        qf[0][i] = (short)f2bf(bf2f((bf16_t)q0[i]) * rq * g0[i]); qf[0][4 + i] = (short)f2bf(bf2f((bf16_t)q0[4 + i]) * rq * g1[i]);
        qf[1][i] = (short)f2bf(bf2f((bf16_t)q1[i]) * rq * g2[i]); qf[1][4 + i] = (short)f2bf(bf2f((bf16_t)q1[4 + i]) * rq * g3[i]); }
}

template <bool LOCAL>
__device__ __forceinline__ void na_wave(Frame& F, int h, const bf16x8 (&qf)[2], const bf16_t* kbase  ,
                                        int qb, int kc0, int ro0, LAS bf16_t* VT, int vstride, int vrow0, f32x4 (&o)[4], float& mrow, float& lrow) {
    constexpr int ntile = 16, tile_base = 0;
    const int fr = F.lane & 15, fq = F.lane >> 4;
    const unsigned klane = (unsigned)(fr * NIN + C_KA + h * 64 + 8 * fq);
    bf16x8 kb[4][2][2];
#define NA_LOADB(bi, buf) do { _Pragma("unroll") for (int tt = 0; tt < 2; ++tt) { const int t_ = (bi) * 2 + tt; if (t_ < ntile) { \
        const bf16_t* tbp = LOCAL ? kbase + (size_t)((t_ >> 1) * 64 + (t_ & 1) * 16) * NIN : kbase + (size_t)((tile_base + t_) * 16) * NIN; \
        if (LOCAL) { kb[buf][tt][0] = *(const bf16x8*)(tbp + klane); kb[buf][tt][1] = *(const bf16x8*)(tbp + klane + 32); } \
        else { kb[buf][tt][0] = *(const LAS bf16x8*)(F.lds + NA_KC + ((t_ * 2) * 64 + F.lane) * 16); kb[buf][tt][1] = *(const LAS bf16x8*)(F.lds + NA_KC + ((t_ * 2 + 1) * 64 + F.lane) * 16); } } } } while (0)
    if (LOCAL) { NA_LOADB(0, 0); NA_LOADB(1, 1); NA_LOADB(2, 2); }
    LAS float* rpb = (LAS float*)(F.lds + NA_RPB);
    LAS float* RKL = (LAS float*)(F.lds + NA_RKL); LAS float* RKC = (LAS float*)(F.lds + NA_RKC);
    int bo[2][4];
    if (LOCAL) {
        const int qcol = 16 * qb + fr; int cs = qcol - 8; cs = cs < 0 ? 0 : (cs > 48 ? 48 : cs);
#pragma unroll
        for (int hc = 0; hc < 2; ++hc)
#pragma unroll
            for (int j = 0; j < 4; ++j) { const int keycol = kc0 + 16 * hc + 4 * fq + j; bo[hc][j] = (keycol >= cs && keycol < cs + 16) ? keycol - qcol + 15 : 31; }
    }
    f32x4 sc[16];
#pragma unroll
    for (int bi = 0; bi < 8; ++bi) {
        asm volatile("" ::: "memory");
        if (LOCAL && bi + 3 < 8) NA_LOADB(bi + 3, (bi + 3) & 3);
        asm volatile("" ::: "memory");
#pragma unroll
        for (int tt = 0; tt < 2; ++tt) {
            const int t = bi * 2 + tt;
            sc[t] = (f32x4){-1e30f, -1e30f, -1e30f, -1e30f};
            if (t < ntile) {
                const f32x4 rk = LOCAL ? *(const LAS f32x4*)(RKL + ((vrow0 + (t >> 1)) % NSLOT) * 64 + kc0 + 16 * (t & 1) + 4 * fq) : *(const LAS f32x4*)(RKC + (tile_base + t) * 16 + 4 * fq);
                f32x4 a = (f32x4){0.f, 0.f, 0.f, 0.f};
                if (LOCAL) { a = mfma16(kb[bi & 3][tt][0], qf[0], a); a = mfma16(kb[bi & 3][tt][1], qf[1], a); }
                else { a = mfma16(*(const LAS bf16x8*)(F.lds + NA_KC + ((t * 2) * 64 + F.lane) * 16), qf[0], a); a = mfma16(*(const LAS bf16x8*)(F.lds + NA_KC + ((t * 2 + 1) * 64 + F.lane) * 16), qf[1], a); }
#pragma unroll
                for (int j = 0; j < 4; ++j) {
                    float sv = a[j] * rk[j];
                    if (LOCAL) sv += rpb[(ro0 + (t >> 1)) * 32 + bo[t & 1][j]];
                    sc[t][j] = sv;
                }
            }
        }
    }
#undef NA_LOADB
    {
        float m = -1e30f;
#pragma unroll
        for (int t = 0; t < 16; ++t) m = fmaxf(fmaxf(fmaxf(m, sc[t][0]), fmaxf(sc[t][1], sc[t][2])), sc[t][3]);
        m = fmaxf(m, SHX(m, 16)); m = fmaxf(m, SHX(m, 32));
        float sm = 0.f;
#pragma unroll
        for (int t = 0; t < 16; ++t)
#pragma unroll
            for (int j = 0; j < 4; ++j) { const float p = __builtin_amdgcn_exp2f(sc[t][j] - m); sc[t][j] = p; sm += p; }
        sm += SHX(sm, 16); sm += SHX(sm, 32);
        mrow = m; lrow = sm;
    }
    int vo[LOCAL ? 1 : 2][2][4];
#pragma unroll
    for (int par = 0; par < (LOCAL ? 1 : 2); ++par)
#pragma unroll
        for (int hc = 0; hc < 2; ++hc)
#pragma unroll
            for (int nb = 0; nb < 4; ++nb) { const int d = nb * 16 + fr;
                vo[par][hc][nb] = d * vstride + (((LOCAL ? kc0 : 32 * par) + 16 * hc + 4 * fq) ^ (((d >> 3) & 7) << 3)) + (LOCAL ? 0 : tile_base * 16);
                asm volatile("" : "+v"(vo[par][hc][nb])); }
#pragma unroll
    for (int nb = 0; nb < 4; ++nb) o[nb] = (f32x4){0.f, 0.f, 0.f, 0.f};
#pragma unroll
    for (int ks = 0; ks < 8; ++ks) {
        if (2 * ks < ntile) {
            union { bf16x8 v; unsigned u[4]; } pb;
            pb.u[0] = cvt_pk_bf16(sc[2 * ks][0], sc[2 * ks][1]); pb.u[1] = cvt_pk_bf16(sc[2 * ks][2], sc[2 * ks][3]);
            pb.u[2] = cvt_pk_bf16(sc[2 * ks + 1][0], sc[2 * ks + 1][1]); pb.u[3] = cvt_pk_bf16(sc[2 * ks + 1][2], sc[2 * ks + 1][3]);
            const int kso = LOCAL ? ((vrow0 + ks) % NSLOT) * 64 : (ks >> 1) * 64;
#pragma unroll
            for (int nb = 0; nb < 4; ++nb) {
                union { bf16x8 v; u32x2 h2[2]; } va;
                va.h2[0] = *(const LAS u32x2*)(VT + vo[LOCAL ? 0 : (ks & 1)][0][nb] + kso);
                va.h2[1] = *(const LAS u32x2*)(VT + vo[LOCAL ? 0 : (ks & 1)][1][nb] + kso);
                o[nb] = mfma16(va.v, pb.v, o[nb]); }
        }
    }
}

__device__ __forceinline__ void stage_ctx(Frame& F, const bf16_t* ctx0, int h, int l) {
    LAS bf16_t* VTC = (LAS bf16_t*)(F.lds + NA_VTC); LAS float* RKC = (LAS float*)(F.lds + NA_RKC);
    if (F.tid < 64) ((LAS float*)(F.lds + NA_GQ))[F.tid] = F.IN(8)[l * 64 + F.tid] * F.IN(9)[l * 64 + F.tid] * (0.125f * 1.4426950408889634f);
#pragma unroll
    for (int it = 0; it < 4; ++it) {
        const int item = it * 512 + F.tid, key = item >> 3, dg = item & 7;
        const bf16x8 v = *(const bf16x8*)(ctx0 + (size_t)key * NIN + C_VA + h * 64 + dg * 8);
        const bf16x8 kk = *(const bf16x8*)(ctx0 + (size_t)key * NIN + C_KA + h * 64 + dg * 8);
        const int kx = key ^ (dg << 3);
#pragma unroll
        for (int i = 0; i < 8; ++i) VTC[(dg * 8 + i) * VTC_STRIDE + kx] = (bf16_t)v[i];
        *(LAS bf16x8*)(F.lds + NA_KC + ((((key >> 4) * 2 + (dg >> 2)) * 64) + (dg & 3) * 16 + (key & 15)) * 16) = kk;
        float ss = sumsq8(kk); ss += SHX(ss, 1); ss += SHX(ss, 2); ss += SHX(ss, 4);
        if (dg == 0) RKC[key] = rsqrtf(ss * (1.0f / 64.0f) + EPS);
    }
}

__device__ __forceinline__ void na_store(Frame& F, int h, int qrow0, const f32x4 (&o)[4], float inv) {
    const int fr = F.lane & 15, fq = F.lane >> 4;
    bf16_t* op = F.MIX + (size_t)(qrow0 + fr) * DM + h * 64 + 4 * fq;
#pragma unroll
    for (int nb = 0; nb < 4; ++nb) { const f32x4 r = o[nb] * inv; u32x2 w; w.x = cvt_pk_bf16(r[0], r[1]); w.y = cvt_pk_bf16(r[2], r[3]); *(u32x2*)(op + nb * 16) = w; }
}

__device__ __forceinline__ void na_band(Frame& F, int l, int unit, bool stage_shared) {
    const int qb = F.wave & 3, half = F.wave >> 2;
    const int b = unit >> 6, h = (unit >> 3) & 7, R = (unit & 7) * 8;
    LAS bf16_t* VTL = (LAS bf16_t*)(F.lds + NA_VTL); LAS bf16_t* VTC = (LAS bf16_t*)(F.lds + NA_VTC); LAS float* RKL = (LAS float*)(F.lds + NA_RKL);
    const bf16_t* lat = F.U + (size_t)(b * SEQ) * NIN; const bf16_t* ctx0 = F.U + (size_t)(NLAT + b * CTXL) * NIN;
    const int skey = F.tid >> 3, sdg = F.tid & 7, skx = skey ^ (sdg << 3);
    const bf16_t* vsrc = lat + (size_t)skey * NIN + C_VA + h * 64 + sdg * 8;
    const bf16_t* ksrc = lat + (size_t)skey * NIN + C_KA + h * 64 + sdg * 8;
#define NA_R0(r_) ((r_) - 4 < 0 ? 0 : ((r_) - 4 > 56 ? 56 : (r_) - 4))
    int hi = NA_R0(R + 1) + 7;
    {
        for (int krow = NA_R0(R); krow <= hi; ++krow) { const bf16x8 v = *(const bf16x8*)(vsrc + (size_t)krow * 64 * NIN), kk = *(const bf16x8*)(ksrc + (size_t)krow * 64 * NIN);
            LAS bf16_t* dst = VTL + (sdg * 8) * VTL_STRIDE + (krow % NSLOT) * 64 + skx;
#pragma unroll
            for (int i = 0; i < 8; ++i) dst[i * VTL_STRIDE] = (bf16_t)v[i];
            float ss = sumsq8(kk); ss += SHX(ss, 1); ss += SHX(ss, 2); ss += SHX(ss, 4);
            if (sdg == 0) RKL[(krow % NSLOT) * 64 + skey] = rsqrtf(ss * (1.0f / 64.0f) + EPS); }
        if (stage_shared) stage_ctx(F, ctx0, h, l);
        LAS float* rpb = (LAS float*)(F.lds + NA_RPB); const float* src = F.IN(10) + ((size_t)l * 8 + h) * 465; if (stage_shared && F.tid < 480) { const int rr_ = F.tid >> 5, cc_ = F.tid & 31; rpb[F.tid] = cc_ < 31 ? src[rr_ * 31 + cc_] * 1.4426950408889634f : -1e30f; }
    }
    __syncthreads();
    int kc0 = 16 * qb - 8; kc0 = kc0 < 0 ? 0 : (kc0 > 32 ? 32 : kc0);
    for (int it2 = 0; it2 < 4; ++it2) {
        asm volatile("" : "+v"(F.lane)); const bf16_t* ctxp = ctx0; asm volatile("" : "+s"(ctxp));
        const int rA = R + 2 * it2, r = rA + half, r0 = NA_R0(r);
        int newhi = it2 < 3 ? NA_R0(rA + 3) + 7 : hi; newhi = newhi > 63 ? 63 : newhi;
        const int nnew = newhi - hi;
        bf16x8 pv0 = (bf16x8){0, 0, 0, 0, 0, 0, 0, 0}, pv1 = pv0, pk0 = pv0, pk1 = pv0;
        if (nnew > 0) { pv0 = *(const bf16x8*)(vsrc + (size_t)(hi + 1) * 64 * NIN); pk0 = *(const bf16x8*)(ksrc + (size_t)(hi + 1) * 64 * NIN); }
        if (nnew > 1) { pv1 = *(const bf16x8*)(vsrc + (size_t)(hi + 2) * 64 * NIN); pk1 = *(const bf16x8*)(ksrc + (size_t)(hi + 2) * 64 * NIN); }
        const int fr = F.lane & 15;
        const int qrow0 = b * SEQ + r * 64 + 16 * qb;
        bf16x8 qf[2];
        na_qfrag(F, h, F.U + (size_t)(qrow0 + fr) * NIN, qf);
        f32x4 oacc[4]; float mrun = -1e30f, lrun = 0.f;
#pragma unroll
        for (int nb = 0; nb < 4; ++nb) oacc[nb] = (f32x4){0.f, 0.f, 0.f, 0.f};
#pragma unroll 1
        for (int ph2 = 0; ph2 < 2; ++ph2) {
            asm volatile("" : "+v"(F.lane) :: "memory");
            f32x4 o[4]; float m1, l1;
            if (ph2 == 0) na_wave<false>(F, h, qf, ctxp, qb, 0, 0, VTC, VTC_STRIDE, 0, o, m1, l1);
            else {
                if (nnew > 0) { const int slot = (hi + 1) % NSLOT; LAS bf16_t* dst = VTL + (sdg * 8) * VTL_STRIDE + slot * 64 + skx;
#pragma unroll
                    for (int i = 0; i < 8; ++i) dst[i * VTL_STRIDE] = (bf16_t)pv0[i];
                    float ss = sumsq8(pk0); ss += SHX(ss, 1); ss += SHX(ss, 2); ss += SHX(ss, 4);
                    if (sdg == 0) RKL[slot * 64 + skey] = rsqrtf(ss * (1.0f / 64.0f) + EPS); }
                if (nnew > 1) { const int slot = (hi + 2) % NSLOT; LAS bf16_t* dst = VTL + (sdg * 8) * VTL_STRIDE + slot * 64 + skx;
#pragma unroll
                    for (int i = 0; i < 8; ++i) dst[i * VTL_STRIDE] = (bf16_t)pv1[i];
                    float ss = sumsq8(pk1); ss += SHX(ss, 1); ss += SHX(ss, 2); ss += SHX(ss, 4);
                    if (sdg == 0) RKL[slot * 64 + skey] = rsqrtf(ss * (1.0f / 64.0f) + EPS); }
                na_wave<true>(F, h, qf, lat + (size_t)(r0 * 64 + kc0) * NIN, qb, kc0, r0 - r + 7, VTL, VTL_STRIDE, r0, o, m1, l1);
            }
            const float M = fmaxf(mrun, m1), a1 = __builtin_amdgcn_exp2f(mrun - M), a2 = __builtin_amdgcn_exp2f(m1 - M);
#pragma unroll
            for (int nb = 0; nb < 4; ++nb) oacc[nb] = oacc[nb] * a1 + o[nb] * a2;
            lrun = lrun * a1 + l1 * a2; mrun = M;
        }
        na_store(F, h, qrow0, oacc, 1.0f / lrun);
        hi = newhi;
        __syncthreads();
    }
#undef NA_R0
}

__device__ __forceinline__ void na_ctx_unit(Frame& F, int l, int u2) {
    const int fr = F.lane & 15;
    const int b = u2 >> 4, qblk = (u2 >> 3) & 1, h = u2 & 7;
    LAS bf16_t* VTC = (LAS bf16_t*)(F.lds + NA_VTC);
    const bf16_t* ctx0 = F.U + (size_t)(NLAT + b * CTXL) * NIN;
    stage_ctx(F, ctx0, h, l);
    __syncthreads();
    const int qrow0 = NLAT + b * CTXL + qblk * 128 + 16 * F.wave;
    bf16x8 qf[2];
    na_qfrag(F, h, F.U + (size_t)(qrow0 + fr) * NIN, qf);
    f32x4 o[4]; float m1, l1;
    na_wave<false>(F, h, qf, ctx0, 0, 0, 0, VTC, VTC_STRIDE, 0, o, m1, l1);
    na_store(F, h, qrow0, o, 1.0f / l1);
    __syncthreads();
}

constexpr int CV_G = 0, CV_ACT = 65536, CV_END = 96256;
static_assert(CV_ACT + 64 * 264 * 2 <= LDS_BYTES, "conv lds");
__device__ __forceinline__ void conv_unit(Frame& F, int l, int unit) {
    const int fr = F.lane & 15, fq = F.lane >> 4;
    int row0, seq0, seqn;
    if (unit < 512) { row0 = unit * 64; seq0 = (unit >> 6) * SEQ; seqn = SEQ; } else { const int u2 = unit - 512; row0 = NLAT + u2 * 64; seq0 = NLAT + (u2 >> 2) * CTXL; seqn = CTXL; }
    LAS float* G = (LAS float*)(F.lds + CV_G);
    for (int item = F.tid; item < 94 * 32; item += 512) {
        const int i = item >> 5, c8 = (item & 31) * 8; const int row = row0 - 15 + i;
        f32x4 g0 = (f32x4){0.f, 0.f, 0.f, 0.f}, g1 = g0;
        if (row >= seq0 && row < seq0 + seqn) {
            const bf16x8 a = *(const bf16x8*)(F.U + (size_t)row * NIN + C_UA + c8), g = *(const bf16x8*)(F.U + (size_t)row * NIN + C_UG + c8);
#pragma unroll
            for (int e = 0; e < 4; ++e) { g0[e] = bf2f((bf16_t)a[e]) * sigmoidf_(bf2f((bf16_t)g[e])); g1[e] = bf2f((bf16_t)a[4 + e]) * sigmoidf_(bf2f((bf16_t)g[4 + e])); }
        }
        *(LAS f32x4*)(G + i * 256 + c8) = g0; *(LAS f32x4*)(G + i * 256 + c8 + 4) = g1;
    }
    __syncthreads();
    const int ch = F.tid & 255, tg = F.tid >> 8;
    float acc[32];
    {
        float w[31];
        const float* cw = F.IN(11) + (size_t)l * 31 * 256 + ch;
#pragma unroll
        for (int j = 0; j < 31; ++j) w[j] = cw[j * 256];
        const float cb = F.IN(12)[l * 256 + ch];
#pragma unroll
        for (int tb = 0; tb < 4; ++tb) {
            float xr[38];
#pragma unroll
            for (int i = 0; i < 38; ++i) xr[i] = G[(tg * 32 + tb * 8 + i) * 256 + ch];
#pragma unroll
            for (int o = 0; o < 8; ++o) { float a = cb;
#pragma unroll
                for (int j = 0; j < 31; ++j) a += w[j] * xr[o + j];
                acc[tb * 8 + o] = a; }
        }
    }
    __syncthreads();
#pragma unroll
    for (int t = 0; t < 32; ++t) G[(tg * 32 + t) * 256 + ch] = acc[t];
    __syncthreads();
    LAS bf16_t* ACT = (LAS bf16_t*)(F.lds + CV_ACT);
    {
        const f32x4 lg = *(const f32x4*)(F.IN(13) + l * 256 + F.lane * 4), lb = *(const f32x4*)(F.IN(14) + l * 256 + F.lane * 4);
#pragma unroll
        for (int tt = 0; tt < 8; ++tt) { const int t = F.wave * 8 + tt;
            const f32x4 v = *(const LAS f32x4*)(G + t * 256 + F.lane * 4);
            float s = v[0] + v[1] + v[2] + v[3];
#pragma unroll
            for (int o = 1; o < 64; o <<= 1) s += SHX(s, o);
            const float mu = s * (1.0f / 256.0f);
            const f32x4 dv = v - mu; float q = dv[0] * dv[0] + dv[1] * dv[1] + dv[2] * dv[2] + dv[3] * dv[3];
#pragma unroll
            for (int o = 1; o < 64; o <<= 1) q += SHX(q, o);
            const float rs = rsqrtf(q * (1.0f / 256.0f) + EPS);
            float y[4];
#pragma unroll
            for (int e = 0; e < 4; ++e) y[e] = siluf_(dv[e] * rs * lg[e] + lb[e]);
            u32x2 w; w.x = cvt_pk_bf16(y[0], y[1]); w.y = cvt_pk_bf16(y[2], y[3]);
            *(LAS u32x2*)(ACT + t * 264 + F.lane * 4) = w; }
    }
    __syncthreads();
    f32x4 o[4][2];
#pragma unroll
    for (int mb = 0; mb < 4; ++mb) { o[mb][0] = (f32x4){0.f, 0.f, 0.f, 0.f}; o[mb][1] = o[mb][0]; }
    const bf16_t* wp = F.Wpw + (size_t)l * 65536 + (size_t)(F.wave * 32 + fr) * 256 + 8 * fq;
#pragma unroll
    for (int ks = 0; ks < 8; ++ks) {
        const bf16x8 b0 = *(const bf16x8*)(wp + ks * 32), b1 = *(const bf16x8*)(wp + 16 * 256 + ks * 32);
#pragma unroll
        for (int mb = 0; mb < 4; ++mb) { const bf16x8 a = *(const LAS bf16x8*)(ACT + (mb * 16 + fr) * 264 + ks * 32 + 8 * fq);
            o[mb][0] = mfma16(b0, a, o[mb][0]); o[mb][1] = mfma16(b1, a, o[mb][1]); }
    }
#pragma unroll
    for (int nn = 0; nn < 2; ++nn) { const int n = F.wave * 32 + nn * 16 + 4 * fq; const f32x4 pb = *(const f32x4*)(F.IN(16) + l * 256 + n);
#pragma unroll
        for (int mb = 0; mb < 4; ++mb) { const f32x4 r = o[mb][nn] + pb; u32x2 w; w.x = cvt_pk_bf16(r[0], r[1]); w.y = cvt_pk_bf16(r[2], r[3]);
            *(u32x2*)(F.MIX + (size_t)(row0 + mb * 16 + fr) * DM + 512 + n) = w; } }
    __syncthreads();
}

struct GlaLd { bf16x8 af, ab, qo, qp, ko, kp, v0, v1; };
__device__ __forceinline__ void gla_unit_decode(int unit, int& b, int& cc, int& h, int& row0);
__device__ __forceinline__ void gla_load(Frame& F, int pair, GlaLd& g) {
    const int slot = F.wave >> 2, w4 = F.wave & 3, t4 = F.tid & 255;
    int b, cc, h, row0; gla_unit_decode(pair * 2 + slot, b, cc, h, row0);
    const bf16_t* rp = F.U + (size_t)(row0 + F.lane) * NIN;
    g.af = *(const bf16x8*)(rp + C_GF + h * 32 + 8 * w4); g.ab = *(const bf16x8*)(rp + C_GB + h * 32 + 8 * w4);
    g.qo = *(const bf16x8*)(rp + C_QG + h * 32 + 8 * w4); g.qp = *(const bf16x8*)(rp + C_QG + h * 32 + 8 * (w4 ^ 1));
    g.ko = *(const bf16x8*)(rp + C_KG + h * 32 + 8 * w4); g.kp = *(const bf16x8*)(rp + C_KG + h * 32 + 8 * (w4 ^ 1));
    g.v0 = *(const bf16x8*)(F.U + (size_t)(row0 + (t4 >> 3)) * NIN + C_VG + h * 64 + (t4 & 7) * 8);
    g.v1 = *(const bf16x8*)(F.U + (size_t)(row0 + 32 + (t4 >> 3)) * NIN + C_VG + h * 64 + (t4 & 7) * 8);
}
__device__ __forceinline__ void gla_prep(Frame& F, const GlaLd& g, int l, int b, int cc, int h, int row0, int w4, float (&qF)[8], float (&kF)[8], float (&qB)[8], float (&kB)[8], float (&totF)[8], float (&totB)[8]) {
    const int lane = F.lane;
    const bf16x8 af = g.af, ab = g.ab, qo = g.qo, qp = g.qp, ko = g.ko, kp = g.kp;
    const float* gbf = F.IN(18) + l * 128 + h * 32 + 8 * w4; const float* gbb = F.IN(20) + l * 128 + h * 32 + 8 * w4;
    const bool isctx = cc < 4;
    const int p = (w4 < 2) ? (cc - 4) : lane;
    const float qscale = 0.17677669529663687f;
#pragma unroll
    for (int i = 0; i < 8; ++i) {
        const float laf = logsigmoidf_(bf2f((bf16_t)af[i]) + gbf[i]) * (1.0f / 16.0f), lab = logsigmoidf_(bf2f((bf16_t)ab[i]) + gbb[i]) * (1.0f / 16.0f);
        const float cf = wave_scan_incl(laf), pb = wave_scan_incl(lab);
        totF[i] = __int_as_float(__builtin_amdgcn_readlane(__float_as_int(cf), 63)); totB[i] = __int_as_float(__builtin_amdgcn_readlane(__float_as_int(pb), 63));
        const float cb = totB[i] - pb + lab;
        float q = bf2f((bf16_t)qo[i]), k = bf2f((bf16_t)ko[i]);
        if (!isctx) {
            const float cs = F.rope[p * 8 + i], sn = F.rope[512 + p * 8 + i];
            const float q2 = bf2f((bf16_t)qp[i]), k2 = bf2f((bf16_t)kp[i]);
            if (w4 & 1) { q = q2 * sn + q * cs; k = k2 * sn + k * cs; } else { q = q * cs - q2 * sn; k = k * cs - k2 * sn; }
        }
        q *= qscale;
        const float ef = __expf(cf), eb = __expf(cb);
        qF[i] = q * ef; kF[i] = k * __expf(-cf); qB[i] = q * eb; kB[i] = k * __expf(-cb);
    }
}
__device__ __forceinline__ void gla_unit_decode(int unit, int& b, int& cc, int& h, int& row0) {
    h = unit & 3; const int t = unit >> 2; cc = t % NCHUNK; b = t / NCHUNK;
    row0 = cc < 4 ? NLAT + b * CTXL + cc * 64 : b * SEQ + (cc - 4) * 64;
}
__device__ __forceinline__ void gla_stage_vt(const GlaLd& g, LAS bf16_t* VT, int t4) {
    const int s = t4 >> 3, dg = t4 & 7;
#pragma unroll
    for (int i = 0; i < 8; ++i) { VT[(dg * 8 + i) * 72 + s] = (bf16_t)g.v0[i]; VT[(dg * 8 + i) * 72 + 32 + s] = (bf16_t)g.v1[i]; }
}

constexpr int GL_SLOT = 18432 + 256;
__device__ __forceinline__ void gla_local_pair(Frame& F, int l, int pair, const GlaLd& g) {
    const int fr = F.lane & 15, fq = F.lane >> 4;
    const int slot = F.wave >> 2, w4 = F.wave & 3, t4 = F.tid & 255;
    const int unit = pair * 2 + slot; int b, cc, h, row0; gla_unit_decode(unit, b, cc, h, row0);
    LAS unsigned char* sb = F.lds + slot * GL_SLOT;
    LAS bf16_t* KT[2] = {(LAS bf16_t*)sb, (LAS bf16_t*)(sb + 4608)}; LAS bf16_t* VT = (LAS bf16_t*)(sb + 9216); LAS float* TOT = (LAS float*)(sb + 18432);
    {
        float qF[8], kF[8], qB[8], kB[8], totF[8], totB[8];
        gla_prep(F, g, l, b, cc, h, row0, w4, qF, kF, qB, kB, totF, totB);
#pragma unroll
        for (int i = 0; i < 8; ++i) { KT[0][(8 * w4 + i) * 72 + F.lane] = f2bf(kF[i]); KT[1][(8 * w4 + i) * 72 + F.lane] = f2bf(kB[i]); }
        {
            bf16_t* gq = F.GQK + (size_t)unit * 8192 + F.lane * 32 + 8 * w4; u32x4 w;
            w.x = cvt_pk_bf16(qF[0], qF[1]); w.y = cvt_pk_bf16(qF[2], qF[3]); w.z = cvt_pk_bf16(qF[4], qF[5]); w.w = cvt_pk_bf16(qF[6], qF[7]); *(u32x4*)(gq) = w;
            w.x = cvt_pk_bf16(kF[0], kF[1]); w.y = cvt_pk_bf16(kF[2], kF[3]); w.z = cvt_pk_bf16(kF[4], kF[5]); w.w = cvt_pk_bf16(kF[6], kF[7]); *(u32x4*)(gq + 2048) = w;
            w.x = cvt_pk_bf16(qB[0], qB[1]); w.y = cvt_pk_bf16(qB[2], qB[3]); w.z = cvt_pk_bf16(qB[4], qB[5]); w.w = cvt_pk_bf16(qB[6], qB[7]); *(u32x4*)(gq + 4096) = w;
            w.x = cvt_pk_bf16(kB[0], kB[1]); w.y = cvt_pk_bf16(kB[2], kB[3]); w.z = cvt_pk_bf16(kB[4], kB[5]); w.w = cvt_pk_bf16(kB[6], kB[7]); *(u32x4*)(gq + 6144) = w;
        }
        if (F.lane == 0) {
#pragma unroll
            for (int i = 0; i < 8; ++i) { TOT[8 * w4 + i] = totF[i]; TOT[32 + 8 * w4 + i] = totB[i];
                F.dec[(size_t)(unit * 2 + 0) * 32 + 8 * w4 + i] = __expf(totF[i]); F.dec[(size_t)(unit * 2 + 1) * 32 + 8 * w4 + i] = __expf(totB[i]); } }
    }
    gla_stage_vt(g, VT, t4);
    __syncthreads();
    {
#pragma unroll
        for (int it2 = 0; it2 < 2; ++it2) { const int item = it2 * 256 + t4, dv = item >> 3, s8 = (item & 7) * 8;
            *(u32x4*)(F.GVT + (size_t)unit * 4096 + dv * 64 + s8) = *(const LAS u32x4*)(VT + dv * 72 + s8); }
    }
    const int dir = w4 >> 1, mb = w4 & 1;
    f32x4 acc[4];
#pragma unroll
    for (int nb = 0; nb < 4; ++nb) acc[nb] = (f32x4){0.f, 0.f, 0.f, 0.f};
#pragma unroll
    for (int ks = 0; ks < 2; ++ks) { const bf16x8 a = *(const LAS bf16x8*)(KT[dir] + (mb * 16 + fr) * 72 + ks * 32 + 8 * fq);
#pragma unroll
        for (int nb = 0; nb < 4; ++nb) { const bf16x8 vb = *(const LAS bf16x8*)(VT + (nb * 16 + fr) * 72 + ks * 32 + 8 * fq); acc[nb] = mfma16(a, vb, acc[nb]); } }
    f32x4 sc4;
#pragma unroll
    for (int j = 0; j < 4; ++j) sc4[j] = __expf(TOT[dir * 32 + mb * 16 + 4 * fq + j]);
#pragma unroll
    for (int nb = 0; nb < 4; ++nb) *(f32x4*)(F.dST + (size_t)(unit * 2 + dir) * 2048 + (nb * 16 + fr) * 32 + mb * 16 + 4 * fq) = acc[nb] * sc4;
    __syncthreads();
}

__device__ void phase_gla_scan(Frame& F) {
    for (int e = F.bid * 512 + F.tid; e < NBATCH * 4 * 2 * 2048; e += F.G * 512) {
        const int inner = e & 2047, dir = (e >> 11) & 1, h = (e >> 12) & 3, b = e >> 14, d = inner & 31;
        float S = 0.f;
#pragma unroll 1
        for (int half = 0; half < 2; ++half) {
            float dc[34], ds[34];
#pragma unroll
            for (int i = 0; i < 34; ++i) { const int step = half * 34 + i;
                const int cc = dir == 0 ? step : (step < 4 ? 3 - step : 71 - step);
                const int unit = (b * NCHUNK + cc) * 4 + h;
                dc[i] = F.dec[(size_t)(unit * 2 + dir) * 32 + d]; ds[i] = F.dST[(size_t)(unit * 2 + dir) * 2048 + inner]; }
#pragma unroll
            for (int i = 0; i < 34; ++i) { const int step = half * 34 + i;
                const int cc = dir == 0 ? step : (step < 4 ? 3 - step : 71 - step);
                const int unit = (b * NCHUNK + cc) * 4 + h;
                F.SinT[(size_t)(unit * 2 + dir) * 2048 + inner] = f2bf(S);
                S = dc[i] * S + ds[i]; }
        }
    }
}

__device__ __forceinline__ void gla_out_wave(Frame& F, int l, int unit, int tb) {
    const int fr = F.lane & 15, fq = F.lane >> 4;
    int b, cc, h, row0; gla_unit_decode(unit, b, cc, h, row0);
    LAS bf16_t* ATT = (LAS bf16_t*)(F.lds + F.wave * 2304);
    const bf16_t* gq = F.GQK + (size_t)unit * 8192; const bf16_t* gv = F.GVT + (size_t)unit * 4096;
    bf16x8 qa2[2], kb2[2][4], vb2[2][4], sb2[2][4];
#pragma unroll
    for (int dir = 0; dir < 2; ++dir) {
        qa2[dir] = *(const bf16x8*)(gq + dir * 4096 + (tb * 16 + fr) * 32 + 8 * fq);
#pragma unroll
        for (int sbk = 0; sbk < 4; ++sbk) { const bool valid = dir == 0 ? (sbk <= tb) : (sbk >= tb);
            kb2[dir][sbk] = valid ? *(const bf16x8*)(gq + dir * 4096 + 2048 + (sbk * 16 + fr) * 32 + 8 * fq) : (bf16x8){0, 0, 0, 0, 0, 0, 0, 0}; }
#pragma unroll
        for (int nb = 0; nb < 4; ++nb) sb2[dir][nb] = *(const bf16x8*)(F.SinT + (size_t)(unit * 2 + dir) * 2048 + (nb * 16 + fr) * 32 + 8 * fq);
    }
#pragma unroll
    for (int ks = 0; ks < 2; ++ks)
#pragma unroll
        for (int nb = 0; nb < 4; ++nb) vb2[ks][nb] = *(const bf16x8*)(gv + (nb * 16 + fr) * 64 + ks * 32 + 8 * fq);
    u32x2 rw4[4]; f32x4 og4[4];
    const size_t orow = (size_t)(row0 + tb * 16 + fr);
#pragma unroll
    for (int nb = 0; nb < 4; ++nb) { rw4[nb] = *(const u32x2*)(F.U + orow * NIN + C_RG + h * 64 + nb * 16 + 4 * fq); og4[nb] = *(const f32x4*)(F.IN(21) + l * 64 + nb * 16 + 4 * fq); }
    f32x4 o[4];
#pragma unroll
    for (int nb = 0; nb < 4; ++nb) o[nb] = (f32x4){0.f, 0.f, 0.f, 0.f};
#pragma unroll
    for (int dir = 0; dir < 2; ++dir) {
        const bf16x8 qa = qa2[dir];
#pragma unroll
        for (int sbk = 0; sbk < 4; ++sbk) {
            const bool valid = dir == 0 ? (sbk <= tb) : (sbk >= tb);
            f32x4 a = (f32x4){0.f, 0.f, 0.f, 0.f};
            if (valid) a = mfma16(qa, kb2[dir][sbk], a);
#pragma unroll
            for (int j = 0; j < 4; ++j) { float v = a[j];
                if (sbk == tb) { const bool keep = dir == 0 ? (fr <= 4 * fq + j) : (fr >= 4 * fq + j); v = keep ? v : 0.f; }
                ATT[(4 * fq + j) * 72 + sbk * 16 + fr] = f2bf(v); }
        }
        asm volatile("s_waitcnt lgkmcnt(0)" ::: "memory");
#pragma unroll
        for (int ks = 0; ks < 2; ++ks) { const bf16x8 pa = *(const LAS bf16x8*)(ATT + fr * 72 + ks * 32 + 8 * fq);
#pragma unroll
            for (int nb = 0; nb < 4; ++nb) o[nb] = mfma16(vb2[ks][nb], pa, o[nb]); }
#pragma unroll
        for (int nb = 0; nb < 4; ++nb) o[nb] = mfma16(sb2[dir][nb], qa, o[nb]);
        asm volatile("s_waitcnt lgkmcnt(0)" ::: "memory");
    }
    {
        float ss = 0.f;
#pragma unroll
        for (int nb = 0; nb < 4; ++nb) ss += o[nb][0] * o[nb][0] + o[nb][1] * o[nb][1] + o[nb][2] * o[nb][2] + o[nb][3] * o[nb][3];
        ss += SHX(ss, 16); ss += SHX(ss, 32);
        const float rinv = rsqrtf(ss * (1.0f / 64.0f) + EPS);
        const size_t row = (size_t)(row0 + tb * 16 + fr);
#pragma unroll
        for (int nb = 0; nb < 4; ++nb) { const int dv = nb * 16 + 4 * fq;
            const u32x2 rw = rw4[nb]; const f32x4 og = og4[nb];
            const float r0_ = __uint_as_float(rw.x << 16), r1_ = __uint_as_float(rw.x & 0xffff0000u), r2_ = __uint_as_float(rw.y << 16), r3_ = __uint_as_float(rw.y & 0xffff0000u);
            u32x2 w; w.x = cvt_pk_bf16(o[nb][0] * rinv * og[0] * siluf_(r0_), o[nb][1] * rinv * og[1] * siluf_(r1_));
            w.y = cvt_pk_bf16(o[nb][2] * rinv * og[2] * siluf_(r2_), o[nb][3] * rinv * og[3] * siluf_(r3_));
            *(u32x2*)(F.MIX + row * DM + 768 + h * 64 + dv) = w; }
    }
}

__device__ void phase_mixers(Frame& F, int l) {
    const int n_na = 512 + (l == 0 ? 128 : 0), n_cv = 512 + (l == 0 ? 32 : 0), n_gl = NGU / 2;
    for (int it = F.bid; it < n_na + n_cv; it += F.G) {
        frame_refresh(F);
        if (it < n_na) {
            if (it < 512) {
                const int wb = it & 255, second = it >> 8, rest = wb >> 3;
                na_band(F, l, ((wb & 7) << 6) | ((rest >> 2) << 3) | ((rest & 3) * 2 + second), second == 0 || F.G != 256);
            } else na_ctx_unit(F, l, it - 512); }
        else conv_unit(F, l, it - n_na);
    }
    const int base = n_na + n_cv;
    int it = base + ((F.bid - base % F.G) + F.G) % F.G;
    frame_refresh(F);
    GlaLd cur;
    if (it < base + n_gl) gla_load(F, it - base, cur);
    for (; it < base + n_gl; it += F.G) {
        frame_refresh(F);
        GlaLd nxt = cur;
        if (it + F.G < base + n_gl) gla_load(F, it + F.G - base, nxt);
        gla_local_pair(F, l, it - base, cur);
        cur = nxt;
    }
}
__device__ void phase_gla_out(Frame& F, int l) {
    for (int it = F.bid * 8 + F.wave; it < NGU * 4; it += F.G * 8) gla_out_wave(F, l, it >> 2, it & 3);
}

#define XB_TMO      128
#define XB_XCNT(j)  (256  + 64 * (j))
#define XB_XSUB(j)  (1280 + 64 * (j))
#define XB_XGEN(j)  (2304 + 64 * (j))
#define XB_TOP      3328
#define XB_TOPGEN   3392
#define XCD_BAR_WORDS 3456
#define XB_SPIN_CAP (1u << 23)
__device__ __forceinline__ unsigned xb_ld(unsigned* p)              { return __hip_atomic_load(p, __ATOMIC_RELAXED, __HIP_MEMORY_SCOPE_AGENT); }
__device__ __forceinline__ unsigned xb_add(unsigned* p, unsigned v) { return __hip_atomic_fetch_add(p, v, __ATOMIC_RELAXED, __HIP_MEMORY_SCOPE_AGENT); }
__device__ __forceinline__ unsigned xb_xcc_id() { return (unsigned)__builtin_amdgcn_s_getreg((3 << 11) | 20) & 0xFu; }
#define XB_SPIN(cond, bar) do { unsigned _sp = 0; while (cond) { __builtin_amdgcn_s_sleep(1); \
    if ((++_sp & 255u) == 0u) { if (xb_ld(&(bar)[XB_TMO])) break; if (_sp > XB_SPIN_CAP) { atomicAdd(&(bar)[XB_TMO], 1u); break; } } } } while (0)
struct XcdBarrier { unsigned* bar; unsigned x; volatile LAS unsigned* st; };
__device__ __forceinline__ XcdBarrier xcd_barrier_post(unsigned* bar, volatile LAS unsigned* st) {
    XcdBarrier b; b.bar = bar; b.x = xb_xcc_id(); b.st = st;
    if (threadIdx.x == 0) (void)xb_add(&bar[XB_XCNT(b.x)], 1u);
    return b;
}
__device__ __forceinline__ void xcd_barrier_complete(unsigned* bar, unsigned x, unsigned& nloc, unsigned& nx) {
    const unsigned G = gridDim.x * gridDim.y * gridDim.z;
    unsigned sum, cnt, mine, sp = 0u;
    for (;;) {
        sum = 0u; cnt = 0u; mine = 0u;
#pragma unroll
        for (unsigned j = 0; j < 16; ++j) { const unsigned c = xb_ld(&bar[XB_XCNT(j)]); sum += c; cnt += (c > 0u) ? 1u : 0u; mine = (j == x) ? c : mine; }
        if (sum == G) break;
        __builtin_amdgcn_s_sleep(1);
        if ((++sp & 255u) == 0u) { if (xb_ld(&bar[XB_TMO])) break; if (sp > XB_SPIN_CAP) { atomicAdd(&bar[XB_TMO], 1u); break; } }
    }
    nloc = mine > 0u ? mine : 1u; nx = cnt > 0u ? cnt : 1u;
}
__device__ __forceinline__ void xcd_barrier(const XcdBarrier& b, const bool t0) {
    asm volatile("s_waitcnt vmcnt(0)" ::: "memory");
    __syncthreads();
    if (t0) {
        unsigned* bar = b.bar;
        __builtin_amdgcn_s_waitcnt(0);
        unsigned nloc = b.st[0], nx = b.st[1];
        if (nloc == 0u) { xcd_barrier_complete(bar, b.x, nloc, nx); b.st[0] = nloc; b.st[1] = nx; }
        const unsigned old = xb_add(&bar[XB_XSUB(b.x)], 1u);
        const unsigned gen = old / nloc;
        if (old + 1u == (gen + 1u) * nloc) {
            __builtin_amdgcn_fence(__ATOMIC_RELEASE, "agent");
            asm volatile("s_waitcnt vmcnt(0)" ::: "memory");
            const unsigned og = xb_add(&bar[XB_TOP], 1u);
            const unsigned tg = og / nx;
            if (og + 1u == (tg + 1u) * nx) xb_add(&bar[XB_TOPGEN], 1u);
            else XB_SPIN(xb_ld(&bar[XB_TOPGEN]) == tg, bar);
            __builtin_amdgcn_fence(__ATOMIC_ACQUIRE, "agent");
            xb_add(&bar[XB_XGEN(b.x)], 1u);
            asm volatile("s_waitcnt vmcnt(0)" ::: "memory");
        } else {
            XB_SPIN(xb_ld(&bar[XB_XGEN(b.x)]) == gen, bar);
            __builtin_amdgcn_fence(__ATOMIC_ACQUIRE, "agent");
            asm volatile("s_waitcnt vmcnt(0)" ::: "memory");
        }
    }
    __syncthreads();
}

constexpr int N_PHASES = 1 + 9 * DEPTH;

__device__ __forceinline__ void run_phase(Frame& F, int ph) {
#ifndef PH_MASK
#define PH_MASK 0x3ff
#endif
    if (ph == 0) { if (PH_MASK & 1) phase_setup(F); return; }
    const int l = (ph - 1) / 9, s = (ph - 1) % 9;
    const float* modl = F.mod + (size_t)l * 9 * 6144;
    const float* xlat = l == 0 ? F.IN(0) : F.out;
    const float* xctx = l == 0 ? F.IN(2) : F.XC;
    const int Mfull = l == 0 ? MTOT : NLAT;
    pg8::StaticOrder S;
    switch (s) {
    case 0: if (PH_MASK & 2) phase_prep(F, xlat, xctx, modl, 0, 1024, F.IN(6) + l * DM, MTOT, l == 0 ? 0 : 8); break;
    case 1: if (PH_MASK & 4) { pg8::Gemm g{F.H, F.WtIn + (size_t)l * NIN * DM, MTOT, NIN, DM}; S.init(MTOT, NIN, F.G, F.bid, DM); pg8::EpiBf16<0> E{F.U, NIN}; pg8::gemm_phase(F.lds, F.tid, g, S, E); } break;
    case 2: if (PH_MASK & 8) phase_mixers(F, l); break;
    case 3: if (PH_MASK & 16) phase_gla_scan(F); break;
    case 4: if (PH_MASK & 32) phase_gla_out(F, l); break;
    case 5: if (PH_MASK & 64) { pg8::Gemm g{F.MIX, F.WtOut + (size_t)l * DM * DM, Mfull, DM, DM}; S.init(NLAT, DM, F.G, F.bid, DM); if (l == 0) S.add_split(32, 4); pg8::EpiResid E{xlat, xctx, F.out, F.XC, modl, 2048, F.dST}; pg8::gemm_phase(F.lds, F.tid, g, S, E); } break;
    case 6: if (PH_MASK & 128) phase_prep(F, F.out, l == 0 ? xctx : F.XC, modl, 3072, 4096, F.IN(23) + l * DM, Mfull, l == 0 ? 4 : 0); break;
    case 7: if (PH_MASK & 256) { pg8::Gemm g{F.H, F.Wt1 + (size_t)l * DFF * DM, Mfull, DFF, DM}; S.init(Mfull, DFF, F.G, F.bid, DM); pg8::EpiBf16<1> E{F.HID, DFF}; pg8::gemm_phase(F.lds, F.tid, g, S, E); } break;
    case 8: if (PH_MASK & 512) { pg8::Gemm g{F.HID, F.Wt2 + (size_t)l * DM * DFF, Mfull, DM, DFF}; S.init(NLAT, DM, F.G, F.bid, DFF); if (l == 0) S.add_split(32, 8); pg8::EpiResid E{F.out, F.XC, F.out, F.XC, modl, 5120, F.dST}; pg8::gemm_phase(F.lds, F.tid, g, S, E); } break;
    }
}

__global__ void __launch_bounds__(512, 2) mk_fwd(Args args) {
    extern __shared__ __attribute__((aligned(16))) unsigned char lds_raw[];
    const int wave0 = __builtin_amdgcn_readfirstlane((int)threadIdx.x >> 6);
    volatile LAS unsigned* bst = (volatile LAS unsigned*)((LAS unsigned char*)lds_raw + LDS_BYTES - 16);
    if (threadIdx.x == 0) { bst[0] = 0u; bst[1] = 0u; }
    __syncthreads();
    XcdBarrier xbar; xbar.bar = (unsigned*)(args.ws + WS_BAR); xbar.x = 0; xbar.st = bst;
    if (args.ph_hi - args.ph_lo > 1) xbar = xcd_barrier_post((unsigned*)(args.ws + WS_BAR), bst);
    for (int step = args.ph_lo; step < args.ph_hi; ++step) {
        int ph = step;
#ifdef PROBE_KIND
        { const int P = PROBE_KIND == 9 ? 0 : 1 + PROBE_KIND, Q = PROBE_KIND == 9 ? 1000 : 10 + PROBE_KIND; ph = step - (step > P ? 1 : 0) - (step > Q + 1 ? 1 : 0); }
#endif
        if (step > args.ph_lo) { if (args.ph_hi < 0) cg::this_grid().sync();
            else { unsigned on2 = ~0u; asm volatile("" : "+s"(on2)); xcd_barrier(xbar, wave0 == 0 && __builtin_amdgcn_mbcnt_hi(on2, __builtin_amdgcn_mbcnt_lo(on2, 0u)) == 0u); } }
        Frame F;
        unsigned ones = ~0u; int w0 = wave0; asm volatile("" : "+s"(ones), "+s"(w0));
        int tid = w0 * 64 + (int)__builtin_amdgcn_mbcnt_hi(ones, __builtin_amdgcn_mbcnt_lo(ones, 0u)); asm volatile("" : "+v"(tid));
        int bid = blockIdx.x, G = gridDim.x; asm volatile("" : "+s"(bid), "+s"(G));
        unsigned char* ws = args.ws; float* out = args.out; asm volatile("" : "+s"(ws), "+s"(out));
        const __attribute__((address_space(4))) fptr_t* kp = (const __attribute__((address_space(4))) fptr_t*)__builtin_amdgcn_kernarg_segment_ptr(); asm volatile("" : "+s"(kp));
        { LAS unsigned char* lb = (LAS unsigned char*)lds_raw; asm volatile("" : "+s"(lb)); F.lds = lb; }
        F.tid = tid; F.lane = tid & 63; F.wave = __builtin_amdgcn_readfirstlane(tid >> 6); F.G = G; F.bid = bid;
        F.inp = kp; F.out = out; F.ws = ws;
        frame_derive(F);
        run_phase(F, ph);
    }
}

extern "C" void kernel_launch(void* const* d_in, const int* in_sizes, int n_in, void* d_out, int out_size, void* d_ws, size_t ws_size, hipStream_t stream) {
    static int grid = 0;
    if (grid == 0) {
        if (n_in != 26 || ws_size < WS_END) { fprintf(stderr, "kernel_launch: unexpected n_in %d or ws_size %zu (< %zu)\n", n_in, ws_size, (size_t)WS_END); grid = -1; return; }
        int dev = 0, cus = 0, per_cu = 0;
        hipGetDevice(&dev); hipDeviceGetAttribute(&cus, hipDeviceAttributeMultiprocessorCount, dev);
        if (hipFuncSetAttribute((const void*)mk_fwd, hipFuncAttributeMaxDynamicSharedMemorySize, LDS_BYTES) != hipSuccess) { fprintf(stderr, "kernel_launch: hipFuncSetAttribute failed\n"); grid = -1; return; }
        if (hipOccupancyMaxActiveBlocksPerMultiprocessor(&per_cu, (const void*)mk_fwd, 512, LDS_BYTES) != hipSuccess || per_cu < 1) { fprintf(stderr, "kernel_launch: occupancy query %d\n", per_cu); per_cu = 1; }
        (void)hipGetLastError();
        grid = cus;
    }
    if (grid < 0) return;
    Args a{};
    for (int i = 0; i < 26; ++i) a.in[i] = (const float*)d_in[i];
    a.out = (float*)d_out; a.ws = (unsigned char*)d_ws;
#if MK_ONE_LAUNCH
    if (hipMemsetAsync((char*)d_ws + WS_BAR, 0, 16384, stream) != hipSuccess) { fprintf(stderr, "kernel_launch: memset failed\n"); return; }
#ifdef PROBE_KIND
    a.ph_lo = 0; a.ph_hi = N_PHASES + (PROBE_KIND == 9 ? 1 : 2);
#else
    a.ph_lo = 0; a.ph_hi = N_PHASES;
#endif
    void* kargs[] = {&a};
    hipError_t e = hipLaunchCooperativeKernel((const void*)mk_fwd, dim3(grid), dim3(512), kargs, LDS_BYTES, stream);
    if (e != hipSuccess) fprintf(stderr, "cooperative launch failed: %s (grid %d)\n", hipGetErrorString(e), grid);
#else
#ifndef RUN_PHASES
#define RUN_PHASES N_PHASES
#endif
    for (int ph = 0; ph < RUN_PHASES; ++ph) {
        a.ph_lo = ph; a.ph_hi = ph + 1;
        hipLaunchKernelGGL(mk_fwd, dim3(grid), dim3(512), LDS_BYTES, stream, a);
    }
#endif
}
```

```cpp
#include <hip/hip_runtime.h>
#include <hip/hip_cooperative_groups.h>
#include <cstdio>
namespace cg = cooperative_groups;

#ifndef MK_ONE_LAUNCH
#define MK_ONE_LAUNCH 1
#endif

#define LAS __attribute__((address_space(3)))
typedef unsigned short bf16_t;
typedef short bf16x8 __attribute__((ext_vector_type(8)));
typedef float f32x4 __attribute__((ext_vector_type(4)));
typedef float f32x2 __attribute__((ext_vector_type(2)));
typedef unsigned u32x4 __attribute__((ext_vector_type(4)));
typedef unsigned u32x2 __attribute__((ext_vector_type(2)));

constexpr int DM = 1024, NBATCH = 8, SEQ = 4096, CTXL = 256, DEPTH = 2;
constexpr int NLAT = NBATCH * SEQ, NCTX = NBATCH * CTXL, MTOT = NLAT + NCTX;
constexpr int NIN = 3072, DFF = 4096, INW = 2848;
constexpr int C_QA = 0, C_KA = 512, C_VA = 1024, C_UA = 1536, C_UG = 1792, C_QG = 2048, C_KG = 2176, C_VG = 2304, C_RG = 2560, C_GF = 2816, C_GB = 2944;
constexpr float EPS = 1e-6f;
constexpr int NCHUNK = 68;
constexpr int NGU = NBATCH * NCHUNK * 4;

constexpr size_t WS_WTIN = 0;
constexpr size_t WS_WTOUT = WS_WTIN + (size_t)DEPTH * NIN * DM * 2;
constexpr size_t WS_WT1 = WS_WTOUT + (size_t)DEPTH * DM * DM * 2;
constexpr size_t WS_WT2 = WS_WT1 + (size_t)DEPTH * DFF * DM * 2;
constexpr size_t WS_WPW = WS_WT2 + (size_t)DEPTH * DFF * DM * 2;
constexpr size_t WS_MOD = WS_WPW + (size_t)DEPTH * 256 * 256 * 2;
constexpr size_t WS_ROPE = WS_MOD + (size_t)DEPTH * 9 * 6144 * 4;
constexpr size_t WS_H = WS_ROPE + 4096;
constexpr size_t WS_U = WS_H + (size_t)MTOT * DM * 2;
constexpr size_t WS_MIX = WS_U + (size_t)MTOT * NIN * 2;
constexpr size_t WS_XC = WS_MIX + (size_t)MTOT * DM * 2;
constexpr size_t WS_DST = WS_XC + (size_t)NCTX * DM * 4;
constexpr size_t WS_DEC = WS_DST + (size_t)NGU * 2 * 2048 * 4;
constexpr size_t WS_SIN = WS_DEC + (size_t)NGU * 2 * 32 * 4;
constexpr size_t WS_GQK = WS_SIN + (size_t)NGU * 2 * 2048 * 2;
constexpr size_t WS_GVT = WS_GQK + (size_t)NGU * 4 * 2048 * 2;
constexpr size_t WS_BAR = WS_GVT + (size_t)NGU * 4096 * 2;
constexpr size_t WS_END = WS_BAR + 16384;
static_assert(WS_END <= (size_t)512 * 1024 * 1024, "workspace too large");
constexpr int LDS_BYTES = 163840;

struct Args { const float* in[26]; float* out; unsigned char* ws; int ph_lo, ph_hi; };

__device__ __forceinline__ float bf2f(bf16_t b) { return __uint_as_float((unsigned)b << 16); }
__device__ __forceinline__ bf16_t f2bf(float f) { unsigned u = __float_as_uint(f); u += 0x7fffu + ((u >> 16) & 1u); return (bf16_t)(u >> 16); }
__device__ __forceinline__ unsigned cvt_pk_bf16(float lo, float hi) { unsigned r; asm volatile("v_cvt_pk_bf16_f32 %0, %1, %2" : "=v"(r) : "v"(lo), "v"(hi)); return r; }
__device__ __forceinline__ float sigmoidf_(float x) { return __builtin_amdgcn_rcpf(1.0f + __expf(-x)); }
__device__ __forceinline__ float siluf_(float x) { return x * __builtin_amdgcn_rcpf(1.0f + __expf(-x)); }
__device__ __forceinline__ float logsigmoidf_(float x) { return x < -30.f ? x : -__logf(1.0f + __expf(-x)); }
__device__ __forceinline__ f32x4 mfma16(bf16x8 a, bf16x8 b, f32x4 c) { return __builtin_amdgcn_mfma_f32_16x16x32_bf16(a, b, c, 0, 0, 0); }

__device__ __forceinline__ float wave_scan_incl(float x) {
    float t;
    t = __int_as_float(__builtin_amdgcn_update_dpp(0, __float_as_int(x), 0x111, 0xf, 0xf, true)); x += t;
    t = __int_as_float(__builtin_amdgcn_update_dpp(0, __float_as_int(x), 0x112, 0xf, 0xf, true)); x += t;
    t = __int_as_float(__builtin_amdgcn_update_dpp(0, __float_as_int(x), 0x114, 0xf, 0xf, true)); x += t;
    t = __int_as_float(__builtin_amdgcn_update_dpp(0, __float_as_int(x), 0x118, 0xf, 0xf, true)); x += t;
    t = __int_as_float(__builtin_amdgcn_update_dpp(0, __float_as_int(x), 0x142, 0xa, 0xf, false)); x += t;
    t = __int_as_float(__builtin_amdgcn_update_dpp(0, __float_as_int(x), 0x143, 0xc, 0xf, false)); x += t;
    return x;
}
#define SHX(x, m) __int_as_float(__builtin_amdgcn_ds_bpermute((F.lane ^ (m)) << 2, __float_as_int(x)))
namespace pg8 {
constexpr int BM = 256, BK = 64, HALF = 128, HTB = HALF * BK * 2, STAGE_BYTES = 8 * HTB, NXCD = 8, WGM = 8;
__host__ __device__ __forceinline__ int lds_byte(int r, int c) { const int st = (r >> 4) * 2 + (c >> 5), rr = r & 15, cc = c & 31, ob = rr * 64 + cc * 2; return st * 1024 + (ob ^ (((ob >> 9) & 1) << 5)); }
__host__ __device__ __forceinline__ void stage_rc(int b, int& R, int& C) { const int st = b / 1024, sb = b % 1024, swz = sb ^ (((sb >> 9) & 1) << 5); R = (st >> 1) * 16 + swz / 64; C = (st & 1) * 32 + (swz % 64) / 2; }
__host__ __device__ __forceinline__ int perm32(int rho) { const int n = rho >> 4, i = rho & 15; return 8 * (i >> 2) + 4 * n + (i & 3); }
struct Unit { int pm, pn, kt0, nt, split, sp; };
struct Gemm { const bf16_t* A; const bf16_t* Bt; int M, N, K; };
struct StaticOrder {
    int nM, nN, nwg, G, c, ntK, nsplit_tiles, ns;
    __device__ __forceinline__ void init(int M, int N, int G_, int c_, int K) { nM = M / BM; nN = N / BM; nwg = nM * nN; G = G_; c = c_; ntK = K / BK; nsplit_tiles = 0; ns = 1; }
    __device__ __forceinline__ void add_split(int ntiles, int ns_) { nsplit_tiles = ntiles; ns = ns_; }
    __device__ __forceinline__ bool next(int i, Unit& u) const {
        const long L = (long)i * G + c;
        const bool sp = L >= nwg;
        const int sidx = sp ? (int)(L - nwg) : 0;
        const bool ok = !sp || sidx < nsplit_tiles * ns;
        const int tile = sidx / ns, spi = sidx % ns;
        int wgid = sp ? 0 : (int)L; { const int q = nwg / NXCD, r = nwg % NXCD, xcd = wgid % NXCD, off = wgid / NXCD; wgid = (xcd < r ? xcd * (q + 1) : r * (q + 1) + (xcd - r) * q) + off; }
        const int nig = WGM * nN, gid = wgid / nig, fm = gid * WGM, gsz = (nM - fm) < WGM ? (nM - fm) : WGM;
        const int pm_f = fm + ((wgid % nig) % gsz), pn_f = (wgid % nig) / gsz;
        const int nts = ntK / ns;
        u.pm = sp ? nM + tile / nN : pm_f; u.pn = sp ? tile % nN : pn_f; u.nt = sp ? nts : ntK; u.kt0 = sp ? spi * nts : 0; u.split = sp ? 1 : 0; u.sp = spi;
        return ok;
    }
    __device__ __forceinline__ void a_ready(const Unit&) const {}
    __device__ __forceinline__ void done(const Unit&) const {}
};
template <int ACT  > struct EpiBf16 {
    static constexpr bool PERM = true;
    bf16_t* O; int ldc;
    __device__ __forceinline__ void operator()(const f32x4 (&acc)[2][2][4][2], const Unit& u, int wr, int wc, int fr, int fq) const {
        const int row0 = u.pm * BM + wr * 64 + fr; const int col0 = u.pn * BM + wc * 32 + 8 * fq;
#pragma unroll
        for (int ai = 0; ai < 2; ++ai)
#pragma unroll
            for (int m = 0; m < 4; ++m) { bf16_t* rowp = O + (size_t)(row0 + ai * HALF + m * 16) * ldc + col0;
#pragma unroll
                for (int bj = 0; bj < 2; ++bj) { f32x4 v0 = acc[ai][bj][m][0], v1 = acc[ai][bj][m][1];
                    if (ACT == 1) {
#pragma unroll
                        for (int j = 0; j < 4; ++j) { float a = fmaxf(v0[j], 0.f), b = fmaxf(v1[j], 0.f); v0[j] = a * a; v1[j] = b * b; } }
                    u32x4 w; w.x = cvt_pk_bf16(v0[0], v0[1]); w.y = cvt_pk_bf16(v0[2], v0[3]); w.z = cvt_pk_bf16(v1[0], v1[1]); w.w = cvt_pk_bf16(v1[2], v1[3]);
                    *(u32x4*)(rowp + bj * HALF) = w; } }
    }
};
struct EpiResid {
    static constexpr bool PERM = false;
    const float* base_lat; const float* base_ctx; float* out_lat; float* out_ctx; const float* mod; int goff; float* part;
    __device__ __forceinline__ void operator()(const f32x4 (&acc)[2][2][4][2], const Unit& u, int wr, int wc, int fr, int fq) const {
        const bool lat = u.pm < (NLAT / BM);
        const float* bp = lat ? base_lat + (size_t)u.pm * BM * DM : base_ctx + (size_t)(u.pm - NLAT / BM) * BM * DM;
        float* op = lat ? out_lat + (size_t)u.pm * BM * DM : out_ctx + (size_t)(u.pm - NLAT / BM) * BM * DM;
        const float* g = mod + (lat ? (u.pm >> 4) : 8) * 6144 + goff;
        const int col0 = u.pn * BM + wc * 32 + 4 * fq;
        f32x4 gv[2][2];
#pragma unroll
        for (int bj = 0; bj < 2; ++bj)
#pragma unroll
            for (int n = 0; n < 2; ++n) gv[bj][n] = *(const f32x4*)(g + col0 + bj * HALF + n * 16);
#pragma unroll
        for (int ai = 0; ai < 2; ++ai)
#pragma unroll
            for (int m = 0; m < 4; ++m) { const size_t ro = (size_t)(wr * 64 + fr + ai * HALF + m * 16) * DM + col0;
#pragma unroll
                for (int bj = 0; bj < 2; ++bj)
#pragma unroll
                    for (int n = 0; n < 2; ++n) {
                        if (u.split) *(f32x4*)(part + (size_t)u.sp * NCTX * DM + (size_t)(u.pm - NLAT / BM) * BM * DM + ro + bj * HALF + n * 16) = gv[bj][n] * acc[ai][bj][m][n];
                        else { const f32x4 bs = *(const f32x4*)(bp + ro + bj * HALF + n * 16); *(f32x4*)(op + ro + bj * HALF + n * 16) = bs + gv[bj][n] * acc[ai][bj][m][n]; } }
                asm volatile("" ::: "memory"); }
    }
};

template <class Epi, class Sched>
__device__ __forceinline__ void gemm_phase(LAS unsigned char* lds, const int tid, const Gemm g, const Sched& S, const Epi& E) {
    const int wid = __builtin_amdgcn_readfirstlane(tid >> 6), lane = tid & 63, wr = wid >> 2, wc = wid & 3, fr = lane & 15, fq = lane >> 4;
    const int K = g.K;
    unsigned voffA[2], voffB[2];
#pragma unroll
    for (int i = 0; i < 2; ++i) { int R, C; stage_rc(tid * 16 + i * 8192, R, C); const int Rb = Epi::PERM ? ((R & ~31) + perm32(R & 31)) : R;
        voffA[i] = (unsigned)(R * K + C) * 2u; voffB[i] = (unsigned)(Rb * K + C) * 2u; }
    const size_t kstep = (size_t)(BK * 2);
    const size_t hstep = (size_t)HALF * K * 2;
    const size_t tstep = 2 * hstep;
    const unsigned ldsw = (unsigned)wid * 1024u;
    const int aoff = lds_byte(wr * 64 + fr, fq * 8), boff = lds_byte(wc * 32 + fr, fq * 8);
#define PG8_SA(b, h) (((b) * 2 + (h)) * HTB)
#define PG8_SB(b, h) ((4 + (b) * 2 + (h)) * HTB)
#define PG8_STAGE(bufoff, gbase, voff) do { _Pragma("unroll") for (int _i = 0; _i < 2; ++_i) \
        __builtin_amdgcn_global_load_lds((const unsigned*)((const char*)(gbase) + (voff)[_i]), (LAS unsigned*)(lds + (bufoff) + ldsw + _i * 8192), 16, 0, 0); } while (0)
#define PG8_LDA(dst, b, h) do { _Pragma("unroll") for (int m = 0; m < 4; ++m) _Pragma("unroll") for (int k = 0; k < 2; ++k) dst[m][k] = *(const LAS bf16x8*)(lds + PG8_SA(b, h) + aoff + m * 2048 + k * 1024); } while (0)
#define PG8_LDB(dst, b, h) do { _Pragma("unroll") for (int n = 0; n < 2; ++n) _Pragma("unroll") for (int k = 0; k < 2; ++k) dst[n][k] = *(const LAS bf16x8*)(lds + PG8_SB(b, h) + boff + n * 2048 + k * 1024); } while (0)
#define PG8_MMA(ai, bj, At, Bt) do { __builtin_amdgcn_s_setprio(1); _Pragma("unroll") for (int m = 0; m < 4; ++m) _Pragma("unroll") for (int n = 0; n < 2; ++n) _Pragma("unroll") for (int k = 0; k < 2; ++k) \
        acc[ai][bj][m][n] = __builtin_amdgcn_mfma_f32_16x16x32_bf16(Bt[n][k], At[m][k], acc[ai][bj][m][n], 0, 0, 0); __builtin_amdgcn_s_setprio(0); } while (0)
#define PG8_WAIT_V(n) asm volatile("s_waitcnt vmcnt(" #n ")" ::: "memory")
#define PG8_WAIT_L(n) asm volatile("s_waitcnt lgkmcnt(" #n ")" ::: "memory")
#define PG8_BAR __builtin_amdgcn_s_barrier()
#define PG8_SCHED __builtin_amdgcn_sched_barrier(0)
    Unit cur, nxt; int ui = 0;
    if (!S.next(0, cur)) return;
    f32x4 acc[2][2][4][2];
#pragma unroll
    for (int a = 0; a < 2; ++a)
#pragma unroll
        for (int b = 0; b < 2; ++b)
#pragma unroll
            for (int m = 0; m < 4; ++m)
#pragma unroll
                for (int n = 0; n < 2; ++n) acc[a][b][m][n] = (f32x4){0.f, 0.f, 0.f, 0.f};
    bf16x8 At[4][2], B0[2][2], B1[2][2];
    const char* cA = (const char*)g.A + (size_t)cur.pm * tstep + (size_t)cur.kt0 * kstep; const char* cB = (const char*)g.Bt + (size_t)cur.pn * tstep + (size_t)cur.kt0 * kstep;
    S.a_ready(cur);
    PG8_STAGE(PG8_SB(0, 0), cB, voffB); PG8_STAGE(PG8_SA(0, 0), cA, voffA); PG8_STAGE(PG8_SB(0, 1), cB + hstep, voffB); PG8_STAGE(PG8_SA(0, 1), cA + hstep, voffA);
    if (wr == 1) PG8_BAR;
    PG8_WAIT_V(4); PG8_BAR;
    PG8_STAGE(PG8_SB(1, 0), cB + kstep, voffB); PG8_STAGE(PG8_SA(1, 0), cA + kstep, voffA); PG8_STAGE(PG8_SB(1, 1), cB + hstep + kstep, voffB);
    PG8_WAIT_V(6); PG8_BAR;
    for (;;) {
        const bool has_next = S.next(ui + 1, nxt);
        const char* nA = has_next ? (const char*)g.A + (size_t)nxt.pm * tstep + (size_t)nxt.kt0 * kstep : cA; const char* nB = has_next ? (const char*)g.Bt + (size_t)nxt.pn * tstep + (size_t)nxt.kt0 * kstep : cB;
        const int nt = cur.nt;
        for (int t = 0; t < nt; t += 2) {
            const bool last = (t == nt - 2);
            const char* a1 = cA + (size_t)(t + 1) * kstep;
            const char* a2 = last ? nA : cA + (size_t)(t + 2) * kstep; const char* b2 = last ? nB : cB + (size_t)(t + 2) * kstep;
            const char* a3 = a2 + kstep; const char* b3 = b2 + kstep;
            if (last && has_next) S.a_ready(nxt);
            PG8_LDB(B0, 0, 0); PG8_SCHED; PG8_LDA(At, 0, 0); PG8_STAGE(PG8_SA(1, 1), a1 + hstep, voffA);
            PG8_WAIT_L(8); PG8_BAR; PG8_WAIT_L(0); PG8_MMA(0, 0, At, B0); PG8_BAR; PG8_SCHED;
            PG8_LDB(B1, 0, 1); PG8_STAGE(PG8_SB(0, 0), b2, voffB);
            PG8_BAR; PG8_WAIT_L(0); PG8_MMA(0, 1, At, B1); PG8_BAR;
            PG8_LDA(At, 0, 1); PG8_STAGE(PG8_SA(0, 0), a2, voffA);
            PG8_BAR; PG8_WAIT_L(0); PG8_MMA(1, 0, At, B0); PG8_BAR; PG8_SCHED;
            PG8_STAGE(PG8_SB(0, 1), b2 + hstep, voffB);
            PG8_WAIT_V(6); PG8_BAR; PG8_MMA(1, 1, At, B1); PG8_BAR;
            PG8_LDB(B0, 1, 0); PG8_SCHED; PG8_LDA(At, 1, 0); PG8_STAGE(PG8_SA(0, 1), a2 + hstep, voffA);
            PG8_WAIT_L(8); PG8_BAR; PG8_WAIT_L(0); PG8_MMA(0, 0, At, B0); PG8_BAR; PG8_SCHED;
            PG8_LDB(B1, 1, 1); PG8_STAGE(PG8_SB(1, 0), b3, voffB);
            PG8_BAR; PG8_WAIT_L(0); PG8_MMA(0, 1, At, B1); PG8_BAR;
            PG8_LDA(At, 1, 1); PG8_STAGE(PG8_SA(1, 0), a3, voffA);
            PG8_BAR; PG8_WAIT_L(0); PG8_MMA(1, 0, At, B0); PG8_BAR; PG8_SCHED;
            PG8_STAGE(PG8_SB(1, 1), b3 + hstep, voffB);
            PG8_WAIT_V(6); PG8_BAR; PG8_MMA(1, 1, At, B1); PG8_BAR;
        }
        E(acc, cur, wr, wc, fr, fq); S.done(cur);
        if (!has_next) break;
#pragma unroll
        for (int a = 0; a < 2; ++a)
#pragma unroll
            for (int b = 0; b < 2; ++b)
#pragma unroll
                for (int m = 0; m < 4; ++m)
#pragma unroll
                    for (int n = 0; n < 2; ++n) acc[a][b][m][n] = (f32x4){0.f, 0.f, 0.f, 0.f};
        cur = nxt; cA = nA; cB = nB; ++ui;
    }
    PG8_WAIT_V(0);
    if (wr == 0) PG8_BAR;
    PG8_BAR;
#undef PG8_SA
#undef PG8_SB
#undef PG8_STAGE
#undef PG8_LDA
#undef PG8_LDB
#undef PG8_MMA
#undef PG8_WAIT_V
#undef PG8_WAIT_L
#undef PG8_BAR
#undef PG8_SCHED
}
}

typedef const float* fptr_t;
struct Frame {
    LAS unsigned char* lds; int tid, lane, wave, G, bid;
    const __attribute__((address_space(4))) fptr_t* inp; float* out; unsigned char* ws;
    __device__ __forceinline__ const float* IN(int i) const { return inp[i]; }
    bf16_t *WtIn, *WtOut, *Wt1, *Wt2, *Wpw, *H, *U, *MIX, *HID, *SinT;
    float *mod, *rope, *XC, *dST, *dec;
    bf16_t *GQK, *GVT;
};

__device__ __forceinline__ void frame_derive(Frame& F) {
    unsigned char* ws = F.ws;
    F.lane = F.tid & 63; F.wave = __builtin_amdgcn_readfirstlane(F.tid >> 6);
    F.WtIn = (bf16_t*)(ws + WS_WTIN); F.WtOut = (bf16_t*)(ws + WS_WTOUT); F.Wt1 = (bf16_t*)(ws + WS_WT1); F.Wt2 = (bf16_t*)(ws + WS_WT2); F.Wpw = (bf16_t*)(ws + WS_WPW);
    F.mod = (float*)(ws + WS_MOD); F.rope = (float*)(ws + WS_ROPE); F.H = (bf16_t*)(ws + WS_H); F.U = (bf16_t*)(ws + WS_U); F.MIX = (bf16_t*)(ws + WS_MIX); F.HID = (bf16_t*)(ws + WS_U);
    F.XC = (float*)(ws + WS_XC); F.dST = (float*)(ws + WS_DST); F.dec = (float*)(ws + WS_DEC); F.SinT = (bf16_t*)(ws + WS_SIN); F.GQK = (bf16_t*)(ws + WS_GQK); F.GVT = (bf16_t*)(ws + WS_GVT);
}
__device__ __forceinline__ void frame_refresh(Frame& F) {
    asm volatile("" : "+v"(F.tid)); asm volatile("" : "+s"(F.ws), "+s"(F.out), "+s"(F.inp), "+s"(F.bid), "+s"(F.G), "+s"(F.lds));
    frame_derive(F);
}
__device__ __forceinline__ void transpose_tile(Frame& F, const float* src, int lds_, int k0, int n0, bf16_t* dst, int ldd) {
    LAS float* T = (LAS float*)F.lds;
    const int r = F.tid >> 4, c4 = (F.tid & 15) * 4;
#pragma unroll
    for (int p = 0; p < 2; ++p) { const int rr = r + p * 32; const f32x4 v = *(const f32x4*)(src + (size_t)(k0 + rr) * lds_ + n0 + c4);
        T[rr * 65 + c4] = v[0]; T[rr * 65 + c4 + 1] = v[1]; T[rr * 65 + c4 + 2] = v[2]; T[rr * 65 + c4 + 3] = v[3]; }
    __syncthreads();
    const int n = F.tid >> 3, kk = (F.tid & 7) * 8;
    u32x4 w;
    w.x = cvt_pk_bf16(T[(kk + 0) * 65 + n], T[(kk + 1) * 65 + n]); w.y = cvt_pk_bf16(T[(kk + 2) * 65 + n], T[(kk + 3) * 65 + n]);
    w.z = cvt_pk_bf16(T[(kk + 4) * 65 + n], T[(kk + 5) * 65 + n]); w.w = cvt_pk_bf16(T[(kk + 6) * 65 + n], T[(kk + 7) * 65 + n]);
    *(u32x4*)(dst + (size_t)(n0 + n) * ldd + k0 + kk) = w;
    __syncthreads();
}

__device__ __forceinline__ void ada_tile(Frame& F, int l, int cgp) {
    LAS float* sc = (LAS float*)F.lds;
    LAS float* red = (LAS float*)(F.lds + 36864);
    const float* c = F.IN(1); const float* cc = F.IN(3);
    for (int i = F.tid; i < 9216; i += 512) { const int j = i >> 10, k = i & 1023; const float v = j < 8 ? c[j * 1024 + k] : cc[k]; sc[i] = siluf_(v); }
    __syncthreads();
    const int n0 = cgp * 64;
    const float* w = F.IN(4) + (size_t)l * 1024 * 6144 + n0 + F.lane;
    float acc[9];
#pragma unroll
    for (int j = 0; j < 9; ++j) acc[j] = 0.f;
    const int kb = F.wave * 128;
#pragma unroll 8
    for (int k = 0; k < 128; ++k) { const float wv = w[(size_t)(kb + k) * 6144];
#pragma unroll
        for (int j = 0; j < 9; ++j) acc[j] += sc[j * 1024 + kb + k] * wv; }
#pragma unroll
    for (int j = 0; j < 9; ++j) red[(F.wave * 9 + j) * 64 + F.lane] = acc[j];
    __syncthreads();
    for (int i = F.tid; i < 576; i += 512) { const int j = i >> 6, col = i & 63; float s = F.IN(5)[l * 6144 + n0 + col];
#pragma unroll
        for (int w8 = 0; w8 < 8; ++w8) s += red[(w8 * 9 + j) * 64 + col];
        F.mod[(size_t)(l * 9 + j) * 6144 + n0 + col] = s; }
    __syncthreads();
}

__device__ __forceinline__ void gate_tile(Frame& F, int l, int kb) {
    const int k = kb * 64 + (F.tid & 63);
    const float* wrow = F.IN(7) + ((size_t)l * 1024 + k) * INW + 2816;
    float z[32];
#pragma unroll
    for (int i = 0; i < 8; ++i) { const f32x4 v = *(const f32x4*)(wrow + 4 * i); z[4 * i] = v[0]; z[4 * i + 1] = v[1]; z[4 * i + 2] = v[2]; z[4 * i + 3] = v[3]; }
    for (int idx = 0; idx < 32; ++idx) {
        const int n = (F.tid >> 6) + 8 * idx, dir = n >> 7, nn = n & 127;
        const float* gw = (dir ? F.IN(19) : F.IN(17)) + (size_t)l * 16 * 128 + nn;
        float s = 0.f;
        if (dir == 0) {
#pragma unroll
            for (int r = 0; r < 16; ++r) s += z[r] * gw[r * 128];
        } else {
#pragma unroll
            for (int r = 0; r < 16; ++r) s += z[16 + r] * gw[r * 128];
        }
        F.WtIn[((size_t)l * NIN + 2816 + n) * DM + k] = f2bf(s);
    }
}

__device__ void phase_setup(Frame& F) {
    constexpr int N_ADA = 192, N_GATE = 32, N_ROPE = 1, TPL = 704 + 256 + 1024 + 1024 + 16, N_TR = 2 * TPL;
    constexpr int N_ITEMS = N_ADA + N_GATE + N_ROPE + N_TR;
    for (int it = F.bid; it < N_ITEMS; it += F.G) {
        frame_refresh(F);
        if (it < N_ADA) { ada_tile(F, it / 96, it % 96); continue; }
        int i = it - N_ADA;
        if (i < N_GATE) { gate_tile(F, i >> 4, i & 15); continue; }
        i -= N_GATE;
        if (i < N_ROPE) {
            const int p = F.tid >> 3, f = F.tid & 7;
            const float inv = powf(10000.0f, -(float)f / 8.0f); const float ang = (float)p * inv;
            F.rope[F.tid] = cosf(ang); F.rope[512 + F.tid] = sinf(ang);
            continue; }
        i -= N_ROPE;
        const int l = i / TPL; int j = i % TPL;
        if (j < 704) { transpose_tile(F, F.IN(7) + (size_t)l * DM * INW, INW, (j / 44) * 64, (j % 44) * 64, F.WtIn + (size_t)l * NIN * DM, DM); continue; }
        j -= 704;
        if (j < 256) { transpose_tile(F, F.IN(22) + (size_t)l * DM * DM, DM, (j / 16) * 64, (j % 16) * 64, F.WtOut + (size_t)l * DM * DM, DM); continue; }
        j -= 256;
        if (j < 1024) { transpose_tile(F, F.IN(24) + (size_t)l * DM * DFF, DFF, (j / 64) * 64, (j % 64) * 64, F.Wt1 + (size_t)l * DFF * DM, DM); continue; }
        j -= 1024;
        if (j < 1024) { transpose_tile(F, F.IN(25) + (size_t)l * DFF * DM, DM, (j / 16) * 64, (j % 16) * 64, F.Wt2 + (size_t)l * DM * DFF, DFF); continue; }
        j -= 1024;
        transpose_tile(F, F.IN(15) + (size_t)l * 65536, 256, (j / 4) * 64, (j % 4) * 64, F.Wpw + (size_t)l * 65536, 256);
    }
}

__device__ void phase_prep(Frame& F, const float* src_lat, const float* src_ctx, const float* modl, int off_sh, int off_sc, const float* gvec, int M, int nparts) {
    for (int row = F.bid * 8 + F.wave; row < M; row += F.G * 8) {
        const float* xp = row < NLAT ? src_lat + (size_t)row * DM : src_ctx + (size_t)(row - NLAT) * DM;
        const float* mp = modl + (row < NLAT ? (row >> 12) : 8) * 6144;
        f32x4 v[4], gq[4], shq[4], scq[4]; float ss = 0.f;
#pragma unroll
        for (int i = 0; i < 4; ++i) { const int c = i * 256 + F.lane * 4;
            gq[i] = *(const f32x4*)(gvec + c); shq[i] = *(const f32x4*)(mp + off_sh + c); scq[i] = *(const f32x4*)(mp + off_sc + c); }
#pragma unroll
        for (int i = 0; i < 4; ++i) { v[i] = *(const f32x4*)(xp + i * 256 + F.lane * 4);
            if (nparts > 0 && row >= NLAT) {
                const float* pp = F.dST + (size_t)(row - NLAT) * DM + i * 256 + F.lane * 4;
                for (int sp = 0; sp < nparts; ++sp) v[i] += *(const f32x4*)(pp + (size_t)sp * NCTX * DM);
                *(f32x4*)(F.XC + (size_t)(row - NLAT) * DM + i * 256 + F.lane * 4) = v[i]; }
            ss += v[i][0] * v[i][0] + v[i][1] * v[i][1] + v[i][2] * v[i][2] + v[i][3] * v[i][3]; }
#pragma unroll
        for (int o = 1; o < 64; o <<= 1) ss += SHX(ss, o);
        const float r = rsqrtf(ss * (1.0f / DM) + EPS);
#pragma unroll
        for (int i = 0; i < 4; ++i) { const int c = i * 256 + F.lane * 4;
            const f32x4 g = gq[i], sh = shq[i], sc = scq[i];
            f32x4 y;
#pragma unroll
            for (int j = 0; j < 4; ++j) y[j] = v[i][j] * r * g[j] * (1.0f + sc[j]) + sh[j];
            u32x2 w; w.x = cvt_pk_bf16(y[0], y[1]); w.y = cvt_pk_bf16(y[2], y[3]);
            *(u32x2*)(F.H + (size_t)row * DM + c) = w; }
    }
}

constexpr int NSLOT = 11;
constexpr int VTL_STRIDE = NSLOT * 64 + 8, VTC_STRIDE = 264;
constexpr int NA_VTL = 0, NA_VTC = NA_VTL + 64 * VTL_STRIDE * 2, NA_RPB = NA_VTC + 64 * VTC_STRIDE * 2, NA_RKL = NA_RPB + 1920, NA_RKC = NA_RKL + NSLOT * 64 * 4, NA_GQ = NA_RKC + 1024, NA_KC = NA_GQ + 256, NA_END = NA_KC + 32768;
static_assert(NA_END <= LDS_BYTES - 16, "na lds");

__device__ __forceinline__ float sumsq8(bf16x8 v) { float s = 0.f;
#pragma unroll
    for (int i = 0; i < 8; ++i) { const float f = bf2f((bf16_t)v[i]); s += f * f; } return s; }

__device__ __forceinline__ void na_qfrag(Frame& F, int h, const bf16_t* qrowp, bf16x8 (&qf)[2]) {
    const int fq = F.lane >> 4;
    const bf16x8 q0 = *(const bf16x8*)(qrowp + C_QA + h * 64 + 8 * fq), q1 = *(const bf16x8*)(qrowp + C_QA + h * 64 + 32 + 8 * fq);
    float ss = sumsq8(q0) + sumsq8(q1); ss += SHX(ss, 16); ss += SHX(ss, 32);
    const float rq = rsqrtf(ss * (1.0f / 64.0f) + EPS);
    LAS float* GQ = (LAS float*)(F.lds + NA_GQ);
    const f32x4 g0 = *(const LAS f32x4*)(GQ + 8 * fq), g1 = *(const LAS f32x4*)(GQ + 8 * fq + 4), g2 = *(const LAS f32x4*)(GQ + 32 + 8 * fq), g3 = *(const LAS f32x4*)(GQ + 36 + 8 * fq);
#pragma unroll
    for (int i = 0; i < 4; ++i) {
        qf[0][i] = (short)f2bf(bf2f((bf16_t)q0[i]) * rq * g0[i]); qf[0][4 + i] = (short)f2bf(bf2f((bf16_t)q0[4 + i]) * rq * g1[i]);
        qf[1][i] = (short)f2bf(bf2f((bf16_t)q1[i]) * rq * g2[i]); qf[1][4 + i] = (short)f2bf(bf2f((bf16_t)q1[4 + i]) * rq * g3[i]); }
}

template <bool LOCAL>
__device__ __forceinline__ void na_wave(Frame& F, int h, const bf16x8 (&qf)[2], const bf16_t* kbase  ,
                                        int qb, int kc0, int ro0, LAS bf16_t* VT, int vstride, int vrow0, f32x4 (&o)[4], float& mrow, float& lrow) {
    constexpr int ntile = 16, tile_base = 0;
    const int fr = F.lane & 15, fq = F.lane >> 4;
    const unsigned klane = (unsigned)(fr * NIN + C_KA + h * 64 + 8 * fq);
    bf16x8 kb[4][2][2];
#define NA_LOADB(bi, buf) do { _Pragma("unroll") for (int tt = 0; tt < 2; ++tt) { const int t_ = (bi) * 2 + tt; if (t_ < ntile) { \
        const bf16_t* tbp = LOCAL ? kbase + (size_t)((t_ >> 1) * 64 + (t_ & 1) * 16) * NIN : kbase + (size_t)((tile_base + t_) * 16) * NIN; \
        if (LOCAL) { kb[buf][tt][0] = *(const bf16x8*)(tbp + klane); kb[buf][tt][1] = *(const bf16x8*)(tbp + klane + 32); } \
        else { kb[buf][tt][0] = *(const LAS bf16x8*)(F.lds + NA_KC + ((t_ * 2) * 64 + F.lane) * 16); kb[buf][tt][1] = *(const LAS bf16x8*)(F.lds + NA_KC + ((t_ * 2 + 1) * 64 + F.lane) * 16); } } } } while (0)
    if (LOCAL) { NA_LOADB(0, 0); NA_LOADB(1, 1); NA_LOADB(2, 2); }
    LAS float* rpb = (LAS float*)(F.lds + NA_RPB);
    LAS float* RKL = (LAS float*)(F.lds + NA_RKL); LAS float* RKC = (LAS float*)(F.lds + NA_RKC);
    int bo[2][4];
    if (LOCAL) {
        const int qcol = 16 * qb + fr; int cs = qcol - 8; cs = cs < 0 ? 0 : (cs > 48 ? 48 : cs);
#pragma unroll
        for (int hc = 0; hc < 2; ++hc)
#pragma unroll
            for (int j = 0; j < 4; ++j) { const int keycol = kc0 + 16 * hc + 4 * fq + j; bo[hc][j] = (keycol >= cs && keycol < cs + 16) ? keycol - qcol + 15 : 31; }
    }
    f32x4 sc[16];
#pragma unroll
    for (int bi = 0; bi < 8; ++bi) {
        asm volatile("" ::: "memory");
        if (LOCAL && bi + 3 < 8) NA_LOADB(bi + 3, (bi + 3) & 3);
        asm volatile("" ::: "memory");
#pragma unroll
        for (int tt = 0; tt < 2; ++tt) {
            const int t = bi * 2 + tt;
            sc[t] = (f32x4){-1e30f, -1e30f, -1e30f, -1e30f};
            if (t < ntile) {
                const f32x4 rk = LOCAL ? *(const LAS f32x4*)(RKL + ((vrow0 + (t >> 1)) % NSLOT) * 64 + kc0 + 16 * (t & 1) + 4 * fq) : *(const LAS f32x4*)(RKC + (tile_base + t) * 16 + 4 * fq);
                f32x4 a = (f32x4){0.f, 0.f, 0.f, 0.f};
                if (LOCAL) { a = mfma16(kb[bi & 3][tt][0], qf[0], a); a = mfma16(kb[bi & 3][tt][1], qf[1], a); }
                else { a = mfma16(*(const LAS bf16x8*)(F.lds + NA_KC + ((t * 2) * 64 + F.lane) * 16), qf[0], a); a = mfma16(*(const LAS bf16x8*)(F.lds + NA_KC + ((t * 2 + 1) * 64 + F.lane) * 16), qf[1], a); }
#pragma unroll
                for (int j = 0; j < 4; ++j) {
                    float sv = a[j] * rk[j];
                    if (LOCAL) sv += rpb[(ro0 + (t >> 1)) * 32 + bo[t & 1][j]];
                    sc[t][j] = sv;
                }
            }
        }
    }
#undef NA_LOADB
    {
        float m = -1e30f;
#pragma unroll
        for (int t = 0; t < 16; ++t) m = fmaxf(fmaxf(fmaxf(m, sc[t][0]), fmaxf(sc[t][1], sc[t][2])), sc[t][3]);
        m = fmaxf(m, SHX(m, 16)); m = fmaxf(m, SHX(m, 32));
        float sm = 0.f;
#pragma unroll
        for (int t = 0; t < 16; ++t)
#pragma unroll
            for (int j = 0; j < 4; ++j) { const float p = __builtin_amdgcn_exp2f(sc[t][j] - m); sc[t][j] = p; sm += p; }
        sm += SHX(sm, 16); sm += SHX(sm, 32);
        mrow = m; lrow = sm;
    }
    int vo[LOCAL ? 1 : 2][2][4];
#pragma unroll
    for (int par = 0; par < (LOCAL ? 1 : 2); ++par)
#pragma unroll
        for (int hc = 0; hc < 2; ++hc)
#pragma unroll
            for (int nb = 0; nb < 4; ++nb) { const int d = nb * 16 + fr;
                vo[par][hc][nb] = d * vstride + (((LOCAL ? kc0 : 32 * par) + 16 * hc + 4 * fq) ^ (((d >> 3) & 7) << 3)) + (LOCAL ? 0 : tile_base * 16);
                asm volatile("" : "+v"(vo[par][hc][nb])); }
#pragma unroll
    for (int nb = 0; nb < 4; ++nb) o[nb] = (f32x4){0.f, 0.f, 0.f, 0.f};
#pragma unroll
    for (int ks = 0; ks < 8; ++ks) {
        if (2 * ks < ntile) {
            union { bf16x8 v; unsigned u[4]; } pb;
            pb.u[0] = cvt_pk_bf16(sc[2 * ks][0], sc[2 * ks][1]); pb.u[1] = cvt_pk_bf16(sc[2 * ks][2], sc[2 * ks][3]);
            pb.u[2] = cvt_pk_bf16(sc[2 * ks + 1][0], sc[2 * ks + 1][1]); pb.u[3] = cvt_pk_bf16(sc[2 * ks + 1][2], sc[2 * ks + 1][3]);
            const int kso = LOCAL ? ((vrow0 + ks) % NSLOT) * 64 : (ks >> 1) * 64;
#pragma unroll
            for (int nb = 0; nb < 4; ++nb) {
                union { bf16x8 v; u32x2 h2[2]; } va;
                va.h2[0] = *(const LAS u32x2*)(VT + vo[LOCAL ? 0 : (ks & 1)][0][nb] + kso);
                va.h2[1] = *(const LAS u32x2*)(VT + vo[LOCAL ? 0 : (ks & 1)][1][nb] + kso);
                o[nb] = mfma16(va.v, pb.v, o[nb]); }
        }
    }
}

__device__ __forceinline__ void stage_ctx(Frame& F, const bf16_t* ctx0, int h, int l) {
    LAS bf16_t* VTC = (LAS bf16_t*)(F.lds + NA_VTC); LAS float* RKC = (LAS float*)(F.lds + NA_RKC);
    if (F.tid < 64) ((LAS float*)(F.lds + NA_GQ))[F.tid] = F.IN(8)[l * 64 + F.tid] * F.IN(9)[l * 64 + F.tid] * (0.125f * 1.4426950408889634f);
#pragma unroll
    for (int it = 0; it < 4; ++it) {
        const int item = it * 512 + F.tid, key = item >> 3, dg = item & 7;
        const bf16x8 v = *(const bf16x8*)(ctx0 + (size_t)key * NIN + C_VA + h * 64 + dg * 8);
        const bf16x8 kk = *(const bf16x8*)(ctx0 + (size_t)key * NIN + C_KA + h * 64 + dg * 8);
        const int kx = key ^ (dg << 3);
#pragma unroll
        for (int i = 0; i < 8; ++i) VTC[(dg * 8 + i) * VTC_STRIDE + kx] = (bf16_t)v[i];
        *(LAS bf16x8*)(F.lds + NA_KC + ((((key >> 4) * 2 + (dg >> 2)) * 64) + (dg & 3) * 16 + (key & 15)) * 16) = kk;
        float ss = sumsq8(kk); ss += SHX(ss, 1); ss += SHX(ss, 2); ss += SHX(ss, 4);
        if (dg == 0) RKC[key] = rsqrtf(ss * (1.0f / 64.0f) + EPS);
    }
}

__device__ __forceinline__ void na_store(Frame& F, int h, int qrow0, const f32x4 (&o)[4], float inv) {
    const int fr = F.lane & 15, fq = F.lane >> 4;
    bf16_t* op = F.MIX + (size_t)(qrow0 + fr) * DM + h * 64 + 4 * fq;
#pragma unroll
    for (int nb = 0; nb < 4; ++nb) { const f32x4 r = o[nb] * inv; u32x2 w; w.x = cvt_pk_bf16(r[0], r[1]); w.y = cvt_pk_bf16(r[2], r[3]); *(u32x2*)(op + nb * 16) = w; }
}

__device__ __forceinline__ void na_band(Frame& F, int l, int unit, bool stage_shared) {
    const int qb = F.wave & 3, half = F.wave >> 2;
    const int b = unit >> 6, h = (unit >> 3) & 7, R = (unit & 7) * 8;
    LAS bf16_t* VTL = (LAS bf16_t*)(F.lds + NA_VTL); LAS bf16_t* VTC = (LAS bf16_t*)(F.lds + NA_VTC); LAS float* RKL = (LAS float*)(F.lds + NA_RKL);
    const bf16_t* lat = F.U + (size_t)(b * SEQ) * NIN; const bf16_t* ctx0 = F.U + (size_t)(NLAT + b * CTXL) * NIN;
    const int skey = F.tid >> 3, sdg = F.tid & 7, skx = skey ^ (sdg << 3);
    const bf16_t* vsrc = lat + (size_t)skey * NIN + C_VA + h * 64 + sdg * 8;
    const bf16_t* ksrc = lat + (size_t)skey * NIN + C_KA + h * 64 + sdg * 8;
#define NA_R0(r_) ((r_) - 4 < 0 ? 0 : ((r_) - 4 > 56 ? 56 : (r_) - 4))
    int hi = NA_R0(R + 1) + 7;
    {
        for (int krow = NA_R0(R); krow <= hi; ++krow) { const bf16x8 v = *(const bf16x8*)(vsrc + (size_t)krow * 64 * NIN), kk = *(const bf16x8*)(ksrc + (size_t)krow * 64 * NIN);
            LAS bf16_t* dst = VTL + (sdg * 8) * VTL_STRIDE + (krow % NSLOT) * 64 + skx;
#pragma unroll
            for (int i = 0; i < 8; ++i) dst[i * VTL_STRIDE] = (bf16_t)v[i];
            float ss = sumsq8(kk); ss += SHX(ss, 1); ss += SHX(ss, 2); ss += SHX(ss, 4);
            if (sdg == 0) RKL[(krow % NSLOT) * 64 + skey] = rsqrtf(ss * (1.0f / 64.0f) + EPS); }
        if (stage_shared) stage_ctx(F, ctx0, h, l);
        LAS float* rpb = (LAS float*)(F.lds + NA_RPB); const float* src = F.IN(10) + ((size_t)l * 8 + h) * 465; if (stage_shared && F.tid < 480) { const int rr_ = F.tid >> 5, cc_ = F.tid & 31; rpb[F.tid] = cc_ < 31 ? src[rr_ * 31 + cc_] * 1.4426950408889634f : -1e30f; }
    }
    __syncthreads();
    int kc0 = 16 * qb - 8; kc0 = kc0 < 0 ? 0 : (kc0 > 32 ? 32 : kc0);
    for (int it2 = 0; it2 < 4; ++it2) {
        asm volatile("" : "+v"(F.lane)); const bf16_t* ctxp = ctx0; asm volatile("" : "+s"(ctxp));
        const int rA = R + 2 * it2, r = rA + half, r0 = NA_R0(r);
        int newhi = it2 < 3 ? NA_R0(rA + 3) + 7 : hi; newhi = newhi > 63 ? 63 : newhi;
        const int nnew = newhi - hi;
        bf16x8 pv0 = (bf16x8){0, 0, 0, 0, 0, 0, 0, 0}, pv1 = pv0, pk0 = pv0, pk1 = pv0;
        if (nnew > 0) { pv0 = *(const bf16x8*)(vsrc + (size_t)(hi + 1) * 64 * NIN); pk0 = *(const bf16x8*)(ksrc + (size_t)(hi + 1) * 64 * NIN); }
        if (nnew > 1) { pv1 = *(const bf16x8*)(vsrc + (size_t)(hi + 2) * 64 * NIN); pk1 = *(const bf16x8*)(ksrc + (size_t)(hi + 2) * 64 * NIN); }
        const int fr = F.lane & 15;
        const int qrow0 = b * SEQ + r * 64 + 16 * qb;
        bf16x8 qf[2];
        na_qfrag(F, h, F.U + (size_t)(qrow0 + fr) * NIN, qf);
        f32x4 oacc[4]; float mrun = -1e30f, lrun = 0.f;
#pragma unroll
        for (int nb = 0; nb < 4; ++nb) oacc[nb] = (f32x4){0.f, 0.f, 0.f, 0.f};
#pragma unroll 1
        for (int ph2 = 0; ph2 < 2; ++ph2) {
            asm volatile("" : "+v"(F.lane) :: "memory");
            f32x4 o[4]; float m1, l1;
            if (ph2 == 0) na_wave<false>(F, h, qf, ctxp, qb, 0, 0, VTC, VTC_STRIDE, 0, o, m1, l1);
            else {
                if (nnew > 0) { const int slot = (hi + 1) % NSLOT; LAS bf16_t* dst = VTL + (sdg * 8) * VTL_STRIDE + slot * 64 + skx;
#pragma unroll
                    for (int i = 0; i < 8; ++i) dst[i * VTL_STRIDE] = (bf16_t)pv0[i];
                    float ss = sumsq8(pk0); ss += SHX(ss, 1); ss += SHX(ss, 2); ss += SHX(ss, 4);
                    if (sdg == 0) RKL[slot * 64 + skey] = rsqrtf(ss * (1.0f / 64.0f) + EPS); }
                if (nnew > 1) { const int slot = (hi + 2) % NSLOT; LAS bf16_t* dst = VTL + (sdg * 8) * VTL_STRIDE + slot * 64 + skx;
#pragma unroll
                    for (int i = 0; i < 8; ++i) dst[i * VTL_STRIDE] = (bf16_t)pv1[i];
                    float ss = sumsq8(pk1); ss += SHX(ss, 1); ss += SHX(ss, 2); ss += SHX(ss, 4);
                    if (sdg == 0) RKL[slot * 64 + skey] = rsqrtf(ss * (1.0f / 64.0f) + EPS); }
                na_wave<true>(F, h, qf, lat + (size_t)(r0 * 64 + kc0) * NIN, qb, kc0, r0 - r + 7, VTL, VTL_STRIDE, r0, o, m1, l1);
            }
            const float M = fmaxf(mrun, m1), a1 = __builtin_amdgcn_exp2f(mrun - M), a2 = __builtin_amdgcn_exp2f(m1 - M);
#pragma unroll
            for (int nb = 0; nb < 4; ++nb) oacc[nb] = oacc[nb] * a1 + o[nb] * a2;
            lrun = lrun * a1 + l1 * a2; mrun = M;
        }
        na_store(F, h, qrow0, oacc, 1.0f / lrun);
        hi = newhi;
        __syncthreads();
    }
#undef NA_R0
}

__device__ __forceinline__ void na_ctx_unit(Frame& F, int l, int u2) {
    const int fr = F.lane & 15;
    const int b = u2 >> 4, qblk = (u2 >> 3) & 1, h = u2 & 7;
    LAS bf16_t* VTC = (LAS bf16_t*)(F.lds + NA_VTC);
    const bf16_t* ctx0 = F.U + (size_t)(NLAT + b * CTXL) * NIN;
    stage_ctx(F, ctx0, h, l);
    __syncthreads();
    const int qrow0 = NLAT + b * CTXL + qblk * 128 + 16 * F.wave;
    bf16x8 qf[2];
    na_qfrag(F, h, F.U + (size_t)(qrow0 + fr) * NIN, qf);
    f32x4 o[4]; float m1, l1;
    na_wave<false>(F, h, qf, ctx0, 0, 0, 0, VTC, VTC_STRIDE, 0, o, m1, l1);
    na_store(F, h, qrow0, o, 1.0f / l1);
    __syncthreads();
}

constexpr int CV_G = 0, CV_ACT = 65536, CV_END = 96256;
static_assert(CV_ACT + 64 * 264 * 2 <= LDS_BYTES, "conv lds");
__device__ __forceinline__ void conv_unit(Frame& F, int l, int unit) {
    const int fr = F.lane & 15, fq = F.lane >> 4;
    int row0, seq0, seqn;
    if (unit < 512) { row0 = unit * 64; seq0 = (unit >> 6) * SEQ; seqn = SEQ; } else { const int u2 = unit - 512; row0 = NLAT + u2 * 64; seq0 = NLAT + (u2 >> 2) * CTXL; seqn = CTXL; }
    LAS float* G = (LAS float*)(F.lds + CV_G);
    for (int item = F.tid; item < 94 * 32; item += 512) {
        const int i = item >> 5, c8 = (item & 31) * 8; const int row = row0 - 15 + i;
        f32x4 g0 = (f32x4){0.f, 0.f, 0.f, 0.f}, g1 = g0;
        if (row >= seq0 && row < seq0 + seqn) {
            const bf16x8 a = *(const bf16x8*)(F.U + (size_t)row * NIN + C_UA + c8), g = *(const bf16x8*)(F.U + (size_t)row * NIN + C_UG + c8);
#pragma unroll
            for (int e = 0; e < 4; ++e) { g0[e] = bf2f((bf16_t)a[e]) * sigmoidf_(bf2f((bf16_t)g[e])); g1[e] = bf2f((bf16_t)a[4 + e]) * sigmoidf_(bf2f((bf16_t)g[4 + e])); }
        }
        *(LAS f32x4*)(G + i * 256 + c8) = g0; *(LAS f32x4*)(G + i * 256 + c8 + 4) = g1;
    }
    __syncthreads();
    const int ch = F.tid & 255, tg = F.tid >> 8;
    float acc[32];
    {
        float w[31];
        const float* cw = F.IN(11) + (size_t)l * 31 * 256 + ch;
#pragma unroll
        for (int j = 0; j < 31; ++j) w[j] = cw[j * 256];
        const float cb = F.IN(12)[l * 256 + ch];
#pragma unroll
        for (int tb = 0; tb < 4; ++tb) {
            float xr[38];
#pragma unroll
            for (int i = 0; i < 38; ++i) xr[i] = G[(tg * 32 + tb * 8 + i) * 256 + ch];
#pragma unroll
            for (int o = 0; o < 8; ++o) { float a = cb;
#pragma unroll
                for (int j = 0; j < 31; ++j) a += w[j] * xr[o + j];
                acc[tb * 8 + o] = a; }
        }
    }
    __syncthreads();
#pragma unroll
    for (int t = 0; t < 32; ++t) G[(tg * 32 + t) * 256 + ch] = acc[t];
    __syncthreads();
    LAS bf16_t* ACT = (LAS bf16_t*)(F.lds + CV_ACT);
    {
        const f32x4 lg = *(const f32x4*)(F.IN(13) + l * 256 + F.lane * 4), lb = *(const f32x4*)(F.IN(14) + l * 256 + F.lane * 4);
#pragma unroll
        for (int tt = 0; tt < 8; ++tt) { const int t = F.wave * 8 + tt;
            const f32x4 v = *(const LAS f32x4*)(G + t * 256 + F.lane * 4);
            float s = v[0] + v[1] + v[2] + v[3];
#pragma unroll
            for (int o = 1; o < 64; o <<= 1) s += SHX(s, o);
            const float mu = s * (1.0f / 256.0f);
            const f32x4 dv = v - mu; float q = dv[0] * dv[0] + dv[1] * dv[1] + dv[2] * dv[2] + dv[3] * dv[3];
#pragma unroll
            for (int o = 1; o < 64; o <<= 1) q += SHX(q, o);
            const float rs = rsqrtf(q * (1.0f / 256.0f) + EPS);
            float y[4];
#pragma unroll
            for (int e = 0; e < 4; ++e) y[e] = siluf_(dv[e] * rs * lg[e] + lb[e]);
            u32x2 w; w.x = cvt_pk_bf16(y[0], y[1]); w.y = cvt_pk_bf16(y[2], y[3]);
            *(LAS u32x2*)(ACT + t * 264 + F.lane * 4) = w; }
    }
    __syncthreads();
    f32x4 o[4][2];
#pragma unroll
    for (int mb = 0; mb < 4; ++mb) { o[mb][0] = (f32x4){0.f, 0.f, 0.f, 0.f}; o[mb][1] = o[mb][0]; }
    const bf16_t* wp = F.Wpw + (size_t)l * 65536 + (size_t)(F.wave * 32 + fr) * 256 + 8 * fq;
#pragma unroll
    for (int ks = 0; ks < 8; ++ks) {
        const bf16x8 b0 = *(const bf16x8*)(wp + ks * 32), b1 = *(const bf16x8*)(wp + 16 * 256 + ks * 32);
#pragma unroll
        for (int mb = 0; mb < 4; ++mb) { const bf16x8 a = *(const LAS bf16x8*)(ACT + (mb * 16 + fr) * 264 + ks * 32 + 8 * fq);
            o[mb][0] = mfma16(b0, a, o[mb][0]); o[mb][1] = mfma16(b1, a, o[mb][1]); }
    }
#pragma unroll
    for (int nn = 0; nn < 2; ++nn) { const int n = F.wave * 32 + nn * 16 + 4 * fq; const f32x4 pb = *(const f32x4*)(F.IN(16) + l * 256 + n);
#pragma unroll
        for (int mb = 0; mb < 4; ++mb) { const f32x4 r = o[mb][nn] + pb; u32x2 w; w.x = cvt_pk_bf16(r[0], r[1]); w.y = cvt_pk_bf16(r[2], r[3]);
            *(u32x2*)(F.MIX + (size_t)(row0 + mb * 16 + fr) * DM + 512 + n) = w; } }
    __syncthreads();
}

struct GlaLd { bf16x8 af, ab, qo, qp, ko, kp, v0, v1; };
__device__ __forceinline__ void gla_unit_decode(int unit, int& b, int& cc, int& h, int& row0);
__device__ __forceinline__ void gla_load(Frame& F, int pair, GlaLd& g) {
    const int slot = F.wave >> 2, w4 = F.wave & 3, t4 = F.tid & 255;
    int b, cc, h, row0; gla_unit_decode(pair * 2 + slot, b, cc, h, row0);
    const bf16_t* rp = F.U + (size_t)(row0 + F.lane) * NIN;
    g.af = *(const bf16x8*)(rp + C_GF + h * 32 + 8 * w4); g.ab = *(const bf16x8*)(rp + C_GB + h * 32 + 8 * w4);
    g.qo = *(const bf16x8*)(rp + C_QG + h * 32 + 8 * w4); g.qp = *(const bf16x8*)(rp + C_QG + h * 32 + 8 * (w4 ^ 1));
    g.ko = *(const bf16x8*)(rp + C_KG + h * 32 + 8 * w4); g.kp = *(const bf16x8*)(rp + C_KG + h * 32 + 8 * (w4 ^ 1));
    g.v0 = *(const bf16x8*)(F.U + (size_t)(row0 + (t4 >> 3)) * NIN + C_VG + h * 64 + (t4 & 7) * 8);
    g.v1 = *(const bf16x8*)(F.U + (size_t)(row0 + 32 + (t4 >> 3)) * NIN + C_VG + h * 64 + (t4 & 7) * 8);
}
__device__ __forceinline__ void gla_prep(Frame& F, const GlaLd& g, int l, int b, int cc, int h, int row0, int w4, float (&qF)[8], float (&kF)[8], float (&qB)[8], float (&kB)[8], float (&totF)[8], float (&totB)[8]) {
    const int lane = F.lane;
    const bf16x8 af = g.af, ab = g.ab, qo = g.qo, qp = g.qp, ko = g.ko, kp = g.kp;
    const bool isctx = cc < 4;
    const int p = (w4 < 2) ? (cc - 4) : lane;
    float gbf[8], gbb[8], rcs[8], rsn[8];
    {
        const float* pf = F.IN(18) + l * 128 + h * 32 + 8 * w4; const float* pb_ = F.IN(20) + l * 128 + h * 32 + 8 * w4;
        const f32x4 a0 = *(const f32x4*)pf, a1 = *(const f32x4*)(pf + 4), b0 = *(const f32x4*)pb_, b1 = *(const f32x4*)(pb_ + 4);
        const int pp = isctx ? 0 : p;
        const f32x4 c0 = *(const f32x4*)(F.rope + pp * 8), c1 = *(const f32x4*)(F.rope + pp * 8 + 4), s0 = *(const f32x4*)(F.rope + 512 + pp * 8), s1 = *(const f32x4*)(F.rope + 512 + pp * 8 + 4);
#pragma unroll
        for (int i = 0; i < 4; ++i) { gbf[i] = a0[i]; gbf[4 + i] = a1[i]; gbb[i] = b0[i]; gbb[4 + i] = b1[i]; rcs[i] = c0[i]; rcs[4 + i] = c1[i]; rsn[i] = s0[i]; rsn[4 + i] = s1[i]; }
    }
    const float qscale = 0.17677669529663687f;
#pragma unroll
    for (int i = 0; i < 8; ++i) {
        const float laf = logsigmoidf_(bf2f((bf16_t)af[i]) + gbf[i]) * (1.0f / 16.0f), lab = logsigmoidf_(bf2f((bf16_t)ab[i]) + gbb[i]) * (1.0f / 16.0f);
        const float cf = wave_scan_incl(laf), pb = wave_scan_incl(lab);
        totF[i] = __int_as_float(__builtin_amdgcn_readlane(__float_as_int(cf), 63)); totB[i] = __int_as_float(__builtin_amdgcn_readlane(__float_as_int(pb), 63));
        const float cb = totB[i] - pb + lab;
        float q = bf2f((bf16_t)qo[i]), k = bf2f((bf16_t)ko[i]);
        if (!isctx) {
            const float cs = rcs[i], sn = rsn[i];
            const float q2 = bf2f((bf16_t)qp[i]), k2 = bf2f((bf16_t)kp[i]);
            if (w4 & 1) { q = q2 * sn + q * cs; k = k2 * sn + k * cs; } else { q = q * cs - q2 * sn; k = k * cs - k2 * sn; }
        }
        q *= qscale;
        const float ef = __expf(cf), eb = __expf(cb);
        qF[i] = q * ef; kF[i] = k * __expf(-cf); qB[i] = q * eb; kB[i] = k * __expf(-cb);
    }
}
__device__ __forceinline__ void gla_unit_decode(int unit, int& b, int& cc, int& h, int& row0) {
    h = unit & 3; const int t = unit >> 2; cc = t % NCHUNK; b = t / NCHUNK;
    row0 = cc < 4 ? NLAT + b * CTXL + cc * 64 : b * SEQ + (cc - 4) * 64;
}
__device__ __forceinline__ void gla_stage_vt(const GlaLd& g, LAS bf16_t* VT, int t4) {
    const int s = t4 >> 3, dg = t4 & 7;
#pragma unroll
    for (int i = 0; i < 8; ++i) { VT[(dg * 8 + i) * 72 + s] = (bf16_t)g.v0[i]; VT[(dg * 8 + i) * 72 + 32 + s] = (bf16_t)g.v1[i]; }
}

constexpr int GL_SLOT = 18432 + 256;
__device__ __forceinline__ void gla_local_pair(Frame& F, int l, int pair, const GlaLd& g) {
    const int fr = F.lane & 15, fq = F.lane >> 4;
    const int slot = F.wave >> 2, w4 = F.wave & 3, t4 = F.tid & 255;
    const int unit = pair * 2 + slot; int b, cc, h, row0; gla_unit_decode(unit, b, cc, h, row0);
    LAS unsigned char* sb = F.lds + slot * GL_SLOT;
    LAS bf16_t* KT[2] = {(LAS bf16_t*)sb, (LAS bf16_t*)(sb + 4608)}; LAS bf16_t* VT = (LAS bf16_t*)(sb + 9216); LAS float* TOT = (LAS float*)(sb + 18432);
    {
        float qF[8], kF[8], qB[8], kB[8], totF[8], totB[8];
        gla_prep(F, g, l, b, cc, h, row0, w4, qF, kF, qB, kB, totF, totB);
#pragma unroll
        for (int i = 0; i < 8; ++i) { KT[0][(8 * w4 + i) * 72 + F.lane] = f2bf(kF[i]); KT[1][(8 * w4 + i) * 72 + F.lane] = f2bf(kB[i]); }
        {
            bf16_t* gq = F.GQK + (size_t)unit * 8192 + F.lane * 32 + 8 * w4; u32x4 w;
            w.x = cvt_pk_bf16(qF[0], qF[1]); w.y = cvt_pk_bf16(qF[2], qF[3]); w.z = cvt_pk_bf16(qF[4], qF[5]); w.w = cvt_pk_bf16(qF[6], qF[7]); *(u32x4*)(gq) = w;
            w.x = cvt_pk_bf16(kF[0], kF[1]); w.y = cvt_pk_bf16(kF[2], kF[3]); w.z = cvt_pk_bf16(kF[4], kF[5]); w.w = cvt_pk_bf16(kF[6], kF[7]); *(u32x4*)(gq + 2048) = w;
            w.x = cvt_pk_bf16(qB[0], qB[1]); w.y = cvt_pk_bf16(qB[2], qB[3]); w.z = cvt_pk_bf16(qB[4], qB[5]); w.w = cvt_pk_bf16(qB[6], qB[7]); *(u32x4*)(gq + 4096) = w;
            w.x = cvt_pk_bf16(kB[0], kB[1]); w.y = cvt_pk_bf16(kB[2], kB[3]); w.z = cvt_pk_bf16(kB[4], kB[5]); w.w = cvt_pk_bf16(kB[6], kB[7]); *(u32x4*)(gq + 6144) = w;
        }
        if (F.lane == 0) {
#pragma unroll
            for (int i = 0; i < 8; ++i) { TOT[8 * w4 + i] = totF[i]; TOT[32 + 8 * w4 + i] = totB[i];
                F.dec[(size_t)(unit * 2 + 0) * 32 + 8 * w4 + i] = __expf(totF[i]); F.dec[(size_t)(unit * 2 + 1) * 32 + 8 * w4 + i] = __expf(totB[i]); } }
    }
    gla_stage_vt(g, VT, t4);
    __syncthreads();
    {
#pragma unroll
        for (int it2 = 0; it2 < 2; ++it2) { const int item = it2 * 256 + t4, dv = item >> 3, s8 = (item & 7) * 8;
            *(u32x4*)(F.GVT + (size_t)unit * 4096 + dv * 64 + s8) = *(const LAS u32x4*)(VT + dv * 72 + s8); }
    }
    const int dir = w4 >> 1, mb = w4 & 1;
    f32x4 acc[4];
#pragma unroll
    for (int nb = 0; nb < 4; ++nb) acc[nb] = (f32x4){0.f, 0.f, 0.f, 0.f};
#pragma unroll
    for (int ks = 0; ks < 2; ++ks) { const bf16x8 a = *(const LAS bf16x8*)(KT[dir] + (mb * 16 + fr) * 72 + ks * 32 + 8 * fq);
#pragma unroll
        for (int nb = 0; nb < 4; ++nb) { const bf16x8 vb = *(const LAS bf16x8*)(VT + (nb * 16 + fr) * 72 + ks * 32 + 8 * fq); acc[nb] = mfma16(a, vb, acc[nb]); } }
    f32x4 sc4;
#pragma unroll
    for (int j = 0; j < 4; ++j) sc4[j] = __expf(TOT[dir * 32 + mb * 16 + 4 * fq + j]);
#pragma unroll
    for (int nb = 0; nb < 4; ++nb) *(f32x4*)(F.dST + (size_t)(unit * 2 + dir) * 2048 + (nb * 16 + fr) * 32 + mb * 16 + 4 * fq) = acc[nb] * sc4;
    __syncthreads();
}

__device__ void phase_gla_scan(Frame& F) {
    for (int e = F.bid * 512 + F.tid; e < NBATCH * 4 * 2 * 2048; e += F.G * 512) {
        const int inner = e & 2047, dir = (e >> 11) & 1, h = (e >> 12) & 3, b = e >> 14, d = inner & 31;
        float S = 0.f;
#pragma unroll 1
        for (int half = 0; half < 2; ++half) {
            float dc[34], ds[34];
#pragma unroll
            for (int i = 0; i < 34; ++i) { const int step = half * 34 + i;
                const int cc = dir == 0 ? step : (step < 4 ? 3 - step : 71 - step);
                const int unit = (b * NCHUNK + cc) * 4 + h;
                dc[i] = F.dec[(size_t)(unit * 2 + dir) * 32 + d]; ds[i] = F.dST[(size_t)(unit * 2 + dir) * 2048 + inner]; }
#pragma unroll
            for (int i = 0; i < 34; ++i) { const int step = half * 34 + i;
                const int cc = dir == 0 ? step : (step < 4 ? 3 - step : 71 - step);
                const int unit = (b * NCHUNK + cc) * 4 + h;
                F.SinT[(size_t)(unit * 2 + dir) * 2048 + inner] = f2bf(S);
                S = dc[i] * S + ds[i]; }
        }
    }
}

__device__ __forceinline__ void gla_out_wave(Frame& F, int l, int unit, int tb) {
    const int fr = F.lane & 15, fq = F.lane >> 4;
    int b, cc, h, row0; gla_unit_decode(unit, b, cc, h, row0);
    LAS bf16_t* ATT = (LAS bf16_t*)(F.lds + F.wave * 2304);
    const bf16_t* gq = F.GQK + (size_t)unit * 8192; const bf16_t* gv = F.GVT + (size_t)unit * 4096;
    bf16x8 qa2[2], kb2[2][4], vb2[2][4], sb2[2][4];
#pragma unroll
    for (int dir = 0; dir < 2; ++dir) {
        qa2[dir] = *(const bf16x8*)(gq + dir * 4096 + (tb * 16 + fr) * 32 + 8 * fq);
#pragma unroll
        for (int sbk = 0; sbk < 4; ++sbk) { const bool valid = dir == 0 ? (sbk <= tb) : (sbk >= tb);
            kb2[dir][sbk] = valid ? *(const bf16x8*)(gq + dir * 4096 + 2048 + (sbk * 16 + fr) * 32 + 8 * fq) : (bf16x8){0, 0, 0, 0, 0, 0, 0, 0}; }
#pragma unroll
        for (int nb = 0; nb < 4; ++nb) sb2[dir][nb] = *(const bf16x8*)(F.SinT + (size_t)(unit * 2 + dir) * 2048 + (nb * 16 + fr) * 32 + 8 * fq);
    }
#pragma unroll
    for (int ks = 0; ks < 2; ++ks)
#pragma unroll
        for (int nb = 0; nb < 4; ++nb) vb2[ks][nb] = *(const bf16x8*)(gv + (nb * 16 + fr) * 64 + ks * 32 + 8 * fq);
    u32x2 rw4[4]; f32x4 og4[4];
    const size_t orow = (size_t)(row0 + tb * 16 + fr);
#pragma unroll
    for (int nb = 0; nb < 4; ++nb) { rw4[nb] = *(const u32x2*)(F.U + orow * NIN + C_RG + h * 64 + nb * 16 + 4 * fq); og4[nb] = *(const f32x4*)(F.IN(21) + l * 64 + nb * 16 + 4 * fq); }
    f32x4 o[4];
#pragma unroll
    for (int nb = 0; nb < 4; ++nb) o[nb] = (f32x4){0.f, 0.f, 0.f, 0.f};
#pragma unroll
    for (int dir = 0; dir < 2; ++dir) {
        const bf16x8 qa = qa2[dir];
#pragma unroll
        for (int sbk = 0; sbk < 4; ++sbk) {
            const bool valid = dir == 0 ? (sbk <= tb) : (sbk >= tb);
            f32x4 a = (f32x4){0.f, 0.f, 0.f, 0.f};
            if (valid) a = mfma16(qa, kb2[dir][sbk], a);
#pragma unroll
            for (int j = 0; j < 4; ++j) { float v = a[j];
                if (sbk == tb) { const bool keep = dir == 0 ? (fr <= 4 * fq + j) : (fr >= 4 * fq + j); v = keep ? v : 0.f; }
                ATT[(4 * fq + j) * 72 + sbk * 16 + fr] = f2bf(v); }
        }
        asm volatile("s_waitcnt lgkmcnt(0)" ::: "memory");
#pragma unroll
        for (int ks = 0; ks < 2; ++ks) { const bf16x8 pa = *(const LAS bf16x8*)(ATT + fr * 72 + ks * 32 + 8 * fq);
#pragma unroll
            for (int nb = 0; nb < 4; ++nb) o[nb] = mfma16(vb2[ks][nb], pa, o[nb]); }
#pragma unroll
        for (int nb = 0; nb < 4; ++nb) o[nb] = mfma16(sb2[dir][nb], qa, o[nb]);
        asm volatile("s_waitcnt lgkmcnt(0)" ::: "memory");
    }
    {
        float ss = 0.f;
#pragma unroll
        for (int nb = 0; nb < 4; ++nb) ss += o[nb][0] * o[nb][0] + o[nb][1] * o[nb][1] + o[nb][2] * o[nb][2] + o[nb][3] * o[nb][3];
        ss += SHX(ss, 16); ss += SHX(ss, 32);
        const float rinv = rsqrtf(ss * (1.0f / 64.0f) + EPS);
        const size_t row = (size_t)(row0 + tb * 16 + fr);
#pragma unroll
        for (int nb = 0; nb < 4; ++nb) { const int dv = nb * 16 + 4 * fq;
            const u32x2 rw = rw4[nb]; const f32x4 og = og4[nb];
            const float r0_ = __uint_as_float(rw.x << 16), r1_ = __uint_as_float(rw.x & 0xffff0000u), r2_ = __uint_as_float(rw.y << 16), r3_ = __uint_as_float(rw.y & 0xffff0000u);
            u32x2 w; w.x = cvt_pk_bf16(o[nb][0] * rinv * og[0] * siluf_(r0_), o[nb][1] * rinv * og[1] * siluf_(r1_));
            w.y = cvt_pk_bf16(o[nb][2] * rinv * og[2] * siluf_(r2_), o[nb][3] * rinv * og[3] * siluf_(r3_));
            *(u32x2*)(F.MIX + row * DM + 768 + h * 64 + dv) = w; }
    }
}

__device__ void phase_mixers(Frame& F, int l) {
    const int n_na = 512 + (l == 0 ? 128 : 0), n_cv = 512 + (l == 0 ? 32 : 0), n_gl = NGU / 2;
    for (int it = F.bid; it < n_na + n_cv; it += F.G) {
        frame_refresh(F);
        if (it < n_na) {
            if (it < 512) {
                const int wb = it & 255, second = it >> 8, rest = wb >> 3;
                na_band(F, l, ((wb & 7) << 6) | ((rest >> 2) << 3) | ((rest & 3) * 2 + second), second == 0 || F.G != 256);
            } else na_ctx_unit(F, l, it - 512); }
        else conv_unit(F, l, it - n_na);
    }
    const int base = n_na + n_cv;
    int it = base + ((F.bid - base % F.G) + F.G) % F.G;
    frame_refresh(F);
    GlaLd cur;
    if (it < base + n_gl) gla_load(F, it - base, cur);
    for (; it < base + n_gl; it += F.G) {
        frame_refresh(F);
        GlaLd nxt = cur;
        if (it + F.G < base + n_gl) gla_load(F, it + F.G - base, nxt);
        gla_local_pair(F, l, it - base, cur);
        cur = nxt;
    }
}
__device__ void phase_gla_out(Frame& F, int l) {
    for (int it = F.bid * 8 + F.wave; it < NGU * 4; it += F.G * 8) gla_out_wave(F, l, it >> 2, it & 3);
}

#define XB_TMO      128
#define XB_XCNT(j)  (256  + 64 * (j))
#define XB_XSUB(j)  (1280 + 64 * (j))
#define XB_XGEN(j)  (2304 + 64 * (j))
#define XB_TOP      3328
#define XB_TOPGEN   3392
#define XCD_BAR_WORDS 3456
#define XB_SPIN_CAP (1u << 23)
__device__ __forceinline__ unsigned xb_ld(unsigned* p)              { return __hip_atomic_load(p, __ATOMIC_RELAXED, __HIP_MEMORY_SCOPE_AGENT); }
__device__ __forceinline__ unsigned xb_add(unsigned* p, unsigned v) { return __hip_atomic_fetch_add(p, v, __ATOMIC_RELAXED, __HIP_MEMORY_SCOPE_AGENT); }
__device__ __forceinline__ unsigned xb_xcc_id() { return (unsigned)__builtin_amdgcn_s_getreg((3 << 11) | 20) & 0xFu; }
#define XB_SPIN(cond, bar) do { unsigned _sp = 0; while (cond) { __builtin_amdgcn_s_sleep(1); \
    if ((++_sp & 255u) == 0u) { if (xb_ld(&(bar)[XB_TMO])) break; if (_sp > XB_SPIN_CAP) { atomicAdd(&(bar)[XB_TMO], 1u); break; } } } } while (0)
struct XcdBarrier { unsigned* bar; unsigned x; volatile LAS unsigned* st; };
__device__ __forceinline__ XcdBarrier xcd_barrier_post(unsigned* bar, volatile LAS unsigned* st) {
    XcdBarrier b; b.bar = bar; b.x = xb_xcc_id(); b.st = st;
    if (threadIdx.x == 0) (void)xb_add(&bar[XB_XCNT(b.x)], 1u);
    return b;
}
__device__ __forceinline__ void xcd_barrier_complete(unsigned* bar, unsigned x, unsigned& nloc, unsigned& nx) {
    const unsigned G = gridDim.x * gridDim.y * gridDim.z;
    unsigned sum, cnt, mine, sp = 0u;
    for (;;) {
        sum = 0u; cnt = 0u; mine = 0u;
#pragma unroll
        for (unsigned j = 0; j < 16; ++j) { const unsigned c = xb_ld(&bar[XB_XCNT(j)]); sum += c; cnt += (c > 0u) ? 1u : 0u; mine = (j == x) ? c : mine; }
        if (sum == G) break;
        __builtin_amdgcn_s_sleep(1);
        if ((++sp & 255u) == 0u) { if (xb_ld(&bar[XB_TMO])) break; if (sp > XB_SPIN_CAP) { atomicAdd(&bar[XB_TMO], 1u); break; } }
    }
    nloc = mine > 0u ? mine : 1u; nx = cnt > 0u ? cnt : 1u;
}
__device__ __forceinline__ void xcd_barrier(const XcdBarrier& b, const bool t0) {
    asm volatile("s_waitcnt vmcnt(0)" ::: "memory");
    __syncthreads();
    if (t0) {
        unsigned* bar = b.bar;
        __builtin_amdgcn_s_waitcnt(0);
        unsigned nloc = b.st[0], nx = b.st[1];
        if (nloc == 0u) { xcd_barrier_complete(bar, b.x, nloc, nx); b.st[0] = nloc; b.st[1] = nx; }
        const unsigned old = xb_add(&bar[XB_XSUB(b.x)], 1u);
        const unsigned gen = old / nloc;
        if (old + 1u == (gen + 1u) * nloc) {
            __builtin_amdgcn_fence(__ATOMIC_RELEASE, "agent");
            asm volatile("s_waitcnt vmcnt(0)" ::: "memory");
            const unsigned og = xb_add(&bar[XB_TOP], 1u);
            const unsigned tg = og / nx;
            if (og + 1u == (tg + 1u) * nx) xb_add(&bar[XB_TOPGEN], 1u);
            else XB_SPIN(xb_ld(&bar[XB_TOPGEN]) == tg, bar);
            __builtin_amdgcn_fence(__ATOMIC_ACQUIRE, "agent");
            xb_add(&bar[XB_XGEN(b.x)], 1u);
            asm volatile("s_waitcnt vmcnt(0)" ::: "memory");
        } else {
            XB_SPIN(xb_ld(&bar[XB_XGEN(b.x)]) == gen, bar);
            __builtin_amdgcn_fence(__ATOMIC_ACQUIRE, "agent");
            asm volatile("s_waitcnt vmcnt(0)" ::: "memory");
        }
    }
    __syncthreads();
}

constexpr int N_PHASES = 1 + 9 * DEPTH;

__device__ __forceinline__ void run_phase(Frame& F, int ph) {
#ifndef PH_MASK
#define PH_MASK 0x3ff
#endif
    if (ph == 0) { if (PH_MASK & 1) phase_setup(F); return; }
    const int l = (ph - 1) / 9, s = (ph - 1) % 9;
    const float* modl = F.mod + (size_t)l * 9 * 6144;
    const float* xlat = l == 0 ? F.IN(0) : F.out;
    const float* xctx = l == 0 ? F.IN(2) : F.XC;
    const int Mfull = l == 0 ? MTOT : NLAT;
    pg8::StaticOrder S;
    switch (s) {
    case 0: if (PH_MASK & 2) phase_prep(F, xlat, xctx, modl, 0, 1024, F.IN(6) + l * DM, MTOT, l == 0 ? 0 : 8); break;
    case 1: if (PH_MASK & 4) { pg8::Gemm g{F.H, F.WtIn + (size_t)l * NIN * DM, MTOT, NIN, DM}; S.init(MTOT, NIN, F.G, F.bid, DM); pg8::EpiBf16<0> E{F.U, NIN}; pg8::gemm_phase(F.lds, F.tid, g, S, E); } break;
    case 2: if (PH_MASK & 8) phase_mixers(F, l); break;
    case 3: if (PH_MASK & 16) phase_gla_scan(F); break;
    case 4: if (PH_MASK & 32) phase_gla_out(F, l); break;
    case 5: if (PH_MASK & 64) { pg8::Gemm g{F.MIX, F.WtOut + (size_t)l * DM * DM, Mfull, DM, DM}; S.init(NLAT, DM, F.G, F.bid, DM); if (l == 0) S.add_split(32, 4); pg8::EpiResid E{xlat, xctx, F.out, F.XC, modl, 2048, F.dST}; pg8::gemm_phase(F.lds, F.tid, g, S, E); } break;
    case 6: if (PH_MASK & 128) phase_prep(F, F.out, l == 0 ? xctx : F.XC, modl, 3072, 4096, F.IN(23) + l * DM, Mfull, l == 0 ? 4 : 0); break;
    case 7: if (PH_MASK & 256) { pg8::Gemm g{F.H, F.Wt1 + (size_t)l * DFF * DM, Mfull, DFF, DM}; S.init(Mfull, DFF, F.G, F.bid, DM); pg8::EpiBf16<1> E{F.HID, DFF}; pg8::gemm_phase(F.lds, F.tid, g, S, E); } break;
    case 8: if (PH_MASK & 512) { pg8::Gemm g{F.HID, F.Wt2 + (size_t)l * DM * DFF, Mfull, DM, DFF}; S.init(NLAT, DM, F.G, F.bid, DFF); if (l == 0) S.add_split(32, 8); pg8::EpiResid E{F.out, F.XC, F.out, F.XC, modl, 5120, F.dST}; pg8::gemm_phase(F.lds, F.tid, g, S, E); } break;
    }
}

__global__ void __launch_bounds__(512, 2) mk_fwd(Args args) {
    extern __shared__ __attribute__((aligned(16))) unsigned char lds_raw[];
    const int wave0 = __builtin_amdgcn_readfirstlane((int)threadIdx.x >> 6);
    volatile LAS unsigned* bst = (volatile LAS unsigned*)((LAS unsigned char*)lds_raw + LDS_BYTES - 16);
    if (threadIdx.x == 0) { bst[0] = 0u; bst[1] = 0u; }
    __syncthreads();
    XcdBarrier xbar; xbar.bar = (unsigned*)(args.ws + WS_BAR); xbar.x = 0; xbar.st = bst;
    if (args.ph_hi - args.ph_lo > 1) xbar = xcd_barrier_post((unsigned*)(args.ws + WS_BAR), bst);
    for (int step = args.ph_lo; step < args.ph_hi; ++step) {
        int ph = step;
#ifdef PROBE_KIND
        { const int P = PROBE_KIND == 9 ? 0 : 1 + PROBE_KIND, Q = PROBE_KIND == 9 ? 1000 : 10 + PROBE_KIND; ph = step - (step > P ? 1 : 0) - (step > Q + 1 ? 1 : 0); }
#endif
        if (step > args.ph_lo) { if (args.ph_hi < 0) cg::this_grid().sync();
            else { unsigned on2 = ~0u; asm volatile("" : "+s"(on2)); xcd_barrier(xbar, wave0 == 0 && __builtin_amdgcn_mbcnt_hi(on2, __builtin_amdgcn_mbcnt_lo(on2, 0u)) == 0u); } }
        Frame F;
        unsigned ones = ~0u; int w0 = wave0; asm volatile("" : "+s"(ones), "+s"(w0));
        int tid = w0 * 64 + (int)__builtin_amdgcn_mbcnt_hi(ones, __builtin_amdgcn_mbcnt_lo(ones, 0u)); asm volatile("" : "+v"(tid));
        int bid = blockIdx.x, G = gridDim.x; asm volatile("" : "+s"(bid), "+s"(G));
        unsigned char* ws = args.ws; float* out = args.out; asm volatile("" : "+s"(ws), "+s"(out));
        const __attribute__((address_space(4))) fptr_t* kp = (const __attribute__((address_space(4))) fptr_t*)__builtin_amdgcn_kernarg_segment_ptr(); asm volatile("" : "+s"(kp));
        { LAS unsigned char* lb = (LAS unsigned char*)lds_raw; asm volatile("" : "+s"(lb)); F.lds = lb; }
        F.tid = tid; F.lane = tid & 63; F.wave = __builtin_amdgcn_readfirstlane(tid >> 6); F.G = G; F.bid = bid;
        F.inp = kp; F.out = out; F.ws = ws;
        frame_derive(F);
        run_phase(F, ph);
    }
}

extern "C" void kernel_launch(void* const* d_in, const int* in_sizes, int n_in, void* d_out, int out_size, void* d_ws, size_t ws_size, hipStream_t stream) {
    static int grid = 0;
    if (grid == 0) {
        if (n_in != 26 || ws_size < WS_END) { fprintf(stderr, "kernel_launch: unexpected n_in %d or ws_size %zu (< %zu)\n", n_in, ws_size, (size_t)WS_END); grid = -1; return; }
        int dev = 0, cus = 0, per_cu = 0;
        hipGetDevice(&dev); hipDeviceGetAttribute(&cus, hipDeviceAttributeMultiprocessorCount, dev);
        if (hipFuncSetAttribute((const void*)mk_fwd, hipFuncAttributeMaxDynamicSharedMemorySize, LDS_BYTES) != hipSuccess) { fprintf(stderr, "kernel_launch: hipFuncSetAttribute failed\n"); grid = -1; return; }
        if (hipOccupancyMaxActiveBlocksPerMultiprocessor(&per_cu, (const void*)mk_fwd, 512, LDS_BYTES) != hipSuccess || per_cu < 1) { fprintf(stderr, "kernel_launch: occupancy query %d\n", per_cu); per_cu = 1; }
        (void)hipGetLastError();
        grid = cus;
    }
    if (grid < 0) return;
    Args a{};
    for (int i = 0; i < 26; ++i) a.in[i] = (const float*)d_in[i];
    a.out = (float*)d_out; a.ws = (unsigned char*)d_ws;
#if MK_ONE_LAUNCH
    if (hipMemsetAsync((char*)d_ws + WS_BAR, 0, 16384, stream) != hipSuccess) { fprintf(stderr, "kernel_launch: memset failed\n"); return; }
#ifdef PROBE_KIND
    a.ph_lo = 0; a.ph_hi = N_PHASES + (PROBE_KIND == 9 ? 1 : 2);
#else
    a.ph_lo = 0; a.ph_hi = N_PHASES;
#endif
    void* kargs[] = {&a};
    hipError_t e = hipLaunchCooperativeKernel((const void*)mk_fwd, dim3(grid), dim3(512), kargs, LDS_BYTES, stream);
    if (e != hipSuccess) fprintf(stderr, "cooperative launch failed: %s (grid %d)\n", hipGetErrorString(e), grid);
#else
#ifndef RUN_PHASES
#define RUN_PHASES N_PHASES
#endif
    for (int ph = 0; ph < RUN_PHASES; ++ph) {
        a.ph_lo = ph; a.ph_hi = ph + 1;
        hipLaunchKernelGGL(mk_fwd, dim3(grid), dim3(512), LDS_BYTES, stream, a);
    }
#endif
}
```

```cpp
#include <hip/hip_runtime.h>
#include <hip/hip_cooperative_groups.h>
#include <cstdio>
namespace cg = cooperative_groups;

#ifndef MK_ONE_LAUNCH
#define MK_ONE_LAUNCH 1
#endif

#define LAS __attribute__((address_space(3)))
typedef unsigned short bf16_t;
typedef short bf16x8 __attribute__((ext_vector_type(8)));
typedef float f32x4 __attribute__((ext_vector_type(4)));
typedef float f32x2 __attribute__((ext_vector_type(2)));
typedef unsigned u32x4 __attribute__((ext_vector_type(4)));
typedef unsigned u32x2 __attribute__((ext_vector_type(2)));

constexpr int DM = 1024, NBATCH = 8, SEQ = 4096, CTXL = 256, DEPTH = 2;
constexpr int NLAT = NBATCH * SEQ, NCTX = NBATCH * CTXL, MTOT = NLAT + NCTX;
constexpr int NIN = 3072, DFF = 4096, INW = 2848;
constexpr int C_QA = 0, C_KA = 512, C_VA = 1024, C_UA = 1536, C_UG = 1792, C_QG = 2048, C_KG = 2176, C_VG = 2304, C_RG = 2560, C_GF = 2816, C_GB = 2944;
constexpr float EPS = 1e-6f;
constexpr int NCHUNK = 68;
constexpr int NGU = NBATCH * NCHUNK * 4;

constexpr size_t WS_WTIN = 0;
constexpr size_t WS_WTOUT = WS_WTIN + (size_t)DEPTH * NIN * DM * 2;
constexpr size_t WS_WT1 = WS_WTOUT + (size_t)DEPTH * DM * DM * 2;
constexpr size_t WS_WT2 = WS_WT1 + (size_t)DEPTH * DFF * DM * 2;
constexpr size_t WS_WPW = WS_WT2 + (size_t)DEPTH * DFF * DM * 2;
constexpr size_t WS_MOD = WS_WPW + (size_t)DEPTH * 256 * 256 * 2;
constexpr size_t WS_ROPE = WS_MOD + (size_t)DEPTH * 9 * 6144 * 4;
constexpr size_t WS_H = WS_ROPE + 4096;
constexpr size_t WS_U = WS_H + (size_t)MTOT * DM * 2;
constexpr size_t WS_MIX = WS_U + (size_t)MTOT * NIN * 2;
constexpr size_t WS_XC = WS_MIX + (size_t)MTOT * DM * 2;
constexpr size_t WS_DST = WS_XC + (size_t)NCTX * DM * 4;
constexpr size_t WS_DEC = WS_DST + (size_t)NGU * 2 * 2048 * 4;
constexpr size_t WS_SIN = WS_DEC + (size_t)NGU * 2 * 32 * 4;
constexpr size_t WS_GQK = WS_SIN + (size_t)NGU * 2 * 2048 * 2;
constexpr size_t WS_GVT = WS_GQK + (size_t)NGU * 4 * 2048 * 2;
constexpr size_t WS_BAR = WS_GVT + (size_t)NGU * 4096 * 2;
constexpr size_t WS_END = WS_BAR + 16384;
static_assert(WS_END <= (size_t)512 * 1024 * 1024, "workspace too large");
constexpr int LDS_BYTES = 163840;

struct Args { const float* in[26]; float* out; unsigned char* ws; int ph_lo, ph_hi; };

__device__ __forceinline__ float bf2f(bf16_t b) { return __uint_as_float((unsigned)b << 16); }
__device__ __forceinline__ bf16_t f2bf(float f) { unsigned u = __float_as_uint(f); u += 0x7fffu + ((u >> 16) & 1u); return (bf16_t)(u >> 16); }
__device__ __forceinline__ unsigned cvt_pk_bf16(float lo, float hi) { unsigned r; asm volatile("v_cvt_pk_bf16_f32 %0, %1, %2" : "=v"(r) : "v"(lo), "v"(hi)); return r; }
__device__ __forceinline__ float sigmoidf_(float x) { return __builtin_amdgcn_rcpf(1.0f + __expf(-x)); }
__device__ __forceinline__ float siluf_(float x) { return x * __builtin_amdgcn_rcpf(1.0f + __expf(-x)); }
__device__ __forceinline__ float logsigmoidf_(float x) { return x < -30.f ? x : -__logf(1.0f + __expf(-x)); }
__device__ __forceinline__ f32x4 mfma16(bf16x8 a, bf16x8 b, f32x4 c) { return __builtin_amdgcn_mfma_f32_16x16x32_bf16(a, b, c, 0, 0, 0); }

__device__ __forceinline__ float wave_scan_incl(float x) {
    float t;
    t = __int_as_float(__builtin_amdgcn_update_dpp(0, __float_as_int(x), 0x111, 0xf, 0xf, true)); x += t;
    t = __int_as_float(__builtin_amdgcn_update_dpp(0, __float_as_int(x), 0x112, 0xf, 0xf, true)); x += t;
    t = __int_as_float(__builtin_amdgcn_update_dpp(0, __float_as_int(x), 0x114, 0xf, 0xf, true)); x += t;
    t = __int_as_float(__builtin_amdgcn_update_dpp(0, __float_as_int(x), 0x118, 0xf, 0xf, true)); x += t;
    t = __int_as_float(__builtin_amdgcn_update_dpp(0, __float_as_int(x), 0x142, 0xa, 0xf, false)); x += t;
    t = __int_as_float(__builtin_amdgcn_update_dpp(0, __float_as_int(x), 0x143, 0xc, 0xf, false)); x += t;
    return x;
}
#define SHX(x, m) __int_as_float(__builtin_amdgcn_ds_bpermute((F.lane ^ (m)) << 2, __float_as_int(x)))
namespace pg8 {
constexpr int BM = 256, BK = 64, HALF = 128, HTB = HALF * BK * 2, STAGE_BYTES = 8 * HTB, NXCD = 8, WGM = 8;
__host__ __device__ __forceinline__ int lds_byte(int r, int c) { const int st = (r >> 4) * 2 + (c >> 5), rr = r & 15, cc = c & 31, ob = rr * 64 + cc * 2; return st * 1024 + (ob ^ (((ob >> 9) & 1) << 5)); }
__host__ __device__ __forceinline__ void stage_rc(int b, int& R, int& C) { const int st = b / 1024, sb = b % 1024, swz = sb ^ (((sb >> 9) & 1) << 5); R = (st >> 1) * 16 + swz / 64; C = (st & 1) * 32 + (swz % 64) / 2; }
__host__ __device__ __forceinline__ int perm32(int rho) { const int n = rho >> 4, i = rho & 15; return 8 * (i >> 2) + 4 * n + (i & 3); }
struct Unit { int pm, pn, kt0, nt, split, sp; };
struct Gemm { const bf16_t* A; const bf16_t* Bt; int M, N, K; };
struct StaticOrder {
    int nM, nN, nwg, G, c, ntK, nsplit_tiles, ns;
    __device__ __forceinline__ void init(int M, int N, int G_, int c_, int K) { nM = M / BM; nN = N / BM; nwg = nM * nN; G = G_; c = c_; ntK = K / BK; nsplit_tiles = 0; ns = 1; }
    __device__ __forceinline__ void add_split(int ntiles, int ns_) { nsplit_tiles = ntiles; ns = ns_; }
    __device__ __forceinline__ bool next(int i, Unit& u) const {
        const long L = (long)i * G + c;
        const bool sp = L >= nwg;
        const int sidx = sp ? (int)(L - nwg) : 0;
        const bool ok = !sp || sidx < nsplit_tiles * ns;
        const int tile = sidx / ns, spi = sidx % ns;
        int wgid = sp ? 0 : (int)L; { const int q = nwg / NXCD, r = nwg % NXCD, xcd = wgid % NXCD, off = wgid / NXCD; wgid = (xcd < r ? xcd * (q + 1) : r * (q + 1) + (xcd - r) * q) + off; }
        const int nig = WGM * nN, gid = wgid / nig, fm = gid * WGM, gsz = (nM - fm) < WGM ? (nM - fm) : WGM;
        const int pm_f = fm + ((wgid % nig) % gsz), pn_f = (wgid % nig) / gsz;
        const int nts = ntK / ns;
        u.pm = sp ? nM + tile / nN : pm_f; u.pn = sp ? tile % nN : pn_f; u.nt = sp ? nts : ntK; u.kt0 = sp ? spi * nts : 0; u.split = sp ? 1 : 0; u.sp = spi;
        return ok;
    }
    __device__ __forceinline__ void a_ready(const Unit&) const {}
    __device__ __forceinline__ void done(const Unit&) const {}
};
template <int ACT  > struct EpiBf16 {
    static constexpr bool PERM = true;
    bf16_t* O; int ldc;
    __device__ __forceinline__ void operator()(const f32x4 (&acc)[2][2][4][2], const Unit& u, int wr, int wc, int fr, int fq) const {
        const int row0 = u.pm * BM + wr * 64 + fr; const int col0 = u.pn * BM + wc * 32 + 8 * fq;
#pragma unroll
        for (int ai = 0; ai < 2; ++ai)
#pragma unroll
            for (int m = 0; m < 4; ++m) { bf16_t* rowp = O + (size_t)(row0 + ai * HALF + m * 16) * ldc + col0;
#pragma unroll
                for (int bj = 0; bj < 2; ++bj) { f32x4 v0 = acc[ai][bj][m][0], v1 = acc[ai][bj][m][1];
                    if (ACT == 1) {
#pragma unroll
                        for (int j = 0; j < 4; ++j) { float a = fmaxf(v0[j], 0.f), b = fmaxf(v1[j], 0.f); v0[j] = a * a; v1[j] = b * b; } }
                    u32x4 w; w.x = cvt_pk_bf16(v0[0], v0[1]); w.y = cvt_pk_bf16(v0[2], v0[3]); w.z = cvt_pk_bf16(v1[0], v1[1]); w.w = cvt_pk_bf16(v1[2], v1[3]);
                    *(u32x4*)(rowp + bj * HALF) = w; } }
    }
};
struct EpiResid {
    static constexpr bool PERM = false;
    const float* base_lat; const float* base_ctx; float* out_lat; float* out_ctx; const float* mod; int goff; float* part;
    __device__ __forceinline__ void operator()(const f32x4 (&acc)[2][2][4][2], const Unit& u, int wr, int wc, int fr, int fq) const {
        const bool lat = u.pm < (NLAT / BM);
        const float* bp = lat ? base_lat + (size_t)u.pm * BM * DM : base_ctx + (size_t)(u.pm - NLAT / BM) * BM * DM;
        float* op = lat ? out_lat + (size_t)u.pm * BM * DM : out_ctx + (size_t)(u.pm - NLAT / BM) * BM * DM;
        const float* g = mod + (lat ? (u.pm >> 4) : 8) * 6144 + goff;
        const int col0 = u.pn * BM + wc * 32 + 4 * fq;
        f32x4 gv[2][2];
#pragma unroll
        for (int bj = 0; bj < 2; ++bj)
#pragma unroll
            for (int n = 0; n < 2; ++n) gv[bj][n] = *(const f32x4*)(g + col0 + bj * HALF + n * 16);
#pragma unroll
        for (int ai = 0; ai < 2; ++ai)
#pragma unroll
            for (int m = 0; m < 4; ++m) { const size_t ro = (size_t)(wr * 64 + fr + ai * HALF + m * 16) * DM + col0;
#pragma unroll
                for (int bj = 0; bj < 2; ++bj)
#pragma unroll
                    for (int n = 0; n < 2; ++n) {
                        if (u.split) *(f32x4*)(part + (size_t)u.sp * NCTX * DM + (size_t)(u.pm - NLAT / BM) * BM * DM + ro + bj * HALF + n * 16) = gv[bj][n] * acc[ai][bj][m][n];
                        else { const f32x4 bs = *(const f32x4*)(bp + ro + bj * HALF + n * 16); *(f32x4*)(op + ro + bj * HALF + n * 16) = bs + gv[bj][n] * acc[ai][bj][m][n]; } }
                asm volatile("" ::: "memory"); }
    }
};

template <class Epi, class Sched>
__device__ __forceinline__ void gemm_phase(LAS unsigned char* lds, const int tid, const Gemm g, const Sched& S, const Epi& E) {
    const int wid = __builtin_amdgcn_readfirstlane(tid >> 6), lane = tid & 63, wr = wid >> 2, wc = wid & 3, fr = lane & 15, fq = lane >> 4;
    const int K = g.K;
    unsigned voffA[2], voffB[2];
#pragma unroll
    for (int i = 0; i < 2; ++i) { int R, C; stage_rc(tid * 16 + i * 8192, R, C); const int Rb = Epi::PERM ? ((R & ~31) + perm32(R & 31)) : R;
        voffA[i] = (unsigned)(R * K + C) * 2u; voffB[i] = (unsigned)(Rb * K + C) * 2u; }
    const size_t kstep = (size_t)(BK * 2);
    const size_t hstep = (size_t)HALF * K * 2;
    const size_t tstep = 2 * hstep;
    const unsigned ldsw = (unsigned)wid * 1024u;
    const int aoff = lds_byte(wr * 64 + fr, fq * 8), boff = lds_byte(wc * 32 + fr, fq * 8);
#define PG8_SA(b, h) (((b) * 2 + (h)) * HTB)
#define PG8_SB(b, h) ((4 + (b) * 2 + (h)) * HTB)
#define PG8_STAGE(bufoff, gbase, voff) do { _Pragma("unroll") for (int _i = 0; _i < 2; ++_i) \
        __builtin_amdgcn_global_load_lds((const unsigned*)((const char*)(gbase) + (voff)[_i]), (LAS unsigned*)(lds + (bufoff) + ldsw + _i * 8192), 16, 0, 0); } while (0)
#define PG8_LDA(dst, b, h) do { _Pragma("unroll") for (int m = 0; m < 4; ++m) _Pragma("unroll") for (int k = 0; k < 2; ++k) dst[m][k] = *(const LAS bf16x8*)(lds + PG8_SA(b, h) + aoff + m * 2048 + k * 1024); } while (0)
#define PG8_LDB(dst, b, h) do { _Pragma("unroll") for (int n = 0; n < 2; ++n) _Pragma("unroll") for (int k = 0; k < 2; ++k) dst[n][k] = *(const LAS bf16x8*)(lds + PG8_SB(b, h) + boff + n * 2048 + k * 1024); } while (0)
#define PG8_MMA(ai, bj, At, Bt) do { __builtin_amdgcn_s_setprio(1); _Pragma("unroll") for (int m = 0; m < 4; ++m) _Pragma("unroll") for (int n = 0; n < 2; ++n) _Pragma("unroll") for (int k = 0; k < 2; ++k) \
        acc[ai][bj][m][n] = __builtin_amdgcn_mfma_f32_16x16x32_bf16(Bt[n][k], At[m][k], acc[ai][bj][m][n], 0, 0, 0); __builtin_amdgcn_s_setprio(0); } while (0)
#define PG8_WAIT_V(n) asm volatile("s_waitcnt vmcnt(" #n ")" ::: "memory")
#define PG8_WAIT_L(n) asm volatile("s_waitcnt lgkmcnt(" #n ")" ::: "memory")
#define PG8_BAR __builtin_amdgcn_s_barrier()
#define PG8_SCHED __builtin_amdgcn_sched_barrier(0)
    Unit cur, nxt; int ui = 0;
    if (!S.next(0, cur)) return;
    f32x4 acc[2][2][4][2];
#pragma unroll
    for (int a = 0; a < 2; ++a)
#pragma unroll
        for (int b = 0; b < 2; ++b)
#pragma unroll
            for (int m = 0; m < 4; ++m)
#pragma unroll
                for (int n = 0; n < 2; ++n) acc[a][b][m][n] = (f32x4){0.f, 0.f, 0.f, 0.f};
    bf16x8 At[4][2], B0[2][2], B1[2][2];
    const char* cA = (const char*)g.A + (size_t)cur.pm * tstep + (size_t)cur.kt0 * kstep; const char* cB = (const char*)g.Bt + (size_t)cur.pn * tstep + (size_t)cur.kt0 * kstep;
    S.a_ready(cur);
    PG8_STAGE(PG8_SB(0, 0), cB, voffB); PG8_STAGE(PG8_SA(0, 0), cA, voffA); PG8_STAGE(PG8_SB(0, 1), cB + hstep, voffB); PG8_STAGE(PG8_SA(0, 1), cA + hstep, voffA);
    if (wr == 1) PG8_BAR;
    PG8_WAIT_V(4); PG8_BAR;
    PG8_STAGE(PG8_SB(1, 0), cB + kstep, voffB); PG8_STAGE(PG8_SA(1, 0), cA + kstep, voffA); PG8_STAGE(PG8_SB(1, 1), cB + hstep + kstep, voffB);
    PG8_WAIT_V(6); PG8_BAR;
    for (;;) {
        const bool has_next = S.next(ui + 1, nxt);
        const char* nA = has_next ? (const char*)g.A + (size_t)nxt.pm * tstep + (size_t)nxt.kt0 * kstep : cA; const char* nB = has_next ? (const char*)g.Bt + (size_t)nxt.pn * tstep + (size_t)nxt.kt0 * kstep : cB;
        const int nt = cur.nt;
        for (int t = 0; t < nt; t += 2) {
            const bool last = (t == nt - 2);
            const char* a1 = cA + (size_t)(t + 1) * kstep;
            const char* a2 = last ? nA : cA + (size_t)(t + 2) * kstep; const char* b2 = last ? nB : cB + (size_t)(t + 2) * kstep;
            const char* a3 = a2 + kstep; const char* b3 = b2 + kstep;
            if (last && has_next) S.a_ready(nxt);
            PG8_LDB(B0, 0, 0); PG8_SCHED; PG8_LDA(At, 0, 0); PG8_STAGE(PG8_SA(1, 1), a1 + hstep, voffA);
            PG8_WAIT_L(8); PG8_BAR; PG8_WAIT_L(0); PG8_MMA(0, 0, At, B0); PG8_BAR; PG8_SCHED;
            PG8_LDB(B1, 0, 1); PG8_STAGE(PG8_SB(0, 0), b2, voffB);
            PG8_BAR; PG8_WAIT_L(0); PG8_MMA(0, 1, At, B1); PG8_BAR;
            PG8_LDA(At, 0, 1); PG8_STAGE(PG8_SA(0, 0), a2, voffA);
            PG8_BAR; PG8_WAIT_L(0); PG8_MMA(1, 0, At, B0); PG8_BAR; PG8_SCHED;
            PG8_STAGE(PG8_SB(0, 1), b2 + hstep, voffB);
            PG8_WAIT_V(6); PG8_BAR; PG8_MMA(1, 1, At, B1); PG8_BAR;
            PG8_LDB(B0, 1, 0); PG8_SCHED; PG8_LDA(At, 1, 0); PG8_STAGE(PG8_SA(0, 1), a2 + hstep, voffA);
            PG8_WAIT_L(8); PG8_BAR; PG8_WAIT_L(0); PG8_MMA(0, 0, At, B0); PG8_BAR; PG8_SCHED;
            PG8_LDB(B1, 1, 1); PG8_STAGE(PG8_SB(1, 0), b3, voffB);
            PG8_BAR; PG8_WAIT_L(0); PG8_MMA(0, 1, At, B1); PG8_BAR;
            PG8_LDA(At, 1, 1); PG8_STAGE(PG8_SA(1, 0), a3, voffA);
            PG8_BAR; PG8_WAIT_L(0); PG8_MMA(1, 0, At, B0); PG8_BAR; PG8_SCHED;
            PG8_STAGE(PG8_SB(1, 1), b3 + hstep, voffB);
            PG8_WAIT_V(6); PG8_BAR; PG8_MMA(1, 1, At, B1); PG8_BAR;
        }
        E(acc, cur, wr, wc, fr, fq); S.done(cur);
        if (!has_next) break;
#pragma unroll
        for (int a = 0; a < 2; ++a)
#pragma unroll
            for (int b = 0; b < 2; ++b)
#pragma unroll
                for (int m = 0; m < 4; ++m)
#pragma unroll
                    for (int n = 0; n < 2; ++n) acc[a][b][m][n] = (f32x4){0.f, 0.f, 0.f, 0.f};
        cur = nxt; cA = nA; cB = nB; ++ui;
    }
    PG8_WAIT_V(0);
    if (wr == 0) PG8_BAR;
    PG8_BAR;
#undef PG8_SA
#undef PG8_SB
#undef PG8_STAGE
#undef PG8_LDA
#undef PG8_LDB
#undef PG8_MMA
#undef PG8_WAIT_V
#undef PG8_WAIT_L
#undef PG8_BAR
#undef PG8_SCHED
}
}

typedef const float* fptr_t;
struct Frame {
    LAS unsigned char* lds; int tid, lane, wave, G, bid;
    const __attribute__((address_space(4))) fptr_t* inp; float* out; unsigned char* ws;
    __device__ __forceinline__ const float* IN(int i) const { return inp[i]; }
    bf16_t *WtIn, *WtOut, *Wt1, *Wt2, *Wpw, *H, *U, *MIX, *HID, *SinT;
    float *mod, *rope, *XC, *dST, *dec;
    bf16_t *GQK, *GVT;
};

__device__ __forceinline__ void frame_derive(Frame& F) {
    unsigned char* ws = F.ws;
    F.lane = F.tid & 63; F.wave = __builtin_amdgcn_readfirstlane(F.tid >> 6);
    F.WtIn = (bf16_t*)(ws + WS_WTIN); F.WtOut = (bf16_t*)(ws + WS_WTOUT); F.Wt1 = (bf16_t*)(ws + WS_WT1); F.Wt2 = (bf16_t*)(ws + WS_WT2); F.Wpw = (bf16_t*)(ws + WS_WPW);
    F.mod = (float*)(ws + WS_MOD); F.rope = (float*)(ws + WS_ROPE); F.H = (bf16_t*)(ws + WS_H); F.U = (bf16_t*)(ws + WS_U); F.MIX = (bf16_t*)(ws + WS_MIX); F.HID = (bf16_t*)(ws + WS_U);
    F.XC = (float*)(ws + WS_XC); F.dST = (float*)(ws + WS_DST); F.dec = (float*)(ws + WS_DEC); F.SinT = (bf16_t*)(ws + WS_SIN); F.GQK = (bf16_t*)(ws + WS_GQK); F.GVT = (bf16_t*)(ws + WS_GVT);
}
__device__ __forceinline__ void frame_refresh(Frame& F) {
    asm volatile("" : "+v"(F.tid)); asm volatile("" : "+s"(F.ws), "+s"(F.out), "+s"(F.inp), "+s"(F.bid), "+s"(F.G), "+s"(F.lds));
    frame_derive(F);
}
__device__ __forceinline__ void transpose_tile(Frame& F, const float* src, int lds_, int k0, int n0, bf16_t* dst, int ldd) {
    LAS float* T = (LAS float*)F.lds;
    const int r = F.tid >> 4, c4 = (F.tid & 15) * 4;
#pragma unroll
    for (int p = 0; p < 2; ++p) { const int rr = r + p * 32; const f32x4 v = *(const f32x4*)(src + (size_t)(k0 + rr) * lds_ + n0 + c4);
        T[rr * 65 + c4] = v[0]; T[rr * 65 + c4 + 1] = v[1]; T[rr * 65 + c4 + 2] = v[2]; T[rr * 65 + c4 + 3] = v[3]; }
    __syncthreads();
    const int n = F.tid >> 3, kk = (F.tid & 7) * 8;
    u32x4 w;
    w.x = cvt_pk_bf16(T[(kk + 0) * 65 + n], T[(kk + 1) * 65 + n]); w.y = cvt_pk_bf16(T[(kk + 2) * 65 + n], T[(kk + 3) * 65 + n]);
    w.z = cvt_pk_bf16(T[(kk + 4) * 65 + n], T[(kk + 5) * 65 + n]); w.w = cvt_pk_bf16(T[(kk + 6) * 65 + n], T[(kk + 7) * 65 + n]);
    *(u32x4*)(dst + (size_t)(n0 + n) * ldd + k0 + kk) = w;
    __syncthreads();
}

__device__ __forceinline__ void ada_tile(Frame& F, int l, int cgp) {
    LAS float* sc = (LAS float*)F.lds;
    LAS float* red = (LAS float*)(F.lds + 36864);
    const float* c = F.IN(1); const float* cc = F.IN(3);
    for (int i = F.tid; i < 9216; i += 512) { const int j = i >> 10, k = i & 1023; const float v = j < 8 ? c[j * 1024 + k] : cc[k]; sc[i] = siluf_(v); }
    __syncthreads();
    const int n0 = cgp * 64;
    const float* w = F.IN(4) + (size_t)l * 1024 * 6144 + n0 + F.lane;
    float acc[9];
#pragma unroll
    for (int j = 0; j < 9; ++j) acc[j] = 0.f;
    const int kb = F.wave * 128;
#pragma unroll 8
    for (int k = 0; k < 128; ++k) { const float wv = w[(size_t)(kb + k) * 6144];
#pragma unroll
        for (int j = 0; j < 9; ++j) acc[j] += sc[j * 1024 + kb + k] * wv; }
#pragma unroll
    for (int j = 0; j < 9; ++j) red[(F.wave * 9 + j) * 64 + F.lane] = acc[j];
    __syncthreads();
    for (int i = F.tid; i < 576; i += 512) { const int j = i >> 6, col = i & 63; float s = F.IN(5)[l * 6144 + n0 + col];
#pragma unroll
        for (int w8 = 0; w8 < 8; ++w8) s += red[(w8 * 9 + j) * 64 + col];
        F.mod[(size_t)(l * 9 + j) * 6144 + n0 + col] = s; }
    __syncthreads();
}

__device__ __forceinline__ void gate_tile(Frame& F, int l, int kb) {
    const int k = kb * 64 + (F.tid & 63);
    const float* wrow = F.IN(7) + ((size_t)l * 1024 + k) * INW + 2816;
    float z[32];
#pragma unroll
    for (int i = 0; i < 8; ++i) { const f32x4 v = *(const f32x4*)(wrow + 4 * i); z[4 * i] = v[0]; z[4 * i + 1] = v[1]; z[4 * i + 2] = v[2]; z[4 * i + 3] = v[3]; }
    for (int idx = 0; idx < 32; ++idx) {
        const int n = (F.tid >> 6) + 8 * idx, dir = n >> 7, nn = n & 127;
        const float* gw = (dir ? F.IN(19) : F.IN(17)) + (size_t)l * 16 * 128 + nn;
        float s = 0.f;
        if (dir == 0) {
#pragma unroll
            for (int r = 0; r < 16; ++r) s += z[r] * gw[r * 128];
        } else {
#pragma unroll
            for (int r = 0; r < 16; ++r) s += z[16 + r] * gw[r * 128];
        }
        F.WtIn[((size_t)l * NIN + 2816 + n) * DM + k] = f2bf(s);
    }
}

__device__ void phase_setup(Frame& F) {
    constexpr int N_ADA = 192, N_GATE = 32, N_ROPE = 1, TPL = 704 + 256 + 1024 + 1024 + 16, N_TR = 2 * TPL;
    constexpr int N_ITEMS = N_ADA + N_GATE + N_ROPE + N_TR;
    for (int it = F.bid; it < N_ITEMS; it += F.G) {
        frame_refresh(F);
        if (it < N_ADA) { ada_tile(F, it / 96, it % 96); continue; }
        int i = it - N_ADA;
        if (i < N_GATE) { gate_tile(F, i >> 4, i & 15); continue; }
        i -= N_GATE;
        if (i < N_ROPE) {
            const int p = F.tid >> 3, f = F.tid & 7;
            const float inv = powf(10000.0f, -(float)f / 8.0f); const float ang = (float)p * inv;
            F.rope[F.tid] = cosf(ang); F.rope[512 + F.tid] = sinf(ang);
            continue; }
        i -= N_ROPE;
        const int l = i / TPL; int j = i % TPL;
        if (j < 704) { transpose_tile(F, F.IN(7) + (size_t)l * DM * INW, INW, (j / 44) * 64, (j % 44) * 64, F.WtIn + (size_t)l * NIN * DM, DM); continue; }
        j -= 704;
        if (j < 256) { transpose_tile(F, F.IN(22) + (size_t)l * DM * DM, DM, (j / 16) * 64, (j % 16) * 64, F.WtOut + (size_t)l * DM * DM, DM); continue; }
        j -= 256;
        if (j < 1024) { transpose_tile(F, F.IN(24) + (size_t)l * DM * DFF, DFF, (j / 64) * 64, (j % 64) * 64, F.Wt1 + (size_t)l * DFF * DM, DM); continue; }
        j -= 1024;
        if (j < 1024) { transpose_tile(F, F.IN(25) + (size_t)l * DFF * DM, DM, (j / 16) * 64, (j % 16) * 64, F.Wt2 + (size_t)l * DM * DFF, DFF); continue; }
        j -= 1024;
        transpose_tile(F, F.IN(15) + (size_t)l * 65536, 256, (j / 4) * 64, (j % 4) * 64, F.Wpw + (size_t)l * 65536, 256);
    }
}

__device__ void phase_prep(Frame& F, const float* src_lat, const float* src_ctx, const float* modl, int off_sh, int off_sc, const float* gvec, int M, int nparts) {
    for (int row = F.bid * 8 + F.wave; row < M; row += F.G * 8) {
        const float* xp = row < NLAT ? src_lat + (size_t)row * DM : src_ctx + (size_t)(row - NLAT) * DM;
        const float* mp = modl + (row < NLAT ? (row >> 12) : 8) * 6144;
        f32x4 v[4], gq[4], shq[4], scq[4]; float ss = 0.f;
#pragma unroll
        for (int i = 0; i < 4; ++i) { const int c = i * 256 + F.lane * 4;
            gq[i] = *(const f32x4*)(gvec + c); shq[i] = *(const f32x4*)(mp + off_sh + c); scq[i] = *(const f32x4*)(mp + off_sc + c); }
#pragma unroll
        for (int i = 0; i < 4; ++i) { v[i] = *(const f32x4*)(xp + i * 256 + F.lane * 4);
            if (nparts > 0 && row >= NLAT) {
                const float* pp = F.dST + (size_t)(row - NLAT) * DM + i * 256 + F.lane * 4;
                for (int sp = 0; sp < nparts; ++sp) v[i] += *(const f32x4*)(pp + (size_t)sp * NCTX * DM);
                *(f32x4*)(F.XC + (size_t)(row - NLAT) * DM + i * 256 + F.lane * 4) = v[i]; }
            ss += v[i][0] * v[i][0] + v[i][1] * v[i][1] + v[i][2] * v[i][2] + v[i][3] * v[i][3]; }
#pragma unroll
        for (int o = 1; o < 64; o <<= 1) ss += SHX(ss, o);
        const float r = rsqrtf(ss * (1.0f / DM) + EPS);
#pragma unroll
        for (int i = 0; i < 4; ++i) { const int c = i * 256 + F.lane * 4;
            const f32x4 g = gq[i], sh = shq[i], sc = scq[i];
            f32x4 y;
#pragma unroll
            for (int j = 0; j < 4; ++j) y[j] = v[i][j] * r * g[j] * (1.0f + sc[j]) + sh[j];
            u32x2 w; w.x = cvt_pk_bf16(y[0], y[1]); w.y = cvt_pk_bf16(y[2], y[3]);
            *(u32x2*)(F.H + (size_t)row * DM + c) = w; }
    }
}

constexpr int NSLOT = 11;
constexpr int VTL_STRIDE = NSLOT * 64 + 8, VTC_STRIDE = 264;
constexpr int NA_VTL = 0, NA_VTC = NA_VTL + 64 * VTL_STRIDE * 2, NA_RPB = NA_VTC + 64 * VTC_STRIDE * 2, NA_RKL = NA_RPB + 1920, NA_RKC = NA_RKL + NSLOT * 64 * 4, NA_GQ = NA_RKC + 1024, NA_KC = NA_GQ + 256, NA_END = NA_KC + 32768;
static_assert(NA_END <= LDS_BYTES - 16, "na lds");

__device__ __forceinline__ float sumsq8(bf16x8 v) { float s = 0.f;
#pragma unroll
    for (int i = 0; i < 8; ++i) { const float f = bf2f((bf16_t)v[i]); s += f * f; } return s; }

__device__ __forceinline__ void na_qfrag(Frame& F, int h, const bf16_t* qrowp, bf16x8 (&qf)[2]) {
    const int fq = F.lane >> 4;
    const bf16x8 q0 = *(const bf16x8*)(qrowp + C_QA + h * 64 + 8 * fq), q1 = *(const bf16x8*)(qrowp + C_QA + h * 64 + 32 + 8 * fq);
    float ss = sumsq8(q0) + sumsq8(q1); ss += SHX(ss, 16); ss += SHX(ss, 32);
    const float rq = rsqrtf(ss * (1.0f / 64.0f) + EPS);
    LAS float* GQ = (LAS float*)(F.lds + NA_GQ);
    const f32x4 g0 = *(const LAS f32x4*)(GQ + 8 * fq), g1 = *(const LAS f32x4*)(GQ + 8 * fq + 4), g2 = *(const LAS f32x4*)(GQ + 32 + 8 * fq), g3 = *(const LAS f32x4*)(GQ + 36 + 8 * fq);
#pragma unroll
    for (int i = 0; i < 4; ++i) {
        qf[0][i] = (short)f2bf(bf2f((bf16_t)q0[i]) * rq * g0[i]); qf[0][4 + i] = (short)f2bf(bf2f((bf16_t)q0[4 + i]) * rq * g1[i]);
        qf[1][i] = (short)f2bf(bf2f((bf16_t)q1[i]) * rq * g2[i]); qf[1][4 + i] = (short)f2bf(bf2f((bf16_t)q1[4 + i]) * rq * g3[i]); }
}

template <bool LOCAL>
__device__ __forceinline__ void na_wave(Frame& F, int h, const bf16x8 (&qf)[2], const bf16_t* kbase  ,
                                        int qb, int kc0, int ro0, LAS bf16_t* VT, int vstride, int vrow0, f32x4 (&o)[4], float& mrow, float& lrow) {
    constexpr int ntile = 16, tile_base = 0;
    const int fr = F.lane & 15, fq = F.lane >> 4;
    const unsigned klane = (unsigned)(fr * NIN + C_KA + h * 64 + 8 * fq);
    bf16x8 kb[4][2][2];
#define NA_LOADB(bi, buf) do { _Pragma("unroll") for (int tt = 0; tt < 2; ++tt) { const int t_ = (bi) * 2 + tt; if (t_ < ntile) { \
        const bf16_t* tbp = LOCAL ? kbase + (size_t)((t_ >> 1) * 64 + (t_ & 1) * 16) * NIN : kbase + (size_t)((tile_base + t_) * 16) * NIN; \
        if (LOCAL) { kb[buf][tt][0] = *(const bf16x8*)(tbp + klane); kb[buf][tt][1] = *(const bf16x8*)(tbp + klane + 32); } \
        else { kb[buf][tt][0] = *(const LAS bf16x8*)(F.lds + NA_KC + ((t_ * 2) * 64 + F.lane) * 16); kb[buf][tt][1] = *(const LAS bf16x8*)(F.lds + NA_KC + ((t_ * 2 + 1) * 64 + F.lane) * 16); } } } } while (0)
    if (LOCAL) { NA_LOADB(0, 0); NA_LOADB(1, 1); NA_LOADB(2, 2); }
    LAS float* rpb = (LAS float*)(F.lds + NA_RPB);
    LAS float* RKL = (LAS float*)(F.lds + NA_RKL); LAS float* RKC = (LAS float*)(F.lds + NA_RKC);
    int bo[2][4];
    if (LOCAL) {
        const int qcol = 16 * qb + fr; int cs = qcol - 8; cs = cs < 0 ? 0 : (cs > 48 ? 48 : cs);
#pragma unroll
        for (int hc = 0; hc < 2; ++hc)
#pragma unroll
            for (int j = 0; j < 4; ++j) { const int keycol = kc0 + 16 * hc + 4 * fq + j; bo[hc][j] = (keycol >= cs && keycol < cs + 16) ? keycol - qcol + 15 : 31; }
    }
    f32x4 sc[16];
#pragma unroll
    for (int bi = 0; bi < 8; ++bi) {
        asm volatile("" ::: "memory");
        if (LOCAL && bi + 3 < 8) NA_LOADB(bi + 3, (bi + 3) & 3);
        asm volatile("" ::: "memory");
#pragma unroll
        for (int tt = 0; tt < 2; ++tt) {
            const int t = bi * 2 + tt;
            sc[t] = (f32x4){-1e30f, -1e30f, -1e30f, -1e30f};
            if (t < ntile) {
                const f32x4 rk = LOCAL ? *(const LAS f32x4*)(RKL + ((vrow0 + (t >> 1)) % NSLOT) * 64 + kc0 + 16 * (t & 1) + 4 * fq) : *(const LAS f32x4*)(RKC + (tile_base + t) * 16 + 4 * fq);
                f32x4 a = (f32x4){0.f, 0.f, 0.f, 0.f};
                if (LOCAL) { a = mfma16(kb[bi & 3][tt][0], qf[0], a); a = mfma16(kb[bi & 3][tt][1], qf[1], a); }
                else { a = mfma16(*(const LAS bf16x8*)(F.lds + NA_KC + ((t * 2) * 64 + F.lane) * 16), qf[0], a); a = mfma16(*(const LAS bf16x8*)(F.lds + NA_KC + ((t * 2 + 1) * 64 + F.lane) * 16), qf[1], a); }
#pragma unroll
                for (int j = 0; j < 4; ++j) {
                    float sv = a[j] * rk[j];
                    if (LOCAL) sv += rpb[(ro0 + (t >> 1)) * 32 + bo[t & 1][j]];
                    sc[t][j] = sv;
                }
            }
        }
    }
#undef NA_LOADB
    {
        float m = -1e30f;
#pragma unroll
        for (int t = 0; t < 16; ++t) m = fmaxf(fmaxf(fmaxf(m, sc[t][0]), fmaxf(sc[t][1], sc[t][2])), sc[t][3]);
        m = fmaxf(m, SHX(m, 16)); m = fmaxf(m, SHX(m, 32));
        float sm = 0.f;
#pragma unroll
        for (int t = 0; t < 16; ++t)
#pragma unroll
            for (int j = 0; j < 4; ++j) { const float p = __builtin_amdgcn_exp2f(sc[t][j] - m); sc[t][j] = p; sm += p; }
        sm += SHX(sm, 16); sm += SHX(sm, 32);
        mrow = m; lrow = sm;
    }
    int vo[LOCAL ? 1 : 2][2][4];
#pragma unroll
    for (int par = 0; par < (LOCAL ? 1 : 2); ++par)
#pragma unroll
        for (int hc = 0; hc < 2; ++hc)
#pragma unroll
            for (int nb = 0; nb < 4; ++nb) { const int d = nb * 16 + fr;
                vo[par][hc][nb] = d * vstride + (((LOCAL ? kc0 : 32 * par) + 16 * hc + 4 * fq) ^ (((d >> 3) & 7) << 3)) + (LOCAL ? 0 : tile_base * 16);
                asm volatile("" : "+v"(vo[par][hc][nb])); }
#pragma unroll
    for (int nb = 0; nb < 4; ++nb) o[nb] = (f32x4){0.f, 0.f, 0.f, 0.f};
#pragma unroll
    for (int ks = 0; ks < 8; ++ks) {
        if (2 * ks < ntile) {
            union { bf16x8 v; unsigned u[4]; } pb;
            pb.u[0] = cvt_pk_bf16(sc[2 * ks][0], sc[2 * ks][1]); pb.u[1] = cvt_pk_bf16(sc[2 * ks][2], sc[2 * ks][3]);
            pb.u[2] = cvt_pk_bf16(sc[2 * ks + 1][0], sc[2 * ks + 1][1]); pb.u[3] = cvt_pk_bf16(sc[2 * ks + 1][2], sc[2 * ks + 1][3]);
            const int kso = LOCAL ? ((vrow0 + ks) % NSLOT) * 64 : (ks >> 1) * 64;
#pragma unroll
            for (int nb = 0; nb < 4; ++nb) {
                union { bf16x8 v; u32x2 h2[2]; } va;
                va.h2[0] = *(const LAS u32x2*)(VT + vo[LOCAL ? 0 : (ks & 1)][0][nb] + kso);
                va.h2[1] = *(const LAS u32x2*)(VT + vo[LOCAL ? 0 : (ks & 1)][1][nb] + kso);
                o[nb] = mfma16(va.v, pb.v, o[nb]); }
        }
    }
}

__device__ __forceinline__ void stage_ctx(Frame& F, const bf16_t* ctx0, int h, int l) {
    LAS bf16_t* VTC = (LAS bf16_t*)(F.lds + NA_VTC); LAS float* RKC = (LAS float*)(F.lds + NA_RKC);
    if (F.tid < 64) ((LAS float*)(F.lds + NA_GQ))[F.tid] = F.IN(8)[l * 64 + F.tid] * F.IN(9)[l * 64 + F.tid] * (0.125f * 1.4426950408889634f);
#pragma unroll
    for (int it = 0; it < 4; ++it) {
        const int item = it * 512 + F.tid, key = item >> 3, dg = item & 7;
        const bf16x8 v = *(const bf16x8*)(ctx0 + (size_t)key * NIN + C_VA + h * 64 + dg * 8);
        const bf16x8 kk = *(const bf16x8*)(ctx0 + (size_t)key * NIN + C_KA + h * 64 + dg * 8);
        const int kx = key ^ (dg << 3);
#pragma unroll
        for (int i = 0; i < 8; ++i) VTC[(dg * 8 + i) * VTC_STRIDE + kx] = (bf16_t)v[i];
        *(LAS bf16x8*)(F.lds + NA_KC + ((((key >> 4) * 2 + (dg >> 2)) * 64) + (dg & 3) * 16 + (key & 15)) * 16) = kk;
        float ss = sumsq8(kk); ss += SHX(ss, 1); ss += SHX(ss, 2); ss += SHX(ss, 4);
        if (dg == 0) RKC[key] = rsqrtf(ss * (1.0f / 64.0f) + EPS);
    }
}

__device__ __forceinline__ void na_store(Frame& F, int h, int qrow0, const f32x4 (&o)[4], float inv) {
    const int fr = F.lane & 15, fq = F.lane >> 4;
    bf16_t* op = F.MIX + (size_t)(qrow0 + fr) * DM + h * 64 + 4 * fq;
#pragma unroll
    for (int nb = 0; nb < 4; ++nb) { const f32x4 r = o[nb] * inv; u32x2 w; w.x = cvt_pk_bf16(r[0], r[1]); w.y = cvt_pk_bf16(r[2], r[3]); *(u32x2*)(op + nb * 16) = w; }
}

__device__ __forceinline__ void na_band(Frame& F, int l, int unit, bool stage_shared) {
    const int qb = F.wave & 3, half = F.wave >> 2;
    const int b = unit >> 6, h = (unit >> 3) & 7, R = (unit & 7) * 8;
    LAS bf16_t* VTL = (LAS bf16_t*)(F.lds + NA_VTL); LAS bf16_t* VTC = (LAS bf16_t*)(F.lds + NA_VTC); LAS float* RKL = (LAS float*)(F.lds + NA_RKL);
    const bf16_t* lat = F.U + (size_t)(b * SEQ) * NIN; const bf16_t* ctx0 = F.U + (size_t)(NLAT + b * CTXL) * NIN;
    const int skey = F.tid >> 3, sdg = F.tid & 7, skx = skey ^ (sdg << 3);
    const bf16_t* vsrc = lat + (size_t)skey * NIN + C_VA + h * 64 + sdg * 8;
    const bf16_t* ksrc = lat + (size_t)skey * NIN + C_KA + h * 64 + sdg * 8;
#define NA_R0(r_) ((r_) - 4 < 0 ? 0 : ((r_) - 4 > 56 ? 56 : (r_) - 4))
    int hi = NA_R0(R + 1) + 7;
    {
        for (int krow = NA_R0(R); krow <= hi; ++krow) { const bf16x8 v = *(const bf16x8*)(vsrc + (size_t)krow * 64 * NIN), kk = *(const bf16x8*)(ksrc + (size_t)krow * 64 * NIN);
            LAS bf16_t* dst = VTL + (sdg * 8) * VTL_STRIDE + (krow % NSLOT) * 64 + skx;
#pragma unroll
            for (int i = 0; i < 8; ++i) dst[i * VTL_STRIDE] = (bf16_t)v[i];
            float ss = sumsq8(kk); ss += SHX(ss, 1); ss += SHX(ss, 2); ss += SHX(ss, 4);
            if (sdg == 0) RKL[(krow % NSLOT) * 64 + skey] = rsqrtf(ss * (1.0f / 64.0f) + EPS); }
        if (stage_shared) stage_ctx(F, ctx0, h, l);
        LAS float* rpb = (LAS float*)(F.lds + NA_RPB); const float* src = F.IN(10) + ((size_t)l * 8 + h) * 465; if (stage_shared && F.tid < 480) { const int rr_ = F.tid >> 5, cc_ = F.tid & 31; rpb[F.tid] = cc_ < 31 ? src[rr_ * 31 + cc_] * 1.4426950408889634f : -1e30f; }
    }
    __syncthreads();
    int kc0 = 16 * qb - 8; kc0 = kc0 < 0 ? 0 : (kc0 > 32 ? 32 : kc0);
    for (int it2 = 0; it2 < 4; ++it2) {
        asm volatile("" : "+v"(F.lane)); const bf16_t* ctxp = ctx0; asm volatile("" : "+s"(ctxp));
        const int rA = R + 2 * it2, r = rA + half, r0 = NA_R0(r);
        int newhi = it2 < 3 ? NA_R0(rA + 3) + 7 : hi; newhi = newhi > 63 ? 63 : newhi;
        const int nnew = newhi - hi;
        bf16x8 pv0 = (bf16x8){0, 0, 0, 0, 0, 0, 0, 0}, pv1 = pv0, pk0 = pv0, pk1 = pv0;
        if (nnew > 0) { pv0 = *(const bf16x8*)(vsrc + (size_t)(hi + 1) * 64 * NIN); pk0 = *(const bf16x8*)(ksrc + (size_t)(hi + 1) * 64 * NIN); }
        if (nnew > 1) { pv1 = *(const bf16x8*)(vsrc + (size_t)(hi + 2) * 64 * NIN); pk1 = *(const bf16x8*)(ksrc + (size_t)(hi + 2) * 64 * NIN); }
        const int fr = F.lane & 15;
        const int qrow0 = b * SEQ + r * 64 + 16 * qb;
        bf16x8 qf[2];
        na_qfrag(F, h, F.U + (size_t)(qrow0 + fr) * NIN, qf);
        f32x4 oacc[4]; float mrun = -1e30f, lrun = 0.f;
#pragma unroll
        for (int nb = 0; nb < 4; ++nb) oacc[nb] = (f32x4){0.f, 0.f, 0.f, 0.f};
#pragma unroll 1
        for (int ph2 = 0; ph2 < 2; ++ph2) {
            asm volatile("" : "+v"(F.lane) :: "memory");
            f32x4 o[4]; float m1, l1;
            if (ph2 == 0) na_wave<false>(F, h, qf, ctxp, qb, 0, 0, VTC, VTC_STRIDE, 0, o, m1, l1);
            else {
                if (nnew > 0) { const int slot = (hi + 1) % NSLOT; LAS bf16_t* dst = VTL + (sdg * 8) * VTL_STRIDE + slot * 64 + skx;
#pragma unroll
                    for (int i = 0; i < 8; ++i) dst[i * VTL_STRIDE] = (bf16_t)pv0[i];
                    float ss = sumsq8(pk0); ss += SHX(ss, 1); ss += SHX(ss, 2); ss += SHX(ss, 4);
                    if (sdg == 0) RKL[slot * 64 + skey] = rsqrtf(ss * (1.0f / 64.0f) + EPS); }
                if (nnew > 1) { const int slot = (hi + 2) % NSLOT; LAS bf16_t* dst = VTL + (sdg * 8) * VTL_STRIDE + slot * 64 + skx;
#pragma unroll
                    for (int i = 0; i < 8; ++i) dst[i * VTL_STRIDE] = (bf16_t)pv1[i];
                    float ss = sumsq8(pk1); ss += SHX(ss, 1); ss += SHX(ss, 2); ss += SHX(ss, 4);
                    if (sdg == 0) RKL[slot * 64 + skey] = rsqrtf(ss * (1.0f / 64.0f) + EPS); }
                na_wave<true>(F, h, qf, lat + (size_t)(r0 * 64 + kc0) * NIN, qb, kc0, r0 - r + 7, VTL, VTL_STRIDE, r0, o, m1, l1);
            }
            const float M = fmaxf(mrun, m1), a1 = __builtin_amdgcn_exp2f(mrun - M), a2 = __builtin_amdgcn_exp2f(m1 - M);
#pragma unroll
            for (int nb = 0; nb < 4; ++nb) oacc[nb] = oacc[nb] * a1 + o[nb] * a2;
            lrun = lrun * a1 + l1 * a2; mrun = M;
        }
        na_store(F, h, qrow0, oacc, 1.0f / lrun);
        hi = newhi;
        __syncthreads();
    }
#undef NA_R0
}

__device__ __forceinline__ void na_ctx_unit(Frame& F, int l, int u2) {
    const int fr = F.lane & 15;
    const int b = u2 >> 4, qblk = (u2 >> 3) & 1, h = u2 & 7;
    LAS bf16_t* VTC = (LAS bf16_t*)(F.lds + NA_VTC);
    const bf16_t* ctx0 = F.U + (size_t)(NLAT + b * CTXL) * NIN;
    stage_ctx(F, ctx0, h, l);
    __syncthreads();
    const int qrow0 = NLAT + b * CTXL + qblk * 128 + 16 * F.wave;
    bf16x8 qf[2];
    na_qfrag(F, h, F.U + (size_t)(qrow0 + fr) * NIN, qf);
    f32x4 o[4]; float m1, l1;
    na_wave<false>(F, h, qf, ctx0, 0, 0, 0, VTC, VTC_STRIDE, 0, o, m1, l1);
    na_store(F, h, qrow0, o, 1.0f / l1);
    __syncthreads();
}

constexpr int CV_G = 0, CV_ACT = 65536, CV_END = 96256;
static_assert(CV_ACT + 64 * 264 * 2 <= LDS_BYTES, "conv lds");
__device__ __forceinline__ void conv_unit(Frame& F, int l, int unit) {
    const int fr = F.lane & 15, fq = F.lane >> 4;
    int row0, seq0, seqn;
    if (unit < 512) { row0 = unit * 64; seq0 = (unit >> 6) * SEQ; seqn = SEQ; } else { const int u2 = unit - 512; row0 = NLAT + u2 * 64; seq0 = NLAT + (u2 >> 2) * CTXL; seqn = CTXL; }
    LAS float* G = (LAS float*)(F.lds + CV_G);
    {
        bf16x8 sa[6], sg[6];
#pragma unroll
        for (int q = 0; q < 6; ++q) { const int item = F.tid + q * 512, i = item >> 5, c8 = (item & 31) * 8; int row = row0 - 15 + i;
            row = row < seq0 ? seq0 : (row > seq0 + seqn - 1 ? seq0 + seqn - 1 : row);
            sa[q] = *(const bf16x8*)(F.U + (size_t)row * NIN + C_UA + c8); sg[q] = *(const bf16x8*)(F.U + (size_t)row * NIN + C_UG + c8); }
#pragma unroll
        for (int q = 0; q < 6; ++q) { const int item = F.tid + q * 512, i = item >> 5, c8 = (item & 31) * 8; const int row = row0 - 15 + i;
            if (item < 94 * 32) {
                f32x4 g0 = (f32x4){0.f, 0.f, 0.f, 0.f}, g1 = g0;
                if (row >= seq0 && row < seq0 + seqn) {
#pragma unroll
                    for (int e = 0; e < 4; ++e) { g0[e] = bf2f((bf16_t)sa[q][e]) * sigmoidf_(bf2f((bf16_t)sg[q][e])); g1[e] = bf2f((bf16_t)sa[q][4 + e]) * sigmoidf_(bf2f((bf16_t)sg[q][4 + e])); }
                }
                *(LAS f32x4*)(G + i * 256 + c8) = g0; *(LAS f32x4*)(G + i * 256 + c8 + 4) = g1; } }
    }
    __syncthreads();
    const int ch = F.tid & 255, tg = F.tid >> 8;
    float acc[32];
    {
        float w[31];
        const float* cw = F.IN(11) + (size_t)l * 31 * 256 + ch;
#pragma unroll
        for (int j = 0; j < 31; ++j) w[j] = cw[j * 256];
        const float cb = F.IN(12)[l * 256 + ch];
#pragma unroll
        for (int tb = 0; tb < 4; ++tb) {
            float xr[38];
#pragma unroll
            for (int i = 0; i < 38; ++i) xr[i] = G[(tg * 32 + tb * 8 + i) * 256 + ch];
#pragma unroll
            for (int o = 0; o < 8; ++o) { float a = cb;
#pragma unroll
                for (int j = 0; j < 31; ++j) a += w[j] * xr[o + j];
                acc[tb * 8 + o] = a; }
        }
    }
    __syncthreads();
#pragma unroll
    for (int t = 0; t < 32; ++t) G[(tg * 32 + t) * 256 + ch] = acc[t];
    __syncthreads();
    LAS bf16_t* ACT = (LAS bf16_t*)(F.lds + CV_ACT);
    {
        const f32x4 lg = *(const f32x4*)(F.IN(13) + l * 256 + F.lane * 4), lb = *(const f32x4*)(F.IN(14) + l * 256 + F.lane * 4);
#pragma unroll
        for (int tt = 0; tt < 8; ++tt) { const int t = F.wave * 8 + tt;
            const f32x4 v = *(const LAS f32x4*)(G + t * 256 + F.lane * 4);
            float s = v[0] + v[1] + v[2] + v[3];
#pragma unroll
            for (int o = 1; o < 64; o <<= 1) s += SHX(s, o);
            const float mu = s * (1.0f / 256.0f);
            const f32x4 dv = v - mu; float q = dv[0] * dv[0] + dv[1] * dv[1] + dv[2] * dv[2] + dv[3] * dv[3];
#pragma unroll
            for (int o = 1; o < 64; o <<= 1) q += SHX(q, o);
            const float rs = rsqrtf(q * (1.0f / 256.0f) + EPS);
            float y[4];
#pragma unroll
            for (int e = 0; e < 4; ++e) y[e] = siluf_(dv[e] * rs * lg[e] + lb[e]);
            u32x2 w; w.x = cvt_pk_bf16(y[0], y[1]); w.y = cvt_pk_bf16(y[2], y[3]);
            *(LAS u32x2*)(ACT + t * 264 + F.lane * 4) = w; }
    }
    __syncthreads();
    f32x4 o[4][2];
#pragma unroll
    for (int mb = 0; mb < 4; ++mb) { o[mb][0] = (f32x4){0.f, 0.f, 0.f, 0.f}; o[mb][1] = o[mb][0]; }
    const bf16_t* wp = F.Wpw + (size_t)l * 65536 + (size_t)(F.wave * 32 + fr) * 256 + 8 * fq;
#pragma unroll
    for (int ks = 0; ks < 8; ++ks) {
        const bf16x8 b0 = *(const bf16x8*)(wp + ks * 32), b1 = *(const bf16x8*)(wp + 16 * 256 + ks * 32);
#pragma unroll
        for (int mb = 0; mb < 4; ++mb) { const bf16x8 a = *(const LAS bf16x8*)(ACT + (mb * 16 + fr) * 264 + ks * 32 + 8 * fq);
            o[mb][0] = mfma16(b0, a, o[mb][0]); o[mb][1] = mfma16(b1, a, o[mb][1]); }
    }
#pragma unroll
    for (int nn = 0; nn < 2; ++nn) { const int n = F.wave * 32 + nn * 16 + 4 * fq; const f32x4 pb = *(const f32x4*)(F.IN(16) + l * 256 + n);
#pragma unroll
        for (int mb = 0; mb < 4; ++mb) { const f32x4 r = o[mb][nn] + pb; u32x2 w; w.x = cvt_pk_bf16(r[0], r[1]); w.y = cvt_pk_bf16(r[2], r[3]);
            *(u32x2*)(F.MIX + (size_t)(row0 + mb * 16 + fr) * DM + 512 + n) = w; } }
    __syncthreads();
}

struct GlaLd { bf16x8 af, ab, qo, qp, ko, kp, v0, v1; };
__device__ __forceinline__ void gla_unit_decode(int unit, int& b, int& cc, int& h, int& row0);
__device__ __forceinline__ void gla_load(Frame& F, int pair, GlaLd& g) {
    const int slot = F.wave >> 2, w4 = F.wave & 3, t4 = F.tid & 255;
    int b, cc, h, row0; gla_unit_decode(pair * 2 + slot, b, cc, h, row0);
    const bf16_t* rp = F.U + (size_t)(row0 + F.lane) * NIN;
    g.af = *(const bf16x8*)(rp + C_GF + h * 32 + 8 * w4); g.ab = *(const bf16x8*)(rp + C_GB + h * 32 + 8 * w4);
    g.qo = *(const bf16x8*)(rp + C_QG + h * 32 + 8 * w4); g.qp = *(const bf16x8*)(rp + C_QG + h * 32 + 8 * (w4 ^ 1));
    g.ko = *(const bf16x8*)(rp + C_KG + h * 32 + 8 * w4); g.kp = *(const bf16x8*)(rp + C_KG + h * 32 + 8 * (w4 ^ 1));
    g.v0 = *(const bf16x8*)(F.U + (size_t)(row0 + (t4 >> 3)) * NIN + C_VG + h * 64 + (t4 & 7) * 8);
    g.v1 = *(const bf16x8*)(F.U + (size_t)(row0 + 32 + (t4 >> 3)) * NIN + C_VG + h * 64 + (t4 & 7) * 8);
}
__device__ __forceinline__ void gla_prep(Frame& F, const GlaLd& g, int l, int b, int cc, int h, int row0, int w4, float (&qF)[8], float (&kF)[8], float (&qB)[8], float (&kB)[8], float (&totF)[8], float (&totB)[8]) {
    const int lane = F.lane;
    const bf16x8 af = g.af, ab = g.ab, qo = g.qo, qp = g.qp, ko = g.ko, kp = g.kp;
    const bool isctx = cc < 4;
    const int p = (w4 < 2) ? (cc - 4) : lane;
    float gbf[8], gbb[8], rcs[8], rsn[8];
    {
        const float* pf = F.IN(18) + l * 128 + h * 32 + 8 * w4; const float* pb_ = F.IN(20) + l * 128 + h * 32 + 8 * w4;
        const f32x4 a0 = *(const f32x4*)pf, a1 = *(const f32x4*)(pf + 4), b0 = *(const f32x4*)pb_, b1 = *(const f32x4*)(pb_ + 4);
        const int pp = isctx ? 0 : p;
        const f32x4 c0 = *(const f32x4*)(F.rope + pp * 8), c1 = *(const f32x4*)(F.rope + pp * 8 + 4), s0 = *(const f32x4*)(F.rope + 512 + pp * 8), s1 = *(const f32x4*)(F.rope + 512 + pp * 8 + 4);
#pragma unroll
        for (int i = 0; i < 4; ++i) { gbf[i] = a0[i]; gbf[4 + i] = a1[i]; gbb[i] = b0[i]; gbb[4 + i] = b1[i]; rcs[i] = c0[i]; rcs[4 + i] = c1[i]; rsn[i] = s0[i]; rsn[4 + i] = s1[i]; }
    }
    const float qscale = 0.17677669529663687f;
#pragma unroll
    for (int i = 0; i < 8; ++i) {
        const float laf = logsigmoidf_(bf2f((bf16_t)af[i]) + gbf[i]) * (1.0f / 16.0f), lab = logsigmoidf_(bf2f((bf16_t)ab[i]) + gbb[i]) * (1.0f / 16.0f);
        const float cf = wave_scan_incl(laf), pb = wave_scan_incl(lab);
        totF[i] = __int_as_float(__builtin_amdgcn_readlane(__float_as_int(cf), 63)); totB[i] = __int_as_float(__builtin_amdgcn_readlane(__float_as_int(pb), 63));
        const float cb = totB[i] - pb + lab;
        float q = bf2f((bf16_t)qo[i]), k = bf2f((bf16_t)ko[i]);
        if (!isctx) {
            const float cs = rcs[i], sn = rsn[i];
            const float q2 = bf2f((bf16_t)qp[i]), k2 = bf2f((bf16_t)kp[i]);
            if (w4 & 1) { q = q2 * sn + q * cs; k = k2 * sn + k * cs; } else { q = q * cs - q2 * sn; k = k * cs - k2 * sn; }
        }
        q *= qscale;
        const float ef = __expf(cf), eb = __expf(cb);
        qF[i] = q * ef; kF[i] = k * __expf(-cf); qB[i] = q * eb; kB[i] = k * __expf(-cb);
    }
}
__device__ __forceinline__ void gla_unit_decode(int unit, int& b, int& cc, int& h, int& row0) {
    h = unit & 3; const int t = unit >> 2; cc = t % NCHUNK; b = t / NCHUNK;
    row0 = cc < 4 ? NLAT + b * CTXL + cc * 64 : b * SEQ + (cc - 4) * 64;
}
__device__ __forceinline__ void gla_stage_vt(const GlaLd& g, LAS bf16_t* VT, int t4) {
    const int s = t4 >> 3, dg = t4 & 7;
#pragma unroll
    for (int i = 0; i < 8; ++i) { VT[(dg * 8 + i) * 72 + s] = (bf16_t)g.v0[i]; VT[(dg * 8 + i) * 72 + 32 + s] = (bf16_t)g.v1[i]; }
}

constexpr int GL_SLOT = 18432 + 256;
__device__ __forceinline__ void gla_local_pair(Frame& F, int l, int pair, const GlaLd& g) {
    const int fr = F.lane & 15, fq = F.lane >> 4;
    const int slot = F.wave >> 2, w4 = F.wave & 3, t4 = F.tid & 255;
    const int unit = pair * 2 + slot; int b, cc, h, row0; gla_unit_decode(unit, b, cc, h, row0);
    LAS unsigned char* sb = F.lds + slot * GL_SLOT;
    LAS bf16_t* KT[2] = {(LAS bf16_t*)sb, (LAS bf16_t*)(sb + 4608)}; LAS bf16_t* VT = (LAS bf16_t*)(sb + 9216); LAS float* TOT = (LAS float*)(sb + 18432);
    {
        float qF[8], kF[8], qB[8], kB[8], totF[8], totB[8];
        gla_prep(F, g, l, b, cc, h, row0, w4, qF, kF, qB, kB, totF, totB);
#pragma unroll
        for (int i = 0; i < 8; ++i) { KT[0][(8 * w4 + i) * 72 + F.lane] = f2bf(kF[i]); KT[1][(8 * w4 + i) * 72 + F.lane] = f2bf(kB[i]); }
        {
            bf16_t* gq = F.GQK + (size_t)unit * 8192 + F.lane * 32 + 8 * w4; u32x4 w;
            w.x = cvt_pk_bf16(qF[0], qF[1]); w.y = cvt_pk_bf16(qF[2], qF[3]); w.z = cvt_pk_bf16(qF[4], qF[5]); w.w = cvt_pk_bf16(qF[6], qF[7]); *(u32x4*)(gq) = w;
            w.x = cvt_pk_bf16(kF[0], kF[1]); w.y = cvt_pk_bf16(kF[2], kF[3]); w.z = cvt_pk_bf16(kF[4], kF[5]); w.w = cvt_pk_bf16(kF[6], kF[7]); *(u32x4*)(gq + 2048) = w;
            w.x = cvt_pk_bf16(qB[0], qB[1]); w.y = cvt_pk_bf16(qB[2], qB[3]); w.z = cvt_pk_bf16(qB[4], qB[5]); w.w = cvt_pk_bf16(qB[6], qB[7]); *(u32x4*)(gq + 4096) = w;
            w.x = cvt_pk_bf16(kB[0], kB[1]); w.y = cvt_pk_bf16(kB[2], kB[3]); w.z = cvt_pk_bf16(kB[4], kB[5]); w.w = cvt_pk_bf16(kB[6], kB[7]); *(u32x4*)(gq + 6144) = w;
        }
        if (F.lane == 0) {
#pragma unroll
            for (int i = 0; i < 8; ++i) { TOT[8 * w4 + i] = totF[i]; TOT[32 + 8 * w4 + i] = totB[i];
                F.dec[(size_t)(unit * 2 + 0) * 32 + 8 * w4 + i] = __expf(totF[i]); F.dec[(size_t)(unit * 2 + 1) * 32 + 8 * w4 + i] = __expf(totB[i]); } }
    }
    gla_stage_vt(g, VT, t4);
    __syncthreads();
    {
#pragma unroll
        for (int it2 = 0; it2 < 2; ++it2) { const int item = it2 * 256 + t4, dv = item >> 3, s8 = (item & 7) * 8;
            *(u32x4*)(F.GVT + (size_t)unit * 4096 + dv * 64 + s8) = *(const LAS u32x4*)(VT + dv * 72 + s8); }
    }
    const int dir = w4 >> 1, mb = w4 & 1;
    f32x4 acc[4];
#pragma unroll
    for (int nb = 0; nb < 4; ++nb) acc[nb] = (f32x4){0.f, 0.f, 0.f, 0.f};
#pragma unroll
    for (int ks = 0; ks < 2; ++ks) { const bf16x8 a = *(const LAS bf16x8*)(KT[dir] + (mb * 16 + fr) * 72 + ks * 32 + 8 * fq);
#pragma unroll
        for (int nb = 0; nb < 4; ++nb) { const bf16x8 vb = *(const LAS bf16x8*)(VT + (nb * 16 + fr) * 72 + ks * 32 + 8 * fq); acc[nb] = mfma16(a, vb, acc[nb]); } }
    f32x4 sc4;
#pragma unroll
    for (int j = 0; j < 4; ++j) sc4[j] = __expf(TOT[dir * 32 + mb * 16 + 4 * fq + j]);
#pragma unroll
    for (int nb = 0; nb < 4; ++nb) *(f32x4*)(F.dST + (size_t)(unit * 2 + dir) * 2048 + (nb * 16 + fr) * 32 + mb * 16 + 4 * fq) = acc[nb] * sc4;
    __syncthreads();
}

__device__ void phase_gla_scan(Frame& F) {
    for (int e = F.bid * 512 + F.tid; e < NBATCH * 4 * 2 * 2048; e += F.G * 512) {
        const int inner = e & 2047, dir = (e >> 11) & 1, h = (e >> 12) & 3, b = e >> 14, d = inner & 31;
        float S = 0.f;
#pragma unroll 1
        for (int half = 0; half < 2; ++half) {
            float dc[34], ds[34];
#pragma unroll
            for (int i = 0; i < 34; ++i) { const int step = half * 34 + i;
                const int cc = dir == 0 ? step : (step < 4 ? 3 - step : 71 - step);
                const int unit = (b * NCHUNK + cc) * 4 + h;
                dc[i] = F.dec[(size_t)(unit * 2 + dir) * 32 + d]; ds[i] = F.dST[(size_t)(unit * 2 + dir) * 2048 + inner]; }
#pragma unroll
            for (int i = 0; i < 34; ++i) { const int step = half * 34 + i;
                const int cc = dir == 0 ? step : (step < 4 ? 3 - step : 71 - step);
                const int unit = (b * NCHUNK + cc) * 4 + h;
                F.SinT[(size_t)(unit * 2 + dir) * 2048 + inner] = f2bf(S);
                S = dc[i] * S + ds[i]; }
        }
    }
}

__device__ __forceinline__ void gla_out_wave(Frame& F, int l, int unit, int tb) {
    const int fr = F.lane & 15, fq = F.lane >> 4;
    int b, cc, h, row0; gla_unit_decode(unit, b, cc, h, row0);
    LAS bf16_t* ATT = (LAS bf16_t*)(F.lds + F.wave * 2304);
    const bf16_t* gq = F.GQK + (size_t)unit * 8192; const bf16_t* gv = F.GVT + (size_t)unit * 4096;
    bf16x8 qa2[2], kb2[2][4], vb2[2][4], sb2[2][4];
#pragma unroll
    for (int dir = 0; dir < 2; ++dir) {
        qa2[dir] = *(const bf16x8*)(gq + dir * 4096 + (tb * 16 + fr) * 32 + 8 * fq);
#pragma unroll
        for (int sbk = 0; sbk < 4; ++sbk) { const bool valid = dir == 0 ? (sbk <= tb) : (sbk >= tb);
            kb2[dir][sbk] = valid ? *(const bf16x8*)(gq + dir * 4096 + 2048 + (sbk * 16 + fr) * 32 + 8 * fq) : (bf16x8){0, 0, 0, 0, 0, 0, 0, 0}; }
#pragma unroll
        for (int nb = 0; nb < 4; ++nb) sb2[dir][nb] = *(const bf16x8*)(F.SinT + (size_t)(unit * 2 + dir) * 2048 + (nb * 16 + fr) * 32 + 8 * fq);
    }
#pragma unroll
    for (int ks = 0; ks < 2; ++ks)
#pragma unroll
        for (int nb = 0; nb < 4; ++nb) vb2[ks][nb] = *(const bf16x8*)(gv + (nb * 16 + fr) * 64 + ks * 32 + 8 * fq);
    u32x2 rw4[4]; f32x4 og4[4];
    const size_t orow = (size_t)(row0 + tb * 16 + fr);
#pragma unroll
    for (int nb = 0; nb < 4; ++nb) { rw4[nb] = *(const u32x2*)(F.U + orow * NIN + C_RG + h * 64 + nb * 16 + 4 * fq); og4[nb] = *(const f32x4*)(F.IN(21) + l * 64 + nb * 16 + 4 * fq); }
    f32x4 o[4];
#pragma unroll
    for (int nb = 0; nb < 4; ++nb) o[nb] = (f32x4){0.f, 0.f, 0.f, 0.f};
#pragma unroll
    for (int dir = 0; dir < 2; ++dir) {
        const bf16x8 qa = qa2[dir];
#pragma unroll
        for (int sbk = 0; sbk < 4; ++sbk) {
            const bool valid = dir == 0 ? (sbk <= tb) : (sbk >= tb);
            f32x4 a = (f32x4){0.f, 0.f, 0.f, 0.f};
            if (valid) a = mfma16(qa, kb2[dir][sbk], a);
#pragma unroll
            for (int j = 0; j < 4; ++j) { float v = a[j];
                if (sbk == tb) { const bool keep = dir == 0 ? (fr <= 4 * fq + j) : (fr >= 4 * fq + j); v = keep ? v : 0.f; }
                ATT[(4 * fq + j) * 72 + sbk * 16 + fr] = f2bf(v); }
        }
        asm volatile("s_waitcnt lgkmcnt(0)" ::: "memory");
#pragma unroll
        for (int ks = 0; ks < 2; ++ks) { const bf16x8 pa = *(const LAS bf16x8*)(ATT + fr * 72 + ks * 32 + 8 * fq);
#pragma unroll
            for (int nb = 0; nb < 4; ++nb) o[nb] = mfma16(vb2[ks][nb], pa, o[nb]); }
#pragma unroll
        for (int nb = 0; nb < 4; ++nb) o[nb] = mfma16(sb2[dir][nb], qa, o[nb]);
        asm volatile("s_waitcnt lgkmcnt(0)" ::: "memory");
    }
    {
        float ss = 0.f;
#pragma unroll
        for (int nb = 0; nb < 4; ++nb) ss += o[nb][0] * o[nb][0] + o[nb][1] * o[nb][1] + o[nb][2] * o[nb][2] + o[nb][3] * o[nb][3];
        ss += SHX(ss, 16); ss += SHX(ss, 32);
        const float rinv = rsqrtf(ss * (1.0f / 64.0f) + EPS);
        const size_t row = (size_t)(row0 + tb * 16 + fr);
#pragma unroll
        for (int nb = 0; nb < 4; ++nb) { const int dv = nb * 16 + 4 * fq;
            const u32x2 rw = rw4[nb]; const f32x4 og = og4[nb];
            const float r0_ = __uint_as_float(rw.x << 16), r1_ = __uint_as_float(rw.x & 0xffff0000u), r2_ = __uint_as_float(rw.y << 16), r3_ = __uint_as_float(rw.y & 0xffff0000u);
            u32x2 w; w.x = cvt_pk_bf16(o[nb][0] * rinv * og[0] * siluf_(r0_), o[nb][1] * rinv * og[1] * siluf_(r1_));
            w.y = cvt_pk_bf16(o[nb][2] * rinv * og[2] * siluf_(r2_), o[nb][3] * rinv * og[3] * siluf_(r3_));
            *(u32x2*)(F.MIX + row * DM + 768 + h * 64 + dv) = w; }
    }
}

__device__ void phase_mixers(Frame& F, int l) {
    const int n_na = 512 + (l == 0 ? 128 : 0), n_cv = 512 + (l == 0 ? 32 : 0), n_gl = NGU / 2;
    for (int it = F.bid; it < n_na + n_cv; it += F.G) {
        frame_refresh(F);
        if (it < n_na) {
            if (it < 512) {
                const int wb = it & 255, second = it >> 8, rest = wb >> 3;
                na_band(F, l, ((wb & 7) << 6) | ((rest >> 2) << 3) | ((rest & 3) * 2 + second), second == 0 || F.G != 256);
            } else na_ctx_unit(F, l, it - 512); }
        else conv_unit(F, l, it - n_na);
    }
    const int base = n_na + n_cv;
    int it = base + ((F.bid - base % F.G) + F.G) % F.G;
    frame_refresh(F);
    GlaLd cur;
    if (it < base + n_gl) gla_load(F, it - base, cur);
    for (; it < base + n_gl; it += F.G) {
        frame_refresh(F);
        GlaLd nxt = cur;
        if (it + F.G < base + n_gl) gla_load(F, it + F.G - base, nxt);
        gla_local_pair(F, l, it - base, cur);
        cur = nxt;
    }
}
__device__ void phase_gla_out(Frame& F, int l) {
    for (int it = F.bid * 8 + F.wave; it < NGU * 4; it += F.G * 8) gla_out_wave(F, l, it >> 2, it & 3);
}

#define XB_TMO      128
#define XB_XCNT(j)  (256  + 64 * (j))
#define XB_XSUB(j)  (1280 + 64 * (j))
#define XB_XGEN(j)  (2304 + 64 * (j))
#define XB_TOP      3328
#define XB_TOPGEN   3392
#define XCD_BAR_WORDS 3456
#define XB_SPIN_CAP (1u << 23)
__device__ __forceinline__ unsigned xb_ld(unsigned* p)              { return __hip_atomic_load(p, __ATOMIC_RELAXED, __HIP_MEMORY_SCOPE_AGENT); }
__device__ __forceinline__ unsigned xb_add(unsigned* p, unsigned v) { return __hip_atomic_fetch_add(p, v, __ATOMIC_RELAXED, __HIP_MEMORY_SCOPE_AGENT); }
__device__ __forceinline__ unsigned xb_xcc_id() { return (unsigned)__builtin_amdgcn_s_getreg((3 << 11) | 20) & 0xFu; }
#define XB_SPIN(cond, bar) do { unsigned _sp = 0; while (cond) { __builtin_amdgcn_s_sleep(1); \
    if ((++_sp & 255u) == 0u) { if (xb_ld(&(bar)[XB_TMO])) break; if (_sp > XB_SPIN_CAP) { atomicAdd(&(bar)[XB_TMO], 1u); break; } } } } while (0)
struct XcdBarrier { unsigned* bar; unsigned x; volatile LAS unsigned* st; };
__device__ __forceinline__ XcdBarrier xcd_barrier_post(unsigned* bar, volatile LAS unsigned* st) {
    XcdBarrier b; b.bar = bar; b.x = xb_xcc_id(); b.st = st;
    if (threadIdx.x == 0) (void)xb_add(&bar[XB_XCNT(b.x)], 1u);
    return b;
}
__device__ __forceinline__ void xcd_barrier_complete(unsigned* bar, unsigned x, unsigned& nloc, unsigned& nx) {
    const unsigned G = gridDim.x * gridDim.y * gridDim.z;
    unsigned sum, cnt, mine, sp = 0u;
    for (;;) {
        sum = 0u; cnt = 0u; mine = 0u;
#pragma unroll
        for (unsigned j = 0; j < 16; ++j) { const unsigned c = xb_ld(&bar[XB_XCNT(j)]); sum += c; cnt += (c > 0u) ? 1u : 0u; mine = (j == x) ? c : mine; }
        if (sum == G) break;
        __builtin_amdgcn_s_sleep(1);
        if ((++sp & 255u) == 0u) { if (xb_ld(&bar[XB_TMO])) break; if (sp > XB_SPIN_CAP) { atomicAdd(&bar[XB_TMO], 1u); break; } }
    }
    nloc = mine > 0u ? mine : 1u; nx = cnt > 0u ? cnt : 1u;
}
__device__ __forceinline__ void xcd_barrier(const XcdBarrier& b, const bool t0) {
    asm volatile("s_waitcnt vmcnt(0)" ::: "memory");
    __syncthreads();
    if (t0) {
        unsigned* bar = b.bar;
        __builtin_amdgcn_s_waitcnt(0);
        unsigned nloc = b.st[0], nx = b.st[1];
        if (nloc == 0u) { xcd_barrier_complete(bar, b.x, nloc, nx); b.st[0] = nloc; b.st[1] = nx; }
        const unsigned old = xb_add(&bar[XB_XSUB(b.x)], 1u);
        const unsigned gen = old / nloc;
        if (old + 1u == (gen + 1u) * nloc) {
            __builtin_amdgcn_fence(__ATOMIC_RELEASE, "agent");
            asm volatile("s_waitcnt vmcnt(0)" ::: "memory");
            const unsigned og = xb_add(&bar[XB_TOP], 1u);
            const unsigned tg = og / nx;
            if (og + 1u == (tg + 1u) * nx) xb_add(&bar[XB_TOPGEN], 1u);
            else XB_SPIN(xb_ld(&bar[XB_TOPGEN]) == tg, bar);
            __builtin_amdgcn_fence(__ATOMIC_ACQUIRE, "agent");
            xb_add(&bar[XB_XGEN(b.x)], 1u);
            asm volatile("s_waitcnt vmcnt(0)" ::: "memory");
        } else {
            XB_SPIN(xb_ld(&bar[XB_XGEN(b.x)]) == gen, bar);
            __builtin_amdgcn_fence(__ATOMIC_ACQUIRE, "agent");
            asm volatile("s_waitcnt vmcnt(0)" ::: "memory");
        }
    }
    __syncthreads();
}

constexpr int N_PHASES = 1 + 9 * DEPTH;

__device__ __forceinline__ void run_phase(Frame& F, int ph) {
#ifndef PH_MASK
#define PH_MASK 0x3ff
#endif
    if (ph == 0) { if (PH_MASK & 1) phase_setup(F); return; }
    const int l = (ph - 1) / 9, s = (ph - 1) % 9;
    const float* modl = F.mod + (size_t)l * 9 * 6144;
    const float* xlat = l == 0 ? F.IN(0) : F.out;
    const float* xctx = l == 0 ? F.IN(2) : F.XC;
    const int Mfull = l == 0 ? MTOT : NLAT;
    pg8::StaticOrder S;
    switch (s) {
    case 0: if (PH_MASK & 2) phase_prep(F, xlat, xctx, modl, 0, 1024, F.IN(6) + l * DM, MTOT, l == 0 ? 0 : 8); break;
    case 1: if (PH_MASK & 4) { pg8::Gemm g{F.H, F.WtIn + (size_t)l * NIN * DM, MTOT, NIN, DM}; S.init(MTOT, NIN, F.G, F.bid, DM); pg8::EpiBf16<0> E{F.U, NIN}; pg8::gemm_phase(F.lds, F.tid, g, S, E); } break;
    case 2: if (PH_MASK & 8) phase_mixers(F, l); break;
    case 3: if (PH_MASK & 16) phase_gla_scan(F); break;
    case 4: if (PH_MASK & 32) phase_gla_out(F, l); break;
    case 5: if (PH_MASK & 64) { pg8::Gemm g{F.MIX, F.WtOut + (size_t)l * DM * DM, Mfull, DM, DM}; S.init(NLAT, DM, F.G, F.bid, DM); if (l == 0) S.add_split(32, 4); pg8::EpiResid E{xlat, xctx, F.out, F.XC, modl, 2048, F.dST}; pg8::gemm_phase(F.lds, F.tid, g, S, E); } break;
    case 6: if (PH_MASK & 128) phase_prep(F, F.out, l == 0 ? xctx : F.XC, modl, 3072, 4096, F.IN(23) + l * DM, Mfull, l == 0 ? 4 : 0); break;
    case 7: if (PH_MASK & 256) { pg8::Gemm g{F.H, F.Wt1 + (size_t)l * DFF * DM, Mfull, DFF, DM}; S.init(Mfull, DFF, F.G, F.bid, DM); pg8::EpiBf16<1> E{F.HID, DFF}; pg8::gemm_phase(F.lds, F.tid, g, S, E); } break;
    case 8: if (PH_MASK & 512) { pg8::Gemm g{F.HID, F.Wt2 + (size_t)l * DM * DFF, Mfull, DM, DFF}; S.init(NLAT, DM, F.G, F.bid, DFF); if (l == 0) S.add_split(32, 8); pg8::EpiResid E{F.out, F.XC, F.out, F.XC, modl, 5120, F.dST}; pg8::gemm_phase(F.lds, F.tid, g, S, E); } break;
    }
}

__global__ void __launch_bounds__(512, 2) mk_fwd(Args args) {
    extern __shared__ __attribute__((aligned(16))) unsigned char lds_raw[];
    const int wave0 = __builtin_amdgcn_readfirstlane((int)threadIdx.x >> 6);
    volatile LAS unsigned* bst = (volatile LAS unsigned*)((LAS unsigned char*)lds_raw + LDS_BYTES - 16);
    if (threadIdx.x == 0) { bst[0] = 0u; bst[1] = 0u; }
    __syncthreads();
    XcdBarrier xbar; xbar.bar = (unsigned*)(args.ws + WS_BAR); xbar.x = 0; xbar.st = bst;
    if (args.ph_hi - args.ph_lo > 1) xbar = xcd_barrier_post((unsigned*)(args.ws + WS_BAR), bst);
    for (int step = args.ph_lo; step < args.ph_hi; ++step) {
        int ph = step;
#ifdef PROBE_KIND
        { const int P = PROBE_KIND == 9 ? 0 : 1 + PROBE_KIND, Q = PROBE_KIND == 9 ? 1000 : 10 + PROBE_KIND; ph = step - (step > P ? 1 : 0) - (step > Q + 1 ? 1 : 0); }
#endif
        if (step > args.ph_lo) { if (args.ph_hi < 0) cg::this_grid().sync();
            else { unsigned on2 = ~0u; asm volatile("" : "+s"(on2)); xcd_barrier(xbar, wave0 == 0 && __builtin_amdgcn_mbcnt_hi(on2, __builtin_amdgcn_mbcnt_lo(on2, 0u)) == 0u); } }
        Frame F;
        unsigned ones = ~0u; int w0 = wave0; asm volatile("" : "+s"(ones), "+s"(w0));
        int tid = w0 * 64 + (int)__builtin_amdgcn_mbcnt_hi(ones, __builtin_amdgcn_mbcnt_lo(ones, 0u)); asm volatile("" : "+v"(tid));
        int bid = blockIdx.x, G = gridDim.x; asm volatile("" : "+s"(bid), "+s"(G));
        unsigned char* ws = args.ws; float* out = args.out; asm volatile("" : "+s"(ws), "+s"(out));
        const __attribute__((address_space(4))) fptr_t* kp = (const __attribute__((address_space(4))) fptr_t*)__builtin_amdgcn_kernarg_segment_ptr(); asm volatile("" : "+s"(kp));
        { LAS unsigned char* lb = (LAS unsigned char*)lds_raw; asm volatile("" : "+s"(lb)); F.lds = lb; }
        F.tid = tid; F.lane = tid & 63; F.wave = __builtin_amdgcn_readfirstlane(tid >> 6); F.G = G; F.bid = bid;
        F.inp = kp; F.out = out; F.ws = ws;
        frame_derive(F);
        run_phase(F, ph);
    }
}

extern "C" void kernel_launch(void* const* d_in, const int* in_sizes, int n_in, void* d_out, int out_size, void* d_ws, size_t ws_size, hipStream_t stream) {
    static int grid = 0;
    if (grid == 0) {
        if (n_in != 26 || ws_size < WS_END) { fprintf(stderr, "kernel_launch: unexpected n_in %d or ws_size %zu (< %zu)\n", n_in, ws_size, (size_t)WS_END); grid = -1; return; }
        int dev = 0, cus = 0, per_cu = 0;
        hipGetDevice(&dev); hipDeviceGetAttribute(&cus, hipDeviceAttributeMultiprocessorCount, dev);
        if (hipFuncSetAttribute((const void*)mk_fwd, hipFuncAttributeMaxDynamicSharedMemorySize, LDS_BYTES) != hipSuccess) { fprintf(stderr, "kernel_launch: hipFuncSetAttribute failed\n"); grid = -1; return; }
        if (hipOccupancyMaxActiveBlocksPerMultiprocessor(&per_cu, (const void*)mk_fwd, 512, LDS_BYTES) != hipSuccess || per_cu < 1) { fprintf(stderr, "kernel_launch: occupancy query %d\n", per_cu); per_cu = 1; }
        (void)hipGetLastError();
        grid = cus;
    }
    if (grid < 0) return;
    Args a{};
    for (int i = 0; i < 26; ++i) a.in[i] = (const float*)d_in[i];
    a.out = (float*)d_out; a.ws = (unsigned char*)d_ws;
#if MK_ONE_LAUNCH
    if (hipMemsetAsync((char*)d_ws + WS_BAR, 0, 16384, stream) != hipSuccess) { fprintf(stderr, "kernel_launch: memset failed\n"); return; }
#ifdef PROBE_KIND
    a.ph_lo = 0; a.ph_hi = N_PHASES + (PROBE_KIND == 9 ? 1 : 2);
#else
    a.ph_lo = 0; a.ph_hi = N_PHASES;
#endif
    void* kargs[] = {&a};
    hipError_t e = hipLaunchCooperativeKernel((const void*)mk_fwd, dim3(grid), dim3(512), kargs, LDS_BYTES, stream);
    if (e != hipSuccess) fprintf(stderr, "cooperative launch failed: %s (grid %d)\n", hipGetErrorString(e), grid);
#else
#ifndef RUN_PHASES
#define RUN_PHASES N_PHASES
#endif
    for (int ph = 0; ph < RUN_PHASES; ++ph) {
        a.ph_lo = ph; a.ph_hi = ph + 1;
        hipLaunchKernelGGL(mk_fwd, dim3(grid), dim3(512), LDS_BYTES, stream, a);
    }
#endif
}
```
